# Optimizing an MI355X kernel written in HIP

```python
import jax, jax.numpy as jnp
from jax import lax
import numpy as np

D_MODEL = 2048
BATCH = 4
SEQ = 2048
DEPTH = 1
DEC_BATCH = 8
DEC_SEQ = 8
PAST_LEN = 16384
PAGE_SIZE = 128

DH_A = 128
H_A = (D_MODEL // 2) // DH_A
W_A = H_A * DH_A
H_IDX = 16
D_IDX = 64
TOPK_MAX = 256
Q_BLOCK = 32
DK_B = 128
DV_B = 128
H_B = (D_MODEL // 4) // DV_B
W_B = H_B * DV_B
HGRN_CHUNK = 64
DH_M = 128
H_M = (D_MODEL // 4) // DH_M
W_M = H_M * DH_M
N_MEM = 256
ROPE_THETA = 500000.0
ROPE_FRAC = 4
LN_EPS = 1e-5
RMS_EPS = 1e-6
ALPHA = (2.0 * DEPTH) ** 0.25
BETA = (8.0 * DEPTH) ** -0.25
IN_SPLITS = (W_A, W_A, W_A, W_A, H_IDX * D_IDX, D_IDX, H_IDX,
             H_B * DK_B, H_B * DK_B, W_B, W_B, W_M, W_M)
N_IN = sum(IN_SPLITS)

kernel_name = "hymba_dsa_hgrn2_memxattn_step"


def _rope(x, pos):
    d = x.shape[-1]
    r = d // ROPE_FRAC
    half = r // 2
    inv = ROPE_THETA ** (-jnp.arange(half, dtype=jnp.float32) / half)
    ang = pos.astype(jnp.float32)[:, None] * inv[None, :]
    cos = jnp.cos(ang)[:, None, :]
    sin = jnp.sin(ang)[:, None, :]
    xr = x[..., :r].astype(jnp.float32)
    x1, x2 = xr[..., :half], xr[..., half:]
    rot = jnp.concatenate([x1 * cos - x2 * sin, x2 * cos + x1 * sin], axis=-1)
    return jnp.concatenate([rot.astype(x.dtype), x[..., r:]], axis=-1)


def _layernorm(x, g, b):
    xf = x.astype(jnp.float32)
    xc = xf - jnp.mean(xf, axis=-1, keepdims=True)
    var = jnp.mean(xc * xc, axis=-1, keepdims=True)
    return (xc * lax.rsqrt(var + LN_EPS) * g.astype(jnp.float32) + b.astype(jnp.float32)).astype(x.dtype)


def _in_proj(h, w, pos):
    n_b, n_t, _ = h.shape
    z = jnp.einsum('btd,dn->btn', h, w)
    cuts = [int(c) for c in np.cumsum(IN_SPLITS)[:-1]]
    aq, ak, av, ag, iq, ik, iw, bq, bf, bi, bg, mq, mg = jnp.split(z, cuts, axis=-1)
    aq = _rope(aq.reshape(n_b, n_t, H_A, DH_A), pos)
    ak = _rope(ak.reshape(n_b, n_t, H_A, DH_A), pos)
    av = av.reshape(n_b, n_t, H_A, DH_A)
    iq = _rope(iq.reshape(n_b, n_t, H_IDX, D_IDX), pos)
    ik = _rope(ik.reshape(n_b, n_t, 1, D_IDX), pos)[:, :, 0]
    mq = mq.reshape(n_b, n_t, H_M, DH_M)
    return aq, ak, av, ag, iq, ik, iw, bq, bf, bi, bg, mq, mg


def _indexer_scores(iq, iw, ik):
    dots = jnp.einsum('bthd,bld->bthl', iq.astype(jnp.float32), ik.astype(jnp.float32)) * (D_IDX ** -0.5)
    return jnp.einsum('bth,bthl->btl', iw.astype(jnp.float32) * (H_IDX ** -0.5), jax.nn.relu(dots))


def _sparse_attend(q, k_sel, v_sel, valid):
    s = jnp.einsum('bthd,btkhd->bthk', q.astype(jnp.float32), k_sel.astype(jnp.float32)) * (DH_A ** -0.5)
    s = jnp.where(valid[:, :, None, :], s, -jnp.inf)
    p = jax.nn.softmax(s, axis=-1)
    return jnp.einsum('bthk,btkhd->bthd', p, v_sel.astype(jnp.float32))


def _take_rows(a, idx):
    return jax.vmap(lambda ab, ib: ab[ib])(a, idx)


def _dsa_prompt(q, k, v, iq, iw, ik):
    n_b, n_t = q.shape[:2]
    n_sel = min(TOPK_MAX, n_t // 4)
    n_blk = n_t // Q_BLOCK
    kpos = jnp.arange(n_t)

    def block(i):
        t0 = i * Q_BLOCK
        qb = lax.dynamic_slice_in_dim(q, t0, Q_BLOCK, axis=1)
        iqb = lax.dynamic_slice_in_dim(iq, t0, Q_BLOCK, axis=1)
        iwb = lax.dynamic_slice_in_dim(iw, t0, Q_BLOCK, axis=1)
        qpos = t0 + jnp.arange(Q_BLOCK)
        sc = _indexer_scores(iqb, iwb, ik)
        sc = jnp.where(kpos[None, None, :] <= qpos[None, :, None], sc, -jnp.inf)
        _, sel = lax.top_k(sc, n_sel)
        valid = sel <= qpos[None, :, None]
        return _sparse_attend(qb, _take_rows(k, sel), _take_rows(v, sel), valid)

    out = lax.map(block, jnp.arange(n_blk))
    return jnp.moveaxis(out, 0, 1).reshape(n_b, n_t, H_A, DH_A)


def _dsa_sample(q, k_new, v_new, iq, iw, ik_new, cache_k, cache_v, cache_idx_k, page_table):
    n_b, n_t = q.shape[:2]
    past = page_table.shape[1] * PAGE_SIZE
    n_keys = past + n_t
    n_sel = min(TOPK_MAX, n_keys // 4)
    ik_past = cache_idx_k[page_table].reshape(n_b, past, D_IDX)
    ik_all = jnp.concatenate([ik_past.astype(ik_new.dtype), ik_new], axis=1)
    qpos = past + jnp.arange(n_t)
    kpos = jnp.arange(n_keys)
    sc = _indexer_scores(iq, iw, ik_all)
    sc = jnp.where(kpos[None, None, :] <= qpos[None, :, None], sc, -jnp.inf)
    _, sel = lax.top_k(sc, n_sel)
    valid = sel <= qpos[None, :, None]
    sel_past = jnp.minimum(sel, past - 1)
    phys = (page_table[jnp.arange(n_b)[:, None, None], sel_past // PAGE_SIZE] * PAGE_SIZE
            + sel_past % PAGE_SIZE)
    pool_k = cache_k.reshape(-1, H_A, DH_A)
    pool_v = cache_v.reshape(-1, H_A, DH_A)
    sel_new = jnp.clip(sel - past, 0, n_t - 1)
    is_new = (sel >= past)[..., None, None]
    k_sel = jnp.where(is_new, _take_rows(k_new, sel_new), pool_k[phys].astype(k_new.dtype))
    v_sel = jnp.where(is_new, _take_rows(v_new, sel_new), pool_v[phys].astype(v_new.dtype))
    return _sparse_attend(q, k_sel, v_sel, valid)


def _hgrn2(bq, bf, bi, lb, s0, chunk):
    n_b, n_t, _ = bq.shape
    q = jax.nn.silu(bq.astype(jnp.float32)).reshape(n_b, n_t, H_B, DK_B)
    f = lb + (1.0 - lb) * jax.nn.sigmoid(bf.astype(jnp.float32))
    log_f = jnp.log(f).reshape(n_b, n_t, H_B, DK_B)
    kk = (1.0 - f).reshape(n_b, n_t, H_B, DK_B)
    v = bi.astype(jnp.float32).reshape(n_b, n_t, H_B, DV_B)
    n_c = n_t // chunk
    tri = jnp.tril(jnp.ones((chunk, chunk), dtype=bool))

    def resh(a):
        return jnp.moveaxis(a.reshape(n_b, n_c, chunk, H_B, a.shape[-1]), 1, 0)

    def step(S, inp):
        qc, gc, kc, vc = inp
        G = jnp.cumsum(gc, axis=1)
        diff = G[:, :, None] - G[:, None, :]
        dec = jnp.exp(jnp.where(tri[None, :, :, None, None], diff, -jnp.inf))
        A = jnp.einsum('bthd,btshd->bhts', qc, kc[:, None] * dec)
        o = (jnp.einsum('bhts,bshv->bthv', A, vc)
             + jnp.einsum('bthd,bhdv->bthv', qc * jnp.exp(G), S))
        G_last = G[:, -1]
        k_dec = kc * jnp.exp(G_last[:, None] - G)
        S_new = jnp.exp(G_last)[..., None] * S + jnp.einsum('bshd,bshv->bhdv', k_dec, vc)
        return S_new, o

    S, o = lax.scan(step, s0.astype(jnp.float32), (resh(q), resh(log_f), resh(kk), resh(v)))
    return jnp.moveaxis(o, 0, 1).reshape(n_b, n_t, H_B, DV_B), S


def _mem_attend(q, mk, mv):
    s = jnp.einsum('bthd,bnhd->bhtn', q.astype(jnp.float32), mk.astype(jnp.float32)) * (DH_M ** -0.5)
    p = jax.nn.softmax(s, axis=-1)
    return jnp.einsum('bhtn,bnhd->bthd', p, mv.astype(jnp.float32))


def _merge(h, a_out, ag, b_o, bg, m_out, mg, norm_g, w_out, ln_g, ln_b):
    n_b, n_t, _ = h.shape
    a = a_out.reshape(n_b, n_t, W_A) * jax.nn.silu(ag.astype(jnp.float32))
    bn = b_o * lax.rsqrt(jnp.mean(b_o * b_o, axis=-1, keepdims=True) + RMS_EPS) * norm_g.astype(jnp.float32)
    b = bn.reshape(n_b, n_t, W_B) * jax.nn.silu(bg.astype(jnp.float32))
    m = m_out.reshape(n_b, n_t, W_M) * jax.nn.silu(mg.astype(jnp.float32))
    cat = jnp.concatenate([a, b, m], axis=-1).astype(h.dtype)
    y = jnp.einsum('btn,nd->btd', cat, w_out)
    return _layernorm(ALPHA * h + y, ln_g, ln_b)


def setup_inputs(seed: int = 0) -> dict:
    key = jax.random.key(seed)
    ks = jax.random.split(key, 20)
    n_pages = PAST_LEN // PAGE_SIZE
    n_phys = (DEC_BATCH * n_pages * 5 + 3) // 4
    nrm = jax.random.normal
    x_prompt = nrm(ks[0], (BATCH, SEQ, D_MODEL), jnp.float32)
    x_sample = nrm(ks[1], (DEC_BATCH, DEC_SEQ, D_MODEL), jnp.float32)
    mem_prompt = nrm(ks[2], (BATCH, N_MEM, D_MODEL), jnp.float32)
    cache_k = nrm(ks[3], (DEPTH, n_phys, PAGE_SIZE, H_A, DH_A), jnp.float32)
    cache_v = nrm(ks[4], (DEPTH, n_phys, PAGE_SIZE, H_A, DH_A), jnp.float32)
    cache_idx_k = nrm(ks[5], (DEPTH, n_phys, PAGE_SIZE, D_IDX), jnp.float32)
    state_hgrn = 0.5 * nrm(ks[6], (DEPTH, DEC_BATCH, H_B, DK_B, DV_B), jnp.float32)
    cache_mem_k = nrm(ks[7], (DEPTH, DEC_BATCH, N_MEM, H_M, DH_M), jnp.float32)
    cache_mem_v = nrm(ks[8], (DEPTH, DEC_BATCH, N_MEM, H_M, DH_M), jnp.float32)
    page_table = jax.random.permutation(ks[9], n_phys)[:DEC_BATCH * n_pages].reshape(
        DEC_BATCH, n_pages).astype(jnp.int32)
    off = np.concatenate([[0], np.cumsum(IN_SPLITS)])
    col_scale = np.ones((N_IN,), np.float32)
    col_scale[off[2]:off[3]] = BETA
    col_scale[off[9]:off[10]] = BETA
    w_in = nrm(ks[10], (DEPTH, D_MODEL, N_IN), jnp.float32) * (D_MODEL ** -0.5) * jnp.asarray(col_scale)
    lb_logits = 0.1 * nrm(ks[11], (DEPTH + 1, H_B * DK_B), jnp.float32)
    hgrn_norm_g = 1.0 + 0.02 * nrm(ks[12], (DEPTH, DV_B), jnp.float32)
    w_mem_k = nrm(ks[13], (DEPTH, D_MODEL, W_M), jnp.float32) * (D_MODEL ** -0.5)
    w_mem_v = nrm(ks[14], (DEPTH, D_MODEL, W_M), jnp.float32) * (D_MODEL ** -0.5) * BETA
    w_out = nrm(ks[15], (DEPTH, D_MODEL, D_MODEL), jnp.float32) * (D_MODEL ** -0.5) * BETA
    ln_g = 1.0 + 0.02 * nrm(ks[16], (DEPTH, D_MODEL), jnp.float32)
    ln_b = 0.02 * nrm(ks[17], (DEPTH, D_MODEL), jnp.float32)
    return {"x_prompt": x_prompt, "x_sample": x_sample, "mem_prompt": mem_prompt,
            "cache_k": cache_k, "cache_v": cache_v, "cache_idx_k": cache_idx_k,
            "state_hgrn": state_hgrn, "cache_mem_k": cache_mem_k, "cache_mem_v": cache_mem_v,
            "page_table": page_table, "w_in": w_in, "lb_logits": lb_logits,
            "hgrn_norm_g": hgrn_norm_g, "w_mem_k": w_mem_k, "w_mem_v": w_mem_v,
            "w_out": w_out, "ln_g": ln_g, "ln_b": ln_b}


def reference(x_prompt, x_sample, mem_prompt, cache_k, cache_v, cache_idx_k, state_hgrn,
              cache_mem_k, cache_mem_v, page_table, w_in, lb_logits, hgrn_norm_g,
              w_mem_k, w_mem_v, w_out, ln_g, ln_b):
    lb_all = jnp.cumsum(jax.nn.softmax(lb_logits.astype(jnp.float32), axis=0), axis=0)
    n_bp, t_p, _ = x_prompt.shape
    n_bs, t_s, _ = x_sample.shape
    past = page_table.shape[1] * PAGE_SIZE
    pos_p = jnp.arange(t_p, dtype=jnp.int32)
    pos_s = past + jnp.arange(t_s, dtype=jnp.int32)
    hp, hs = x_prompt, x_sample
    kp_l, vp_l, ikp_l, sp_l, mkp_l, mvp_l = [], [], [], [], [], []
    ks_l, vs_l, iks_l, ss_l = [], [], [], []
    for l in range(DEPTH):
        lb = lb_all[l]
        aq, ak, av, ag, iq, ik, iw, bq, bf, bi, bg, mq, mg = _in_proj(hp, w_in[l], pos_p)
        a_out = _dsa_prompt(aq, ak, av, iq, iw, ik)
        s0 = jnp.zeros((n_bp, H_B, DK_B, DV_B), jnp.float32)
        b_o, s_p = _hgrn2(bq, bf, bi, lb, s0, min(HGRN_CHUNK, t_p))
        mk = jnp.einsum('bnd,dm->bnm', mem_prompt, w_mem_k[l]).reshape(n_bp, N_MEM, H_M, DH_M)
        mv = jnp.einsum('bnd,dm->bnm', mem_prompt, w_mem_v[l]).reshape(n_bp, N_MEM, H_M, DH_M)
        m_out = _mem_attend(mq, mk, mv)
        hp_next = _merge(hp, a_out, ag, b_o, bg, m_out, mg, hgrn_norm_g[l], w_out[l], ln_g[l], ln_b[l])
        kp_l.append(ak); vp_l.append(av); ikp_l.append(ik); sp_l.append(s_p)
        mkp_l.append(mk); mvp_l.append(mv)
        aq, ak, av, ag, iq, ik, iw, bq, bf, bi, bg, mq, mg = _in_proj(hs, w_in[l], pos_s)
        a_out = _dsa_sample(aq, ak, av, iq, iw, ik, cache_k[l], cache_v[l], cache_idx_k[l], page_table)
        b_o, s_s = _hgrn2(bq, bf, bi, lb, state_hgrn[l], t_s)
        m_out = _mem_attend(mq, cache_mem_k[l], cache_mem_v[l])
        hs_next = _merge(hs, a_out, ag, b_o, bg, m_out, mg, hgrn_norm_g[l], w_out[l], ln_g[l], ln_b[l])
        ks_l.append(ak); vs_l.append(av); iks_l.append(ik); ss_l.append(s_s)
        hp, hs = hp_next, hs_next
    return (hp, hs, jnp.stack(kp_l), jnp.stack(vp_l), jnp.stack(ikp_l), jnp.stack(sp_l),
            jnp.stack(mkp_l), jnp.stack(mvp_l), jnp.stack(ks_l), jnp.stack(vs_l),
            jnp.stack(iks_l), jnp.stack(ss_l))
```

```cpp
#include <hip/hip_runtime.h>
#include <stdint.h>
#include <math.h>

constexpr int DM = 2048, NB = 4, T = 2048, SB = 8, ST = 8, PAST = 16384, PAGE = 128, NPAGES = PAST / PAGE;
constexpr int HA = 8, DH = 128, WA = 1024, HI = 16, DI = 64, HB = 4, DK = 128, DV = 128, WB = 512, HM = 4, WM = 512, NMEM = 256;
constexpr int NIN = 8272, TOPK = 256;
constexpr int MP = NB * T, MS = SB * ST, MR = MP + MS;
constexpr int NKEYS_S = PAST + ST;
constexpr int C_AQ = 0, C_AK = 1024, C_AV = 2048, C_AG = 3072, C_IQ = 4096, C_IK = 5120, C_IW = 5184, C_BQ = 5200, C_BF = 5712, C_BI = 6224, C_BG = 6736, C_MQ = 7248, C_MG = 7760;
constexpr float ALPHA = 1.189207115002721f, LN_EPS = 1e-5f, RMS_EPS = 1e-6f;
constexpr size_t O_YP = 0, O_YS = O_YP + (size_t)MP * DM, O_KP = O_YS + (size_t)MS * DM, O_VP = O_KP + (size_t)MP * WA, O_IKP = O_VP + (size_t)MP * WA,
                 O_HP = O_IKP + (size_t)MP * DI, O_MKP = O_HP + (size_t)NB * HB * DK * DV, O_MVP = O_MKP + (size_t)NB * NMEM * WM, O_KS = O_MVP + (size_t)NB * NMEM * WM,
                 O_VS = O_KS + (size_t)MS * WA, O_IKS = O_VS + (size_t)MS * WA, O_HS = O_IKS + (size_t)MS * DI, O_END = O_HS + (size_t)SB * HB * DK * DV;

__device__ __forceinline__ float silu_f(float x) { return x / (1.f + expf(-x)); }
__device__ __forceinline__ float sigmoid_f(float x) { return 1.f / (1.f + expf(-x)); }

__global__ void __launch_bounds__(256) gemm_nn(const float* __restrict__ A, const float* __restrict__ B, float* __restrict__ C, int M, int N, int K, int lda, int ldb, int ldc) {
    __shared__ float As[16][64 + 4];
    __shared__ float Bs[16][64 + 4];
    const int tid = threadIdx.x, tx = tid & 15, ty = tid >> 4;
    const int m0 = blockIdx.y * 64, n0 = blockIdx.x * 64;
    float acc[4][4] = {};
    for (int k0 = 0; k0 < K; k0 += 16) {
        for (int i = tid; i < 64 * 16; i += 256) { const int r = i >> 4, c = i & 15; As[c][r] = A[(size_t)(m0 + r) * lda + k0 + c]; }
        for (int i = tid; i < 16 * 64; i += 256) { const int r = i >> 6, c = i & 63; Bs[r][c] = (n0 + c < N) ? B[(size_t)(k0 + r) * ldb + n0 + c] : 0.f; }
        __syncthreads();
#pragma unroll
        for (int kk = 0; kk < 16; ++kk) {
            float a[4], b[4];
#pragma unroll
            for (int i = 0; i < 4; ++i) { a[i] = As[kk][ty * 4 + i]; b[i] = Bs[kk][tx * 4 + i]; }
#pragma unroll
            for (int i = 0; i < 4; ++i)
#pragma unroll
                for (int j = 0; j < 4; ++j) acc[i][j] = fmaf(a[i], b[j], acc[i][j]);
        }
        __syncthreads();
    }
#pragma unroll
    for (int i = 0; i < 4; ++i)
#pragma unroll
        for (int j = 0; j < 4; ++j) { const int n = n0 + tx * 4 + j; if (n < N) C[(size_t)(m0 + ty * 4 + i) * ldc + n] = acc[i][j]; }
}

__device__ __forceinline__ int row_pos(int row) { return row < MP ? (row % T) : (PAST + ((row - MP) % ST)); }
__device__ __forceinline__ void rope_cs(int pos, int j, int half, float& c, float& s) {
    const float inv = exp2f(-(float)j / (float)half * 18.931568569324174f);
    const float ang = (float)pos * inv;
    const float k = rintf(ang * 0.15915494309189535f);
    float r = fmaf(-k, 6.2831854820251465f, ang);
    r = fmaf(-k, -1.7484555e-7f, r);
    c = cosf(r); s = sinf(r);
}
__device__ __forceinline__ void rope_pair(float x1, float x2, int pos, int j, int half, float& o1, float& o2) {
    float c, s; rope_cs(pos, j, half, c, s);
    o1 = x1 * c - x2 * s; o2 = x2 * c + x1 * s;
}
__global__ void __launch_bounds__(256) post_rows(const float* __restrict__ Z, float* __restrict__ Qr, float* __restrict__ IQr, float* __restrict__ out) {
    const int row = blockIdx.x, pos = row_pos(row);
    const float* z = Z + (size_t)row * NIN;
    float* kout = row < MP ? out + O_KP + (size_t)row * WA : out + O_KS + (size_t)(row - MP) * WA;
    float* vout = row < MP ? out + O_VP + (size_t)row * WA : out + O_VS + (size_t)(row - MP) * WA;
    float* ikout = row < MP ? out + O_IKP + (size_t)row * DI : out + O_IKS + (size_t)(row - MP) * DI;
    for (int c = threadIdx.x; c < WA; c += 256) {
        const int d = c & 127;
        float q = z[C_AQ + c], k = z[C_AK + c];
        if (d < 32) {
            const int j = d & 15; const bool lo = d < 16; const int c1 = lo ? c : c - 16, c2 = c1 + 16;
            float o1, o2; rope_pair(z[C_AQ + c1], z[C_AQ + c2], pos, j, 16, o1, o2); q = lo ? o1 : o2;
            rope_pair(z[C_AK + c1], z[C_AK + c2], pos, j, 16, o1, o2); k = lo ? o1 : o2;
        }
        Qr[(size_t)row * WA + c] = q; kout[c] = k; vout[c] = z[C_AV + c];
        const int di = c & 63;
        float iq = z[C_IQ + c];
        if (di < 16) { const int j = di & 7; const bool lo = di < 8; const int c1 = lo ? c : c - 8, c2 = c1 + 8; float o1, o2; rope_pair(z[C_IQ + c1], z[C_IQ + c2], pos, j, 8, o1, o2); iq = lo ? o1 : o2; }
        IQr[(size_t)row * WA + c] = iq;
    }
    for (int c = threadIdx.x; c < DI; c += 256) {
        float ik = z[C_IK + c];
        if (c < 16) { const int j = c & 7; const bool lo = c < 8; const int c1 = lo ? c : c - 8, c2 = c1 + 8; float o1, o2; rope_pair(z[C_IK + c1], z[C_IK + c2], pos, j, 8, o1, o2); ik = lo ? o1 : o2; }
        ikout[c] = ik;
    }
}

__device__ __forceinline__ const float* idx_key_row(int row, int s, const float* out, const float* cache_idx_k, const int* page_table) {
    if (row < MP) { const int b = row / T; return out + O_IKP + (size_t)(b * T + s) * DI; }
    const int b = (row - MP) / ST;
    if (s >= PAST) return out + O_IKS + (size_t)(b * ST + (s - PAST)) * DI;
    const int pg = page_table[b * NPAGES + s / PAGE];
    return cache_idx_k + ((size_t)pg * PAGE + (s % PAGE)) * DI;
}
__global__ void __launch_bounds__(256) idx_scores(const float* __restrict__ Z, const float* __restrict__ IQr, const float* out, const float* __restrict__ cache_idx_k, const int* __restrict__ page_table,
                                                   float* __restrict__ SC, int row0, int ldsc) {
    __shared__ float q[HI * DI];
    __shared__ float w[HI];
    const int row = row0 + blockIdx.y;
    const int nk = row < MP ? (row % T) + 1 : PAST + ((row - MP) % ST) + 1;
    for (int i = threadIdx.x; i < HI * DI; i += 256) q[i] = IQr[(size_t)row * WA + i];
    if (threadIdx.x < HI) w[threadIdx.x] = Z[(size_t)row * NIN + C_IW + threadIdx.x] * 0.25f;
    __syncthreads();
    const int s = blockIdx.x * 256 + threadIdx.x;
    if (s >= nk) return;
    const float4* kr = (const float4*)idx_key_row(row, s, out, cache_idx_k, page_table);
    float acc = 0.f;
    for (int h = 0; h < HI; ++h) {
        float dot = 0.f;
#pragma unroll
        for (int d4 = 0; d4 < DI / 4; ++d4) { const float4 kv = kr[d4]; const float* qq = q + h * DI + d4 * 4;
            dot = fmaf(qq[0], kv.x, dot); dot = fmaf(qq[1], kv.y, dot); dot = fmaf(qq[2], kv.z, dot); dot = fmaf(qq[3], kv.w, dot); }
        dot *= 0.125f;
        acc += w[h] * fmaxf(dot, 0.f);
    }
    SC[(size_t)blockIdx.y * ldsc + s] = acc;
}
__global__ void __launch_bounds__(256) idx_select(const float* __restrict__ SC, int* __restrict__ sel, int row0, int ldsc) {
    __shared__ float tile[1024];
    const int row = row0 + blockIdx.y;
    const int nk = row < MP ? (row % T) + 1 : PAST + ((row - MP) % ST) + 1;
    const float* sc = SC + (size_t)blockIdx.y * ldsc;
    const int s = blockIdx.x * 256 + threadIdx.x;
    if (blockIdx.x * 256 >= nk) return;
    const float mine = s < nk ? sc[s] : 0.f;
    int rank = 0;
    for (int t0 = 0; t0 < nk; t0 += 1024) {
        __syncthreads();
        for (int i = threadIdx.x; i < 1024; i += 256) tile[i] = (t0 + i < nk) ? sc[t0 + i] : -INFINITY;
        __syncthreads();
        const int lim = min(1024, nk - t0);
        for (int i = 0; i < lim; ++i) { const float o = tile[i]; rank += (o > mine || (o == mine && (t0 + i) < s)) ? 1 : 0; }
    }
    if (s < nk && rank < TOPK) sel[(size_t)row * TOPK + rank] = s;
}

__device__ __forceinline__ const float* kv_row(int row, int s, int h, bool isv, const float* out, const float* cache_k, const float* cache_v, const int* page_table) {
    if (row < MP) { const int b = row / T; return out + (isv ? O_VP : O_KP) + (size_t)(b * T + s) * WA + h * DH; }
    const int b = (row - MP) / ST;
    if (s >= PAST) return out + (isv ? O_VS : O_KS) + (size_t)(b * ST + (s - PAST)) * WA + h * DH;
    const int pg = page_table[b * NPAGES + s / PAGE];
    return (isv ? cache_v : cache_k) + ((size_t)pg * PAGE + (s % PAGE)) * WA + h * DH;
}
__global__ void __launch_bounds__(256) sparse_attn(const float* __restrict__ Qr, const int* __restrict__ sel, const float* out, const float* __restrict__ cache_k, const float* __restrict__ cache_v,
                                                    const int* __restrict__ page_table, float* __restrict__ a_out, int row0) {
    __shared__ float q[WA];
    __shared__ float p[HA][TOPK];
    __shared__ int sl[TOPK];
    const int row = row0 + blockIdx.x, tid = threadIdx.x, h = tid >> 5, l = tid & 31;
    const int nk = row < MP ? (row % T) + 1 : PAST + ((row - MP) % ST) + 1;
    const int ns = nk < TOPK ? nk : TOPK;
    for (int i = tid; i < WA; i += 256) q[i] = Qr[(size_t)row * WA + i];
    for (int i = tid; i < ns; i += 256) sl[i] = sel[(size_t)row * TOPK + i];
    __syncthreads();
    float mx = -INFINITY;
    for (int j = l; j < ns; j += 32) {
        const float4* kr = (const float4*)kv_row(row, sl[j], h, false, out, cache_k, cache_v, page_table);
        float dot = 0.f;
        for (int d4 = 0; d4 < DH / 4; ++d4) { const float4 kv = kr[d4]; const float* qq = q + h * DH + d4 * 4;
            dot = fmaf(qq[0], kv.x, dot); dot = fmaf(qq[1], kv.y, dot); dot = fmaf(qq[2], kv.z, dot); dot = fmaf(qq[3], kv.w, dot); }
        dot *= 0.08838834764831845f;
        p[h][j] = dot; mx = fmaxf(mx, dot);
    }
    for (int o = 16; o >= 1; o >>= 1) mx = fmaxf(mx, __shfl_xor(mx, o));
    float sum = 0.f;
    for (int j = l; j < ns; j += 32) { const float e = expf(p[h][j] - mx); p[h][j] = e; sum += e; }
    for (int o = 16; o >= 1; o >>= 1) sum += __shfl_xor(sum, o);
    __syncthreads();
    float4 acc = make_float4(0.f, 0.f, 0.f, 0.f);
    for (int j = 0; j < ns; ++j) {
        const float4 vr = *((const float4*)kv_row(row, sl[j], h, true, out, cache_k, cache_v, page_table) + l);
        const float pj = p[h][j];
        acc.x = fmaf(pj, vr.x, acc.x); acc.y = fmaf(pj, vr.y, acc.y); acc.z = fmaf(pj, vr.z, acc.z); acc.w = fmaf(pj, vr.w, acc.w);
    }
    const float inv = 1.f / sum;
    *((float4*)(a_out + (size_t)row * WA + h * DH) + l) = make_float4(acc.x * inv, acc.y * inv, acc.z * inv, acc.w * inv);
}

__global__ void __launch_bounds__(256) hgrn_seq(const float* __restrict__ Z, const float* __restrict__ lb_logits, const float* __restrict__ s0, float* __restrict__ s_out, float* __restrict__ b_o,
                                                int row_base, int nt) {
    __shared__ float qs[DK], fs[DK], ks[DK], vs[64], red[4][64];
    const int b = blockIdx.x / (HB * 2), hd = (blockIdx.x / 2) % HB, vh = blockIdx.x & 1;
    const int tid = threadIdx.x, vl = tid & 63, dp = tid >> 6, v = vh * 64 + vl;
    float S[32];
#pragma unroll
    for (int i = 0; i < 32; ++i) S[i] = s0 ? s0[(((size_t)b * HB + hd) * DK + dp * 32 + i) * DV + v] : 0.f;
    float lbv = 0.f;
    if (tid < DK) { const float l0 = lb_logits[hd * DK + tid], l1 = lb_logits[HB * DK + hd * DK + tid]; const float m = fmaxf(l0, l1); const float e0 = expf(l0 - m), e1 = expf(l1 - m); lbv = e0 / (e0 + e1); }
    for (int t = 0; t < nt; ++t) {
        const float* z = Z + (size_t)(row_base + b * nt + t) * NIN;
        __syncthreads();
        if (tid < DK) { qs[tid] = silu_f(z[C_BQ + hd * DK + tid]); const float f = lbv + (1.f - lbv) * sigmoid_f(z[C_BF + hd * DK + tid]); fs[tid] = f; ks[tid] = 1.f - f; }
        else if (tid < DK + 64) vs[tid - DK] = z[C_BI + hd * DV + vh * 64 + (tid - DK)];
        __syncthreads();
        const float vv = vs[vl]; float o = 0.f;
#pragma unroll
        for (int i = 0; i < 32; ++i) { const int d = dp * 32 + i; S[i] = fs[d] * S[i] + ks[d] * vv; o = fmaf(qs[d], S[i], o); }
        red[dp][vl] = o;
        __syncthreads();
        if (dp == 0) b_o[(size_t)(row_base + b * nt + t) * WB + hd * DV + v] = (red[0][vl] + red[1][vl]) + (red[2][vl] + red[3][vl]);
    }
#pragma unroll
    for (int i = 0; i < 32; ++i) s_out[(((size_t)b * HB + hd) * DK + dp * 32 + i) * DV + v] = S[i];
}

__global__ void __launch_bounds__(256) mem_attn(const float* __restrict__ Z, const float* __restrict__ mk, const float* __restrict__ mv, float* __restrict__ m_out, int row0, int rows_per_batch) {
    __shared__ float q[WM];
    __shared__ float p[HM][NMEM];
    const int row = row0 + blockIdx.x, b = blockIdx.x / rows_per_batch, tid = threadIdx.x, h = tid >> 6, l = tid & 63;
    for (int i = tid; i < WM; i += 256) q[i] = Z[(size_t)row * NIN + C_MQ + i];
    __syncthreads();
    float mx = -INFINITY;
    for (int n = l; n < NMEM; n += 64) {
        const float4* kr = (const float4*)(mk + ((size_t)(b * NMEM + n) * HM + h) * DH);
        float dot = 0.f;
        for (int d4 = 0; d4 < DH / 4; ++d4) { const float4 kv = kr[d4]; const float* qq = q + h * DH + d4 * 4;
            dot = fmaf(qq[0], kv.x, dot); dot = fmaf(qq[1], kv.y, dot); dot = fmaf(qq[2], kv.z, dot); dot = fmaf(qq[3], kv.w, dot); }
        dot *= 0.08838834764831845f; p[h][n] = dot; mx = fmaxf(mx, dot);
    }
    for (int o = 32; o >= 1; o >>= 1) mx = fmaxf(mx, __shfl_xor(mx, o));
    float sum = 0.f;
    for (int n = l; n < NMEM; n += 64) { const float e = expf(p[h][n] - mx); p[h][n] = e; sum += e; }
    for (int o = 32; o >= 1; o >>= 1) sum += __shfl_xor(sum, o);
    __syncthreads();
    float a0 = 0.f, a1 = 0.f;
    for (int n = 0; n < NMEM; ++n) { const float* vr = mv + ((size_t)(b * NMEM + n) * HM + h) * DH + l * 2; const float pn = p[h][n]; a0 = fmaf(pn, vr[0], a0); a1 = fmaf(pn, vr[1], a1); }
    const float inv = 1.f / sum;
    m_out[(size_t)row * WM + h * DH + l * 2] = a0 * inv; m_out[(size_t)row * WM + h * DH + l * 2 + 1] = a1 * inv;
}

__global__ void __launch_bounds__(256) merge_rows(const float* __restrict__ Z, const float* __restrict__ a_out, const float* __restrict__ b_o, const float* __restrict__ m_out, const float* __restrict__ norm_g,
                                                   float* __restrict__ cat) {
    __shared__ float ssq[HB];
    const int row = blockIdx.x, tid = threadIdx.x;
    const float* z = Z + (size_t)row * NIN;
    { const int h = tid >> 6, l = tid & 63; const float x0 = b_o[(size_t)row * WB + h * DV + l], x1 = b_o[(size_t)row * WB + h * DV + 64 + l]; float s = x0 * x0 + x1 * x1;
      for (int o = 32; o >= 1; o >>= 1) s += __shfl_xor(s, o);
      if (l == 0) ssq[h] = s; }
    __syncthreads();
    for (int c = tid; c < WA; c += 256) cat[(size_t)row * DM + c] = a_out[(size_t)row * WA + c] * silu_f(z[C_AG + c]);
    for (int c = tid; c < WB; c += 256) { const int h = c >> 7; const float r = rsqrtf(ssq[h] * (1.f / DV) + RMS_EPS);
        cat[(size_t)row * DM + WA + c] = b_o[(size_t)row * WB + c] * r * norm_g[c & 127] * silu_f(z[C_BG + c]); }
    for (int c = tid; c < WM; c += 256) cat[(size_t)row * DM + WA + WB + c] = m_out[(size_t)row * WM + c] * silu_f(z[C_MG + c]);
}

__global__ void __launch_bounds__(256) ln_rows(const float* __restrict__ xp, const float* __restrict__ xs, const float* __restrict__ Y, const float* __restrict__ g, const float* __restrict__ bta, float* __restrict__ out) {
    __shared__ float red[8];
    const int row = blockIdx.x, tid = threadIdx.x;
    const float* x = row < MP ? xp + (size_t)row * DM : xs + (size_t)(row - MP) * DM;
    float* o = row < MP ? out + O_YP + (size_t)row * DM : out + O_YS + (size_t)(row - MP) * DM;
    float v[8]; float s = 0.f;
#pragma unroll
    for (int i = 0; i < 8; ++i) { const int c = tid + 256 * i; v[i] = ALPHA * x[c] + Y[(size_t)row * DM + c]; s += v[i]; }
    for (int of = 32; of >= 1; of >>= 1) s += __shfl_xor(s, of);
    if ((tid & 63) == 0) red[tid >> 6] = s;
    __syncthreads();
    const float mean = (red[0] + red[1] + red[2] + red[3]) * (1.f / DM);
    float q = 0.f;
#pragma unroll
    for (int i = 0; i < 8; ++i) { v[i] -= mean; q += v[i] * v[i]; }
    for (int of = 32; of >= 1; of >>= 1) q += __shfl_xor(q, of);
    if ((tid & 63) == 0) red[4 + (tid >> 6)] = q;
    __syncthreads();
    const float rstd = rsqrtf((red[4] + red[5] + red[6] + red[7]) * (1.f / DM) + LN_EPS);
#pragma unroll
    for (int i = 0; i < 8; ++i) { const int c = tid + 256 * i; o[c] = v[i] * rstd * g[c] + bta[c]; }
}

extern "C" void kernel_launch(void* const* d_in, const int* in_sizes, int n_in, void* d_out, int out_size, void* d_ws, size_t ws_size, hipStream_t stream) {
    const float* x_prompt = (const float*)d_in[0]; const float* x_sample = (const float*)d_in[1]; const float* mem_prompt = (const float*)d_in[2];
    const float* cache_k = (const float*)d_in[3]; const float* cache_v = (const float*)d_in[4]; const float* cache_idx_k = (const float*)d_in[5];
    const float* state_hgrn = (const float*)d_in[6]; const float* cache_mem_k = (const float*)d_in[7]; const float* cache_mem_v = (const float*)d_in[8];
    const int* page_table = (const int*)d_in[9]; const float* w_in = (const float*)d_in[10]; const float* lb_logits = (const float*)d_in[11];
    const float* norm_g = (const float*)d_in[12]; const float* w_mem_k = (const float*)d_in[13]; const float* w_mem_v = (const float*)d_in[14];
    const float* w_out = (const float*)d_in[15]; const float* ln_g = (const float*)d_in[16]; const float* ln_b = (const float*)d_in[17];
    float* out = (float*)d_out;
    float* ws = (float*)d_ws;
    size_t o = 0;
    float* Z = ws + o; o += (size_t)MR * NIN;
    float* Qr = ws + o; o += (size_t)MR * WA;
    float* IQr = ws + o; o += (size_t)MR * WA;
    int* sel = (int*)(ws + o); o += (size_t)MR * TOPK;
    float* a_out = ws + o; o += (size_t)MR * WA;
    float* b_o = ws + o; o += (size_t)MR * WB;
    float* m_out = ws + o; o += (size_t)MR * WM;
    float* cat = ws + o; o += (size_t)MR * DM;
    float* Y = ws + o; o += (size_t)MR * DM;
    float* SC = ws + o; o += (size_t)64 * 16400;

    gemm_nn<<<dim3((NIN + 63) / 64, MP / 64), 256, 0, stream>>>(x_prompt, w_in, Z, MP, NIN, DM, DM, NIN, NIN);
    gemm_nn<<<dim3((NIN + 63) / 64, MS / 64), 256, 0, stream>>>(x_sample, w_in, Z + (size_t)MP * NIN, MS, NIN, DM, DM, NIN, NIN);
    gemm_nn<<<dim3(WM / 64, NB * NMEM / 64), 256, 0, stream>>>(mem_prompt, w_mem_k, out + O_MKP, NB * NMEM, WM, DM, DM, WM, WM);
    gemm_nn<<<dim3(WM / 64, NB * NMEM / 64), 256, 0, stream>>>(mem_prompt, w_mem_v, out + O_MVP, NB * NMEM, WM, DM, DM, WM, WM);
    post_rows<<<MR, 256, 0, stream>>>(Z, Qr, IQr, out);
    for (int r0 = 0; r0 < MP; r0 += 64) {
        const int tmax = (r0 % T) + 64;
        idx_scores<<<dim3((tmax + 255) / 256, 64), 256, 0, stream>>>(Z, IQr, out, cache_idx_k, page_table, SC, r0, 16400);
        idx_select<<<dim3((tmax + 255) / 256, 64), 256, 0, stream>>>(SC, sel, r0, 16400);
    }
    idx_scores<<<dim3((NKEYS_S + 255) / 256, 64), 256, 0, stream>>>(Z, IQr, out, cache_idx_k, page_table, SC, MP, 16400);
    idx_select<<<dim3((NKEYS_S + 255) / 256, 64), 256, 0, stream>>>(SC, sel, MP, 16400);
    sparse_attn<<<MR, 256, 0, stream>>>(Qr, sel, out, cache_k, cache_v, page_table, a_out, 0);
    hgrn_seq<<<NB * HB * 2, 256, 0, stream>>>(Z, lb_logits, nullptr, out + O_HP, b_o, 0, T);
    hgrn_seq<<<SB * HB * 2, 256, 0, stream>>>(Z, lb_logits, state_hgrn, out + O_HS, b_o, MP, ST);
    mem_attn<<<MP, 256, 0, stream>>>(Z, out + O_MKP, out + O_MVP, m_out, 0, T);
    mem_attn<<<MS, 256, 0, stream>>>(Z, cache_mem_k, cache_mem_v, m_out, MP, ST);
    merge_rows<<<MR, 256, 0, stream>>>(Z, a_out, b_o, m_out, norm_g, cat);
    gemm_nn<<<dim3(DM / 64, MR / 64), 256, 0, stream>>>(cat, w_out, Y, MR, DM, DM, DM, DM, DM);
    ln_rows<<<MR, 256, 0, stream>>>(x_prompt, x_sample, Y, ln_g, ln_b, out);
}
```

```cpp
#include <hip/hip_runtime.h>
#include <cstdio>
#include <cstdint>
#include <math.h>

#ifndef HYBRID
#define HYBRID 0
#endif
#ifndef PROBE
#define PROBE 0
#endif
#ifndef NLAUNCH
#define NLAUNCH 1
#endif

constexpr int DM = 2048, NB = 4, T = 2048, SB = 8, ST = 8, PAST = 16384, PAGE = 128, NPAGES = PAST / PAGE;
constexpr int HA = 8, DH = 128, WA = 1024, HI = 16, DI = 64, HB = 4, DK = 128, DV = 128, WB = 512, HM = 4, WM = 512, NMEM = 256;
constexpr int NIN = 8272, NMAIN = 8192, NIKW = 80, TOPK = 256;
constexpr int MP = NB * T, MS = SB * ST, MR = MP + MS;
constexpr int NKEYS_S = PAST + ST;
constexpr int C_AQ = 0, C_AK = 1024, C_AV = 2048, C_AG = 3072, C_IQ = 4096, C_IK = 5120, C_IW = 5184, C_BQ = 5200, C_BF = 5712, C_BI = 6224, C_BG = 6736, C_MQ = 7248, C_MG = 7760;
constexpr float ALPHA = 1.189207115002721f, LN_EPS = 1e-5f, RMS_EPS = 1e-6f;
constexpr float SM_SCALE = 0.08838834764831845f, LOG2E = 1.4426950408889634f;
constexpr int NPOS = T + ST;
constexpr size_t O_YP = 0, O_YS = O_YP + (size_t)MP * DM, O_KP = O_YS + (size_t)MS * DM, O_VP = O_KP + (size_t)MP * WA, O_IKP = O_VP + (size_t)MP * WA,
                 O_HP = O_IKP + (size_t)MP * DI, O_MKP = O_HP + (size_t)NB * HB * DK * DV, O_MVP = O_MKP + (size_t)NB * NMEM * WM, O_KS = O_MVP + (size_t)NB * NMEM * WM,
                 O_VS = O_KS + (size_t)MS * WA, O_IKS = O_VS + (size_t)MS * WA, O_HS = O_IKS + (size_t)MS * DI, O_END = O_HS + (size_t)SB * HB * DK * DV;

constexpr size_t al256(size_t x) { return (x + 255) & ~(size_t)255; }
constexpr size_t WS_CTL = 0, CTL_BYTES = 1u << 20;
constexpr size_t WS_XB = WS_CTL + CTL_BYTES;
constexpr size_t WS_WMAIN = WS_XB + al256((size_t)MR * DM * 2);
constexpr size_t WS_WIKW = WS_WMAIN + al256((size_t)NMAIN * DM * 2);
constexpr size_t WS_WOUT = WS_WIKW + al256((size_t)NIKW * DM * 2);
constexpr size_t WS_WMKV = WS_WOUT + al256((size_t)DM * DM * 2);
constexpr size_t WS_MEMB = WS_WMKV + al256((size_t)1024 * DM * 2);
constexpr size_t WS_ROPEA = WS_MEMB + al256((size_t)NB * NMEM * DM * 2);
constexpr size_t WS_ROPEI = WS_ROPEA + al256((size_t)NPOS * 16 * 8);
constexpr size_t WS_LB = WS_ROPEI + al256((size_t)NPOS * 8 * 8);
constexpr size_t WS_QB = WS_LB + al256(512 * 4);
constexpr size_t WS_KB = WS_QB + al256((size_t)MP * WA * 2);
constexpr size_t WS_VB = WS_KB + al256((size_t)MP * WA * 2);
constexpr size_t WS_GA = WS_VB + al256((size_t)MP * WA * 2);
constexpr size_t WS_IQB = WS_GA + al256((size_t)MP * WA * 2);
constexpr size_t WS_HQ = WS_IQB + al256((size_t)MP * WA * 2);
constexpr size_t WS_HG = WS_HQ + al256((size_t)MP * WB * 4);
constexpr size_t WS_HV = WS_HG + al256((size_t)MP * WB * 4);
constexpr size_t WS_GB = WS_HV + al256((size_t)MP * WB * 2);
constexpr size_t WS_MQB = WS_GB + al256((size_t)MP * WB * 2);
constexpr size_t WS_GM = WS_MQB + al256((size_t)MP * WM * 2);
constexpr size_t WS_IKB = WS_GM + al256((size_t)MP * WM * 2);
constexpr size_t WS_IW = WS_IKB + al256((size_t)MR * DI * 2);
constexpr size_t WS_MKB = WS_IW + al256((size_t)MR * HI * 4);
constexpr size_t WS_MVB = WS_MKB + al256((size_t)NB * NMEM * WM * 2);
constexpr size_t WS_ZS = WS_MVB + al256((size_t)NB * NMEM * WM * 2);
constexpr size_t WS_CATB = WS_ZS + al256((size_t)MS * NIN * 4);
constexpr size_t WS_MASK = WS_CATB + al256((size_t)MR * DM * 2);
constexpr int NCH = T / 64, NHU = NB * HB * NCH;
constexpr size_t WS_QABS = WS_MASK + al256((size_t)MP * 64 * 4);
constexpr size_t WS_OT = WS_QABS + al256((size_t)MP * WB * 2);
constexpr size_t WS_KVT = WS_OT + al256((size_t)NHU * 128 * 64 * 4);
constexpr size_t WS_EG = WS_KVT + al256((size_t)NHU * 128 * 128 * 4);
constexpr size_t WS_SCT = WS_EG + al256((size_t)NHU * 128 * 4);
constexpr int LDSC = 16400;
constexpr size_t WS_SCS = WS_SCT + al256((size_t)NHU * 128 * 128 * 2);
constexpr size_t WS_SELS = WS_SCS + al256((size_t)MS * LDSC * 4);
constexpr size_t WS_FAST_END = WS_SELS + al256((size_t)MS * TOPK * 4);
constexpr size_t WS_Z = WS_FAST_END;
constexpr size_t WS_QR = WS_Z + al256((size_t)MR * NIN * 4);
constexpr size_t WS_IQR = WS_QR + al256((size_t)MR * WA * 4);
constexpr size_t WS_SEL = WS_IQR + al256((size_t)MR * WA * 4);
constexpr size_t WS_AOUT = WS_SEL + al256((size_t)MR * TOPK * 4);
constexpr size_t WS_BO = WS_AOUT + al256((size_t)MR * WA * 4);
constexpr size_t WS_MO = WS_BO + al256((size_t)MR * WB * 4);
constexpr size_t WS_CAT = WS_MO + al256((size_t)MR * WM * 4);
constexpr size_t WS_Y = WS_CAT + al256((size_t)MR * DM * 4);
constexpr size_t WS_SC = WS_Y + al256((size_t)MR * DM * 4);
constexpr size_t WS_END = WS_SC + al256((size_t)64 * 16400 * 4);

__device__ __forceinline__ float silu_f(float x) { return x / (1.f + expf(-x)); }
__device__ __forceinline__ float sigmoid_f(float x) { return 1.f / (1.f + expf(-x)); }

namespace pg8 {
#define PG8_LAS __attribute__((address_space(3)))
typedef unsigned short bf16_t;
typedef short bf16x8 __attribute__((ext_vector_type(8)));
typedef float f32x4 __attribute__((ext_vector_type(4)));
typedef unsigned u32x4 __attribute__((ext_vector_type(4)));
constexpr int BM = 256, BK = 64, HALF = 128, HTB = HALF * BK * 2  , STAGE_BYTES = 8 * HTB, NXCD = 8, WGM = 8;

__host__ __device__ __forceinline__ int lds_byte(int r, int c) { const int st = (r >> 4) * 2 + (c >> 5), rr = r & 15, cc = c & 31, ob = rr * 64 + cc * 2; return st * 1024 + (ob ^ (((ob >> 9) & 1) << 5)); }
__host__ __device__ __forceinline__ void stage_rc(int b, int& R, int& C) { const int st = b / 1024, sb = b % 1024, swz = sb ^ (((sb >> 9) & 1) << 5); R = (st >> 1) * 16 + swz / 64; C = (st & 1) * 32 + (swz % 64) / 2; }
__host__ __device__ __forceinline__ int perm32(int rho) { const int n = rho >> 4, i = rho & 15; return 8 * (i >> 2) + 4 * n + (i & 3); }

struct Unit { int pm, pn; };
struct Gemm { const bf16_t* A; const bf16_t* Bt; int M, N, K; };

struct StaticOrder {
    int nM, nN, nwg, G, c;
    __host__ __device__ void init(int M, int N, int G_, int c_) { nM = M / BM; nN = N / BM; nwg = nM * nN; G = G_; c = c_; }
    __host__ __device__ bool next(int i, Unit& u) const {
        const long L = (long)i * G + c; if (L >= nwg) return false;
        int wgid = (int)L; { const int q = nwg / NXCD, r = nwg % NXCD, xcd = wgid % NXCD, off = wgid / NXCD; wgid = (xcd < r ? xcd * (q + 1) : r * (q + 1) + (xcd - r) * q) + off; }
        const int nig = WGM * nN, gid = wgid / nig, fm = gid * WGM, gsz = (nM - fm) < WGM ? (nM - fm) : WGM;
        u.pm = fm + ((wgid % nig) % gsz); u.pn = (wgid % nig) / gsz; return true;
    }
    __device__ __forceinline__ void a_ready(const Unit&) const {}
    __device__ __forceinline__ void done(const Unit&) const {}
};

__device__ __forceinline__ unsigned cvt_pk_bf16(float lo, float hi) { unsigned r; asm volatile("v_cvt_pk_bf16_f32 %0, %1, %2" : "=v"(r) : "v"(lo), "v"(hi)); return r; }
template <class Epi, class Sched, bool ALIGN_EPI = false, bool SP2 = false>
__device__ __forceinline__ void gemm_phase(PG8_LAS unsigned char* lds, const Gemm g, const Sched& S, const Epi& E) {
    const int tid = threadIdx.x, wid = __builtin_amdgcn_readfirstlane(tid >> 6), lane = tid & 63, wr = wid >> 2, wc = wid & 3, fr = lane & 15, fq = lane >> 4;
    const int K = g.K, nt = K / BK;
    unsigned voffA[2], voffB[2];
#pragma unroll
    for (int i = 0; i < 2; ++i) { int R, C; stage_rc(tid * 16 + i * 8192, R, C); const int Rb = Epi::PERM ? ((R & ~31) + perm32(R & 31)) : R;
        voffA[i] = (unsigned)(R * K + C) * 2u; voffB[i] = (unsigned)(Rb * K + C) * 2u; }
    const size_t kstep = (size_t)(BK * 2);
    const size_t hstep = (size_t)HALF * K * 2;
    const size_t tstep = 2 * hstep;
    const unsigned ldsw = (unsigned)wid * 1024u;
    const int aoff = lds_byte(wr * 64 + fr, fq * 8), boff = lds_byte(wc * 32 + fr, fq * 8);
#define PG8_SA(b, h) (((b) * 2 + (h)) * HTB)
#define PG8_SB(b, h) ((4 + (b) * 2 + (h)) * HTB)
#define PG8_STAGE(bufoff, gbase, voff) do { _Pragma("unroll") for (int _i = 0; _i < 2; ++_i) \
        __builtin_amdgcn_global_load_lds((const unsigned*)((const char*)(gbase) + (voff)[_i]), (PG8_LAS unsigned*)(lds + (bufoff) + ldsw + _i * 8192), 16, 0, 0); } while (0)
#define PG8_LDA(dst, b, h) do { _Pragma("unroll") for (int m = 0; m < 4; ++m) _Pragma("unroll") for (int k = 0; k < 2; ++k) dst[m][k] = *(const PG8_LAS bf16x8*)(lds + PG8_SA(b, h) + aoff + m * 2048 + k * 1024); } while (0)
#define PG8_LDB(dst, b, h) do { _Pragma("unroll") for (int n = 0; n < 2; ++n) _Pragma("unroll") for (int k = 0; k < 2; ++k) dst[n][k] = *(const PG8_LAS bf16x8*)(lds + PG8_SB(b, h) + boff + n * 2048 + k * 1024); } while (0)
#define PG8_MMA(ai, bj, At, Bt) do { __builtin_amdgcn_s_setprio(1); _Pragma("unroll") for (int m = 0; m < 4; ++m) _Pragma("unroll") for (int n = 0; n < 2; ++n) _Pragma("unroll") for (int k = 0; k < 2; ++k) \
        acc[ai][bj][m][n] = __builtin_amdgcn_mfma_f32_16x16x32_bf16(Bt[n][k], At[m][k], acc[ai][bj][m][n], 0, 0, 0); __builtin_amdgcn_s_setprio(0); } while (0)
#define PG8_WAIT_V(n) asm volatile("s_waitcnt vmcnt(" #n ")" ::: "memory")
#define PG8_WAIT_L(n) asm volatile("s_waitcnt lgkmcnt(" #n ")" ::: "memory")
#define PG8_BAR __builtin_amdgcn_s_barrier()
#define PG8_SCHED __builtin_amdgcn_sched_barrier(0)
    Unit cur, nxt; int ui = 0;
    if (!S.next(0, cur)) return;
    f32x4 acc[2][2][4][2];
#pragma unroll
    for (int a = 0; a < 2; ++a)
#pragma unroll
        for (int b = 0; b < 2; ++b)
#pragma unroll
            for (int m = 0; m < 4; ++m)
#pragma unroll
                for (int n = 0; n < 2; ++n) acc[a][b][m][n] = (f32x4){0.f, 0.f, 0.f, 0.f};
    bf16x8 At[4][2], B0[2][2], B1[2][2];
    const char* cA = (const char*)g.A + (size_t)cur.pm * tstep; const char* cB = (const char*)g.Bt + (size_t)cur.pn * tstep;
    S.a_ready(cur);
    if constexpr (SP2) {
        PG8_STAGE(PG8_SB(0, 0), cB, voffB); PG8_STAGE(PG8_SB(0, 1), cB + hstep, voffB); PG8_STAGE(PG8_SA(0, 0), cA, voffA); PG8_STAGE(PG8_SA(0, 1), cA + hstep, voffA);
        if (wr == 1) PG8_BAR;
        PG8_WAIT_V(2); PG8_BAR;
        PG8_STAGE(PG8_SB(1, 0), cB + kstep, voffB); PG8_STAGE(PG8_SA(1, 0), cA + kstep, voffA); PG8_STAGE(PG8_SB(1, 1), cB + hstep + kstep, voffB);
        PG8_WAIT_V(6); PG8_BAR;
    } else {
        PG8_STAGE(PG8_SB(0, 0), cB, voffB); PG8_STAGE(PG8_SA(0, 0), cA, voffA); PG8_STAGE(PG8_SB(0, 1), cB + hstep, voffB); PG8_STAGE(PG8_SA(0, 1), cA + hstep, voffA);
        if (wr == 1) PG8_BAR;
        PG8_WAIT_V(4); PG8_BAR;
        PG8_STAGE(PG8_SB(1, 0), cB + kstep, voffB); PG8_STAGE(PG8_SA(1, 0), cA + kstep, voffA); PG8_STAGE(PG8_SB(1, 1), cB + hstep + kstep, voffB);
        PG8_WAIT_V(6); PG8_BAR;
    }
    for (;;) {
        const bool has_next = S.next(ui + 1, nxt);
        const char* nA = has_next ? (const char*)g.A + (size_t)nxt.pm * tstep : cA; const char* nB = has_next ? (const char*)g.Bt + (size_t)nxt.pn * tstep : cB;
        for (int t = 0; t < nt; t += 2) {
            const bool last = (t == nt - 2);
            const char* a1 = cA + (size_t)(t + 1) * kstep;
            const char* a2 = last ? nA : cA + (size_t)(t + 2) * kstep; const char* b2 = last ? nB : cB + (size_t)(t + 2) * kstep;
            const char* a3 = a2 + kstep; const char* b3 = b2 + kstep;
            if (last && has_next) S.a_ready(nxt);
            if constexpr (SP2) {
            PG8_LDB(B0, 0, 0); PG8_LDB(B1, 0, 1); PG8_SCHED; PG8_LDA(At, 0, 0); PG8_STAGE(PG8_SA(1, 1), a1 + hstep, voffA);
            PG8_WAIT_V(8); PG8_WAIT_L(0); PG8_BAR; PG8_MMA(0, 0, At, B0); PG8_MMA(0, 1, At, B1); PG8_BAR; PG8_SCHED;
            PG8_LDA(At, 0, 1); PG8_STAGE(PG8_SB(0, 0), b2, voffB); PG8_STAGE(PG8_SB(0, 1), b2 + hstep, voffB); PG8_STAGE(PG8_SA(0, 0), a2, voffA);
            PG8_WAIT_V(8); PG8_WAIT_L(0); PG8_BAR; PG8_MMA(1, 0, At, B0); PG8_MMA(1, 1, At, B1); PG8_BAR; PG8_SCHED;
            PG8_LDB(B0, 1, 0); PG8_LDB(B1, 1, 1); PG8_SCHED; PG8_LDA(At, 1, 0); PG8_STAGE(PG8_SA(0, 1), a2 + hstep, voffA);
            PG8_WAIT_V(8); PG8_WAIT_L(0); PG8_BAR; PG8_MMA(0, 0, At, B0); PG8_MMA(0, 1, At, B1); PG8_BAR; PG8_SCHED;
            PG8_LDA(At, 1, 1); PG8_STAGE(PG8_SB(1, 0), b3, voffB); PG8_STAGE(PG8_SB(1, 1), b3 + hstep, voffB); PG8_STAGE(PG8_SA(1, 0), a3, voffA);
            PG8_WAIT_V(8); PG8_WAIT_L(0); PG8_BAR; PG8_MMA(1, 0, At, B0); PG8_MMA(1, 1, At, B1); PG8_BAR; PG8_SCHED;
            } else {
            PG8_LDB(B0, 0, 0); PG8_SCHED; PG8_LDA(At, 0, 0); PG8_STAGE(PG8_SA(1, 1), a1 + hstep, voffA);
            PG8_WAIT_L(8); PG8_BAR; PG8_WAIT_L(0); PG8_MMA(0, 0, At, B0); PG8_BAR; PG8_SCHED;
            PG8_LDB(B1, 0, 1); PG8_STAGE(PG8_SB(0, 0), b2, voffB);
            PG8_BAR; PG8_WAIT_L(0); PG8_MMA(0, 1, At, B1); PG8_BAR;
            PG8_LDA(At, 0, 1); PG8_STAGE(PG8_SA(0, 0), a2, voffA);
            PG8_BAR; PG8_WAIT_L(0); PG8_MMA(1, 0, At, B0); PG8_BAR; PG8_SCHED;
            PG8_STAGE(PG8_SB(0, 1), b2 + hstep, voffB);
            PG8_WAIT_V(6); PG8_BAR; PG8_MMA(1, 1, At, B1); PG8_BAR;
            PG8_LDB(B0, 1, 0); PG8_SCHED; PG8_LDA(At, 1, 0); PG8_STAGE(PG8_SA(0, 1), a2 + hstep, voffA);
            PG8_WAIT_L(8); PG8_BAR; PG8_WAIT_L(0); PG8_MMA(0, 0, At, B0); PG8_BAR; PG8_SCHED;
            PG8_LDB(B1, 1, 1); PG8_STAGE(PG8_SB(1, 0), b3, voffB);
            PG8_BAR; PG8_WAIT_L(0); PG8_MMA(0, 1, At, B1); PG8_BAR;
            PG8_LDA(At, 1, 1); PG8_STAGE(PG8_SA(1, 0), a3, voffA);
            PG8_BAR; PG8_WAIT_L(0); PG8_MMA(1, 0, At, B0); PG8_BAR; PG8_SCHED;
            PG8_STAGE(PG8_SB(1, 1), b3 + hstep, voffB);
            PG8_WAIT_V(6); PG8_BAR; PG8_MMA(1, 1, At, B1); PG8_BAR;
            }
        }
        if constexpr (ALIGN_EPI) { if (wr == 0) PG8_BAR; }
        if constexpr (!Epi::AFTER_DRAIN) { E(acc, cur, wr, wc, fr, fq); S.done(cur); }
        if (!has_next) break;
#pragma unroll
        for (int a = 0; a < 2; ++a)
#pragma unroll
            for (int b = 0; b < 2; ++b)
#pragma unroll
                for (int m = 0; m < 4; ++m)
#pragma unroll
                    for (int n = 0; n < 2; ++n) acc[a][b][m][n] = (f32x4){0.f, 0.f, 0.f, 0.f};
        cur = nxt; cA = nA; cB = nB; ++ui;
        if constexpr (ALIGN_EPI) { if (wr == 1) PG8_BAR; }
    }
    PG8_WAIT_V(0);
    if constexpr (!ALIGN_EPI) { if (wr == 0) PG8_BAR; }
    PG8_BAR;
    if constexpr (Epi::AFTER_DRAIN) { E.fused(acc, cur, wr, wc, fr, fq, lds, wid, lane); S.done(cur); }
#undef PG8_SA
#undef PG8_SB
#undef PG8_STAGE
#undef PG8_LDA
#undef PG8_LDB
#undef PG8_MMA
#undef PG8_WAIT_V
#undef PG8_WAIT_L
#undef PG8_BAR
#undef PG8_SCHED
}
}


#define GAS __attribute__((address_space(1)))
#define LAS __attribute__((address_space(3)))
typedef unsigned short bf16;
typedef unsigned v4u __attribute__((ext_vector_type(4)));
typedef float f32x4 __attribute__((ext_vector_type(4)));
typedef short bf16x8 __attribute__((ext_vector_type(8)));
typedef GAS unsigned gu32;
#define RLX_AGENT __ATOMIC_RELAXED, __HIP_MEMORY_SCOPE_AGENT
#define LDS_WAIT() asm volatile("s_waitcnt lgkmcnt(0)" ::: "memory")
#define VM_WAIT() asm volatile("s_waitcnt vmcnt(0)" ::: "memory")
__device__ __forceinline__ unsigned f2bf(float f) { unsigned u = __builtin_bit_cast(unsigned, f); return (u + 0x7fffu + ((u >> 16) & 1u)) >> 16; }
__device__ __forceinline__ unsigned pk2(float lo, float hi) { return f2bf(lo) | (f2bf(hi) << 16); }
__device__ __forceinline__ v4u pack8(const f32x4 a, const f32x4 b) { v4u w; w.x = pg8::cvt_pk_bf16(a[0], a[1]); w.y = pg8::cvt_pk_bf16(a[2], a[3]); w.z = pg8::cvt_pk_bf16(b[0], b[1]); w.w = pg8::cvt_pk_bf16(b[2], b[3]); return w; }

#define XB_TMO      128
#define XB_XCNT(j)  (256  + 64 * (j))
#define XB_XSUB(j)  (1280 + 64 * (j))
#define XB_XGEN(j)  (2304 + 64 * (j))
#define XB_TOP      3328
#define XB_TOPGEN   3392
#define XCD_BAR_WORDS 3456
#define XB_SPIN_CAP (1u << 18)

__device__ __forceinline__ unsigned xb_ld(unsigned* p)              { return __hip_atomic_load(p, __ATOMIC_RELAXED, __HIP_MEMORY_SCOPE_AGENT); }
__device__ __forceinline__ unsigned xb_add(unsigned* p, unsigned v) { return __hip_atomic_fetch_add(p, v, __ATOMIC_RELAXED, __HIP_MEMORY_SCOPE_AGENT); }
__device__ __forceinline__ unsigned xb_xcc_id() { return (unsigned)__builtin_amdgcn_s_getreg((3 << 11) | 20) & 0xFu; }
#define XB_SPIN(cond, bar) do { unsigned _sp = 0; while (cond) { __builtin_amdgcn_s_sleep(1); \
    if ((++_sp & 255u) == 0u) { if (xb_ld(&(bar)[XB_TMO])) break; if (_sp > XB_SPIN_CAP) { atomicAdd(&(bar)[XB_TMO], 1u); break; } } } } while (0)

struct XcdBarrier {
    unsigned* bar; unsigned x;
    volatile LAS unsigned* st;
};

__device__ __forceinline__ XcdBarrier xcd_barrier_post(unsigned* bar, volatile LAS unsigned* st) {
    XcdBarrier b; b.bar = bar; b.x = xb_xcc_id(); b.st = st;
    if (threadIdx.x == 0) (void)xb_add(&bar[XB_XCNT(b.x)], 1u);
    return b;
}
__device__ __forceinline__ void xcd_barrier_complete(unsigned* bar, unsigned x, unsigned& nloc, unsigned& nx) {
    const unsigned G = gridDim.x * gridDim.y * gridDim.z;
    unsigned sum, cnt, mine, sp = 0u;
    for (;;) {
        sum = 0u; cnt = 0u; mine = 0u;
#pragma unroll
        for (unsigned j = 0; j < 16; ++j) { const unsigned c = xb_ld(&bar[XB_XCNT(j)]); sum += c; cnt += (c > 0u) ? 1u : 0u; mine = (j == x) ? c : mine; }
        if (sum == G) break;
        __builtin_amdgcn_s_sleep(1);
        if ((++sp & 255u) == 0u) { if (xb_ld(&bar[XB_TMO])) break; if (sp > XB_SPIN_CAP) { atomicAdd(&bar[XB_TMO], 1u); break; } }
    }
    nloc = mine > 0u ? mine : 1u; nx = cnt > 0u ? cnt : 1u;
}

__device__ __forceinline__ void xcd_barrier(const XcdBarrier& b) {
    asm volatile("s_waitcnt vmcnt(0)" ::: "memory");
    __syncthreads();
    if (threadIdx.x == 0) {
        unsigned* bar = b.bar;
        __builtin_amdgcn_s_waitcnt(0);
        unsigned nloc = b.st[0], nx = b.st[1];
        if (nloc == 0u) { xcd_barrier_complete(bar, b.x, nloc, nx); b.st[0] = nloc; b.st[1] = nx; }
        const unsigned old = xb_add(&bar[XB_XSUB(b.x)], 1u);
        const unsigned gen = old / nloc;
        if (old + 1u == (gen + 1u) * nloc) {
            __builtin_amdgcn_fence(__ATOMIC_RELEASE, "agent");
            asm volatile("s_waitcnt vmcnt(0)" ::: "memory");
            const unsigned og = xb_add(&bar[XB_TOP], 1u);
            const unsigned tg = og / nx;
            if (og + 1u == (tg + 1u) * nx) xb_add(&bar[XB_TOPGEN], 1u);
            else XB_SPIN(xb_ld(&bar[XB_TOPGEN]) == tg, bar);
            __builtin_amdgcn_fence(__ATOMIC_ACQUIRE, "agent");
            xb_add(&bar[XB_XGEN(b.x)], 1u);
            asm volatile("s_waitcnt vmcnt(0)" ::: "memory");
        } else {
            XB_SPIN(xb_ld(&bar[XB_XGEN(b.x)]) == gen, bar);
            __builtin_amdgcn_fence(__ATOMIC_ACQUIRE, "agent");
            asm volatile("s_waitcnt vmcnt(0)" ::: "memory");
        }
    }
    __syncthreads();
}


constexpr int RING_OFF = 0, RING_BYTES = 131072;
constexpr int AUX_OFF = RING_BYTES, AUX_BYTES = 24576;
constexpr int LDSCTL_OFF = AUX_OFF + AUX_BYTES, MISC_OFF = LDSCTL_OFF + 320;
constexpr int LDS_BYTES = LDSCTL_OFF + 1024;
constexpr int NWAVES = 8;
constexpr int CW_BAR = 4096;

struct Args {
    const float *x_prompt, *x_sample, *mem_prompt, *cache_k, *cache_v, *cache_idx_k, *state_hgrn, *cache_mem_k, *cache_mem_v;
    const int* page_table;
    const float *w_in, *lb_logits, *norm_g, *w_mem_k, *w_mem_v, *w_out, *ln_g, *ln_b;
    float* out; unsigned char* ws; float* dbg_aout; float* dbg_mout; float* dbg_bo; int ph_lo, ph_hi, li, pad;
};

__device__ __forceinline__ void rope_cs(int pos, int j, int half, float& c, float& s) {
    const float inv = exp2f(-(float)j / (float)half * 18.931568569324174f);
    const float ang = (float)pos * inv;
    const float k = rintf(ang * 0.15915494309189535f);
    float r = fmaf(-k, 6.2831854820251465f, ang);
    r = fmaf(-k, -1.7484555e-7f, r);
    c = cosf(r); s = sinf(r);
}
__device__ __forceinline__ void p0_tr_item(const float* W, int ldw, int k0, int n0, int nc, bf16* WT, int r0, int K, LAS float* scr, int lane) {
    const int c = lane & 31;
#pragma unroll 8
    for (int i = 0; i < 32; ++i) { const int kk = 2 * i + (lane >> 5); scr[kk * 33 + c] = (c < nc) ? W[(size_t)(k0 + kk) * ldw + n0 + c] : 0.f; }
    LDS_WAIT(); asm volatile("" ::: "memory");
    const int c8 = lane & 7;
#pragma unroll
    for (int j = 0; j < 4; ++j) { const int n = (lane >> 3) + 8 * j; const LAS float* s = scr + (8 * c8) * 33 + n;
        v4u o; o.x = pk2(s[0 * 33], s[1 * 33]); o.y = pk2(s[2 * 33], s[3 * 33]); o.z = pk2(s[4 * 33], s[5 * 33]); o.w = pk2(s[6 * 33], s[7 * 33]);
        if (n < nc) *(GAS v4u*)(WT + (size_t)(r0 + n) * K + k0 + 8 * c8) = o; }
    LDS_WAIT(); asm volatile("" ::: "memory");
}
__device__ __forceinline__ void cvt_rows(const float* src, bf16* dst, size_t nchunk8, size_t gtid, size_t gthreads) {
    for (size_t c = gtid; c < nchunk8; c += gthreads) {
        const f32x4 a = *(const GAS f32x4*)(src + c * 8), b = *(const GAS f32x4*)(src + c * 8 + 4);
        v4u o; o.x = pk2(a[0], a[1]); o.y = pk2(a[2], a[3]); o.z = pk2(b[0], b[1]); o.w = pk2(b[2], b[3]);
        *(GAS v4u*)(dst + c * 8) = o;
    }
}
__device__ __forceinline__ void p0_prologue(const Args& A, LAS unsigned char* lds, int G) {
    const int tid = threadIdx.x, lane = tid & 63, wave = tid >> 6;
    unsigned char* ws = A.ws;
    bf16* Xb = (bf16*)(ws + WS_XB); bf16* Wmain = (bf16*)(ws + WS_WMAIN); bf16* Wikw = (bf16*)(ws + WS_WIKW); bf16* Wout = (bf16*)(ws + WS_WOUT);
    bf16* Wmkv = (bf16*)(ws + WS_WMKV); bf16* MEMb = (bf16*)(ws + WS_MEMB);
    const size_t gtid = (size_t)blockIdx.x * 512 + tid, gthreads = (size_t)G * 512;
    {
        LAS float* scr = (LAS float*)(lds + RING_OFF + wave * 16384);
        const int gw = blockIdx.x * NWAVES + wave, NGW = G * NWAVES;
        constexpr int NBLK = 160 + 96 + 3 + 64 + 16 + 16;
        for (int it = gw; it < 32 * NBLK; it += NGW) {
            const int kb = it / NBLK; int nb = it % NBLK; const int k0 = kb * 64;
            if (nb < 160) { p0_tr_item(A.w_in, NIN, k0, nb * 32, 32, Wmain, nb * 32, DM, scr, lane); continue; } nb -= 160;
            if (nb < 96) { p0_tr_item(A.w_in, NIN, k0, 5200 + nb * 32, 32, Wmain, 5120 + nb * 32, DM, scr, lane); continue; } nb -= 96;
            if (nb < 3) { p0_tr_item(A.w_in, NIN, k0, 5120 + nb * 32, nb < 2 ? 32 : 16, Wikw, nb * 32, DM, scr, lane); continue; } nb -= 3;
            if (nb < 64) { p0_tr_item(A.w_out, DM, k0, nb * 32, 32, Wout, nb * 32, DM, scr, lane); continue; } nb -= 64;
            if (nb < 16) { p0_tr_item(A.w_mem_k, WM, k0, nb * 32, 32, Wmkv, nb * 32, DM, scr, lane); continue; } nb -= 16;
            p0_tr_item(A.w_mem_v, WM, k0, nb * 32, 32, Wmkv, 512 + nb * 32, DM, scr, lane);
        }
    }
    cvt_rows(A.x_prompt, Xb, (size_t)MP * DM / 8, gtid, gthreads);
    cvt_rows(A.x_sample, Xb + (size_t)MP * DM, (size_t)MS * DM / 8, gtid, gthreads);
    cvt_rows(A.mem_prompt, MEMb, (size_t)NB * NMEM * DM / 8, gtid, gthreads);
    float2* ropeA = (float2*)(ws + WS_ROPEA); float2* ropeI = (float2*)(ws + WS_ROPEI); float* lbv = (float*)(ws + WS_LB);
    for (size_t i = gtid; i < (size_t)NPOS * 16; i += gthreads) { const int p = (int)(i >> 4), j = (int)(i & 15); const int pos = p < T ? p : PAST + (p - T); float c, s; rope_cs(pos, j, 16, c, s); ropeA[i] = make_float2(c, s); }
    for (size_t i = gtid; i < (size_t)NPOS * 8; i += gthreads) { const int p = (int)(i >> 3), j = (int)(i & 7); const int pos = p < T ? p : PAST + (p - T); float c, s; rope_cs(pos, j, 8, c, s); ropeI[i] = make_float2(c, s); }
    for (size_t i = gtid; i < 512; i += gthreads) { const float l0 = A.lb_logits[i], l1 = A.lb_logits[512 + i]; const float m = fmaxf(l0, l1); const float e0 = expf(l0 - m), e1 = expf(l1 - m); lbv[i] = e0 / (e0 + e1); }
}

__device__ __forceinline__ int orig_col(int n) { return n < 5120 ? n : n + NIKW; }
struct EpiIn {
    static constexpr bool PERM = true, AFTER_DRAIN = false;
    float* out; float* Z; bf16 *Qb, *Kb, *Vb, *GA, *IQb, *HV, *GB, *MQb, *GM; float *HQ, *HG; const float2* ropeA; const float2* ropeI; const float* lbv;
    template <int GRP> __device__ __forceinline__ void run(const pg8::f32x4 (&acc)[2][2][4][2], const pg8::Unit& u, int wr, int wc, int fr, int fq) const {
        constexpr int gstart = GRP <= 4 ? GRP * 1024 : 5120 + (GRP - 5) * 512;
        const int ncol0 = u.pn * 256 + wc * 32 + 8 * fq;
        const int row0 = u.pm * 256 + wr * 64 + fr;
        const bool ropeA_on = (GRP == 0 || GRP == 1) && (wc == 0);
        const bool ropeI_on = (GRP == 4) && ((wc & 1) == 0);
#pragma unroll
        for (int ai = 0; ai < 2; ++ai)
#pragma unroll
            for (int m = 0; m < 4; ++m) {
                const int row = row0 + ai * 128 + m * 16;
                f32x4 cs[4];
                if (GRP == 0 || GRP == 1) { if (ropeA_on) { const GAS f32x4* tp = (const GAS f32x4*)(ropeA + (size_t)(row & (T - 1)) * 16 + 8 * (fq & 1));
#pragma unroll
                    for (int q = 0; q < 4; ++q) cs[q] = tp[q]; } }
                if (GRP == 4) { if (ropeI_on) { const GAS f32x4* tp = (const GAS f32x4*)(ropeI + (size_t)(row & (T - 1)) * 8);
#pragma unroll
                    for (int q = 0; q < 4; ++q) cs[q] = tp[q]; } }
#pragma unroll
                for (int bj = 0; bj < 2; ++bj) {
                    f32x4 v0 = acc[ai][bj][m][0], v1 = acc[ai][bj][m][1];
                    const int ncol = ncol0 + bj * 128, gcol = ncol - gstart;
#if HYBRID
                    { float* zp = Z + (size_t)row * NIN + orig_col(ncol); *(GAS f32x4*)zp = v0; *(GAS f32x4*)(zp + 4) = v1; }
#endif
                    if (GRP == 0 || GRP == 1) {
                        if (ropeA_on) {
                            f32x4 p0, p1;
#pragma unroll
                            for (int e = 0; e < 4; ++e) { p0[e] = __shfl_xor(v0[e], 32); p1[e] = __shfl_xor(v1[e], 32); }
                            const float sg = fq < 2 ? -1.f : 1.f;
                            v0[0] = v0[0] * cs[0][0] + sg * p0[0] * cs[0][1]; v0[1] = v0[1] * cs[0][2] + sg * p0[1] * cs[0][3];
                            v0[2] = v0[2] * cs[1][0] + sg * p0[2] * cs[1][1]; v0[3] = v0[3] * cs[1][2] + sg * p0[3] * cs[1][3];
                            v1[0] = v1[0] * cs[2][0] + sg * p1[0] * cs[2][1]; v1[1] = v1[1] * cs[2][2] + sg * p1[1] * cs[2][3];
                            v1[2] = v1[2] * cs[3][0] + sg * p1[2] * cs[3][1]; v1[3] = v1[3] * cs[3][2] + sg * p1[3] * cs[3][3];
                        }
                    }
                    if (GRP == 4) {
                        if (ropeI_on) {
                            f32x4 p0, p1;
#pragma unroll
                            for (int e = 0; e < 4; ++e) { p0[e] = __shfl_xor(v0[e], 16); p1[e] = __shfl_xor(v1[e], 16); }
                            if (fq < 2) { const float sg = fq == 0 ? -1.f : 1.f;
                                v0[0] = v0[0] * cs[0][0] + sg * p0[0] * cs[0][1]; v0[1] = v0[1] * cs[0][2] + sg * p0[1] * cs[0][3];
                                v0[2] = v0[2] * cs[1][0] + sg * p0[2] * cs[1][1]; v0[3] = v0[3] * cs[1][2] + sg * p0[3] * cs[1][3];
                                v1[0] = v1[0] * cs[2][0] + sg * p1[0] * cs[2][1]; v1[1] = v1[1] * cs[2][2] + sg * p1[1] * cs[2][3];
                                v1[2] = v1[2] * cs[3][0] + sg * p1[2] * cs[3][1]; v1[3] = v1[3] * cs[3][2] + sg * p1[3] * cs[3][3]; }
                        }
                    }
                    if (GRP == 0) { *(GAS v4u*)(Qb + (size_t)row * WA + gcol) = pack8(v0 * (SM_SCALE * LOG2E), v1 * (SM_SCALE * LOG2E)); }
                    if (GRP == 1) { float* op = out + O_KP + (size_t)row * WA + gcol; *(GAS f32x4*)op = v0; *(GAS f32x4*)(op + 4) = v1; *(GAS v4u*)(Kb + (size_t)row * WA + gcol) = pack8(v0, v1); }
                    if (GRP == 2) { float* op = out + O_VP + (size_t)row * WA + gcol; *(GAS f32x4*)op = v0; *(GAS f32x4*)(op + 4) = v1; *(GAS v4u*)(Vb + (size_t)row * WA + gcol) = pack8(v0, v1); }
                    if (GRP == 4) { *(GAS v4u*)(IQb + (size_t)row * WA + gcol) = pack8(v0 * 0.125f, v1 * 0.125f); }
                    if (GRP == 3 || GRP == 8 || GRP == 10 || GRP == 5) {
#pragma unroll
                        for (int e = 0; e < 4; ++e) { v0[e] = silu_f(v0[e]); v1[e] = silu_f(v1[e]); }
                        if (GRP == 3) *(GAS v4u*)(GA + (size_t)row * WA + gcol) = pack8(v0, v1);
                        if (GRP == 8) *(GAS v4u*)(GB + (size_t)row * WB + gcol) = pack8(v0, v1);
                        if (GRP == 10) *(GAS v4u*)(GM + (size_t)row * WM + gcol) = pack8(v0, v1);
                        if (GRP == 5) { float* op = HQ + (size_t)row * WB + gcol; *(GAS f32x4*)op = v0; *(GAS f32x4*)(op + 4) = v1; }
                    }
                    if (GRP == 6) { const f32x4 l0 = *(const GAS f32x4*)(lbv + gcol), l1 = *(const GAS f32x4*)(lbv + gcol + 4);
#pragma unroll
                        for (int e = 0; e < 4; ++e) { v0[e] = logf(l0[e] + (1.f - l0[e]) * sigmoid_f(v0[e])); v1[e] = logf(l1[e] + (1.f - l1[e]) * sigmoid_f(v1[e])); }
                        float* op = HG + (size_t)row * WB + gcol; *(GAS f32x4*)op = v0; *(GAS f32x4*)(op + 4) = v1; }
                    if (GRP == 7) *(GAS v4u*)(HV + (size_t)row * WB + gcol) = pack8(v0, v1);
                    if (GRP == 9) *(GAS v4u*)(MQb + (size_t)row * WM + gcol) = pack8(v0 * (SM_SCALE * LOG2E), v1 * (SM_SCALE * LOG2E));
                }
            }
    }
    __device__ __forceinline__ void operator()(const pg8::f32x4 (&acc)[2][2][4][2], const pg8::Unit& u, int wr, int wc, int fr, int fq) const {
        const int pn = u.pn;
        if (pn < 4) run<0>(acc, u, wr, wc, fr, fq);
        else if (pn < 8) run<1>(acc, u, wr, wc, fr, fq);
        else if (pn < 12) run<2>(acc, u, wr, wc, fr, fq);
        else if (pn < 16) run<3>(acc, u, wr, wc, fr, fq);
        else if (pn < 20) run<4>(acc, u, wr, wc, fr, fq);
        else if (pn < 22) run<5>(acc, u, wr, wc, fr, fq);
        else if (pn < 24) run<6>(acc, u, wr, wc, fr, fq);
        else if (pn < 26) run<7>(acc, u, wr, wc, fr, fq);
        else if (pn < 28) run<8>(acc, u, wr, wc, fr, fq);
        else if (pn < 30) run<9>(acc, u, wr, wc, fr, fq);
        else run<10>(acc, u, wr, wc, fr, fq);
    }
};

template <int MT, int NT>
__device__ __forceinline__ void small_gemm(const bf16* A, const bf16* Bt, int K, int m0, int n0, int lane, f32x4 (&acc)[MT][NT]) {
    const int fr = lane & 15, fq = lane >> 4;
    const GAS bf16x8* ap[MT]; const GAS bf16x8* bp[NT];
#pragma unroll
    for (int i = 0; i < MT; ++i) ap[i] = (const GAS bf16x8*)(A + (size_t)(m0 + 16 * i + fr) * K + 8 * fq);
#pragma unroll
    for (int j = 0; j < NT; ++j) bp[j] = (const GAS bf16x8*)(Bt + (size_t)(n0 + 16 * j + fr) * K + 8 * fq);
#pragma unroll
    for (int i = 0; i < MT; ++i)
#pragma unroll
        for (int j = 0; j < NT; ++j) acc[i][j] = (f32x4){0.f, 0.f, 0.f, 0.f};
    bf16x8 a[MT], b[NT];
#pragma unroll
    for (int i = 0; i < MT; ++i) a[i] = ap[i][0];
#pragma unroll
    for (int j = 0; j < NT; ++j) b[j] = bp[j][0];
    for (int k = 0; k < K / 32; ++k) {
        bf16x8 an[MT], bn[NT];
        const int kn = (k + 1 < K / 32) ? (k + 1) * 4 : 0;
#pragma unroll
        for (int i = 0; i < MT; ++i) an[i] = ap[i][kn];
#pragma unroll
        for (int j = 0; j < NT; ++j) bn[j] = bp[j][kn];
#pragma unroll
        for (int i = 0; i < MT; ++i)
#pragma unroll
            for (int j = 0; j < NT; ++j) acc[i][j] = __builtin_amdgcn_mfma_f32_16x16x32_bf16(a[i], b[j], acc[i][j], 0, 0, 0);
#pragma unroll
        for (int i = 0; i < MT; ++i) a[i] = an[i];
#pragma unroll
        for (int j = 0; j < NT; ++j) b[j] = bn[j];
    }
}

__device__ __forceinline__ void p1_small(const Args& A, int G) {
    const int tid = threadIdx.x, lane = tid & 63, wave = tid >> 6, fr = lane & 15, fq = lane >> 4;
    unsigned char* ws = A.ws;
    const bf16* Xb = (const bf16*)(ws + WS_XB); const bf16* Wmain = (const bf16*)(ws + WS_WMAIN); const bf16* Wikw = (const bf16*)(ws + WS_WIKW);
    const bf16* Wmkv = (const bf16*)(ws + WS_WMKV); const bf16* MEMb = (const bf16*)(ws + WS_MEMB);
    const float2* ropeI = (const float2*)(ws + WS_ROPEI);
    bf16* IKb = (bf16*)(ws + WS_IKB); float* IW = (float*)(ws + WS_IW); bf16* MKb = (bf16*)(ws + WS_MKB); bf16* MVb = (bf16*)(ws + WS_MVB); float* Zs = (float*)(ws + WS_ZS);
#if HYBRID
    float* Z = (float*)(ws + WS_Z);
#endif
    const int gw = blockIdx.x * NWAVES + wave, NGW = G * NWAVES;
    constexpr int U_IKW = MR / 32, U_SMP = NMAIN / 32, U_MKV = 32 * 32;
    for (int u = gw; u < U_IKW + U_SMP + U_MKV; u += NGW) {
        if (u < U_IKW) {
            f32x4 acc[2][5];
            small_gemm<2, 5>(Xb, Wikw, DM, u * 32, 0, lane, acc);
#pragma unroll
            for (int i = 0; i < 2; ++i)
#pragma unroll
                for (int e = 0; e < 4; ++e) {
                    const int row = u * 32 + 16 * i + 4 * fq + e;
                    const int pidx = row < MP ? (row & (T - 1)) : T + ((row - MP) & (ST - 1));
                    float* ikout = row < MP ? A.out + O_IKP + (size_t)row * DI : A.out + O_IKS + (size_t)(row - MP) * DI;
#pragma unroll
                    for (int j = 0; j < 4; ++j) {
                        float v = acc[i][j][e];
#if HYBRID
                        Z[(size_t)row * NIN + C_IK + 16 * j + fr] = v;
#endif
                        if (row >= MP) Zs[(size_t)(row - MP) * NIN + C_IK + 16 * j + fr] = v;
                        if (j == 0) { const float p = __shfl_xor(v, 8); const float2 cs = ropeI[(size_t)pidx * 8 + (fr & 7)]; v = v * cs.x + (fr < 8 ? -p : p) * cs.y; }
                        ikout[16 * j + fr] = v;
                        IKb[(size_t)row * DI + 16 * j + fr] = (bf16)f2bf(v);
                    }
                    { const float v = acc[i][4][e];
#if HYBRID
                      Z[(size_t)row * NIN + C_IW + fr] = v;
#endif
                      if (row >= MP) Zs[(size_t)(row - MP) * NIN + C_IW + fr] = v;
                      IW[(size_t)row * HI + fr] = v * 0.25f; }
                }
        } else if (u < U_IKW + U_SMP) {
            const int n0 = (u - U_IKW) * 32;
            f32x4 acc[4][2];
            small_gemm<4, 2>(Xb, Wmain, DM, MP, n0, lane, acc);
#pragma unroll
            for (int i = 0; i < 4; ++i)
#pragma unroll
                for (int j = 0; j < 2; ++j)
#pragma unroll
                    for (int e = 0; e < 4; ++e) { const int r = 16 * i + 4 * fq + e, oc = orig_col(n0 + 16 * j + fr);
                        Zs[(size_t)r * NIN + oc] = acc[i][j][e];
#if HYBRID
                        Z[(size_t)(MP + r) * NIN + oc] = acc[i][j][e];
#endif
                    }
        } else {
            const int t = u - U_IKW - U_SMP, m0 = (t >> 5) * 32, n0 = (t & 31) * 32;
            f32x4 acc[2][2];
            small_gemm<2, 2>(MEMb, Wmkv, DM, m0, n0, lane, acc);
#pragma unroll
            for (int i = 0; i < 2; ++i)
#pragma unroll
                for (int j = 0; j < 2; ++j)
#pragma unroll
                    for (int e = 0; e < 4; ++e) { const int r = m0 + 16 * i + 4 * fq + e, c = n0 + 16 * j + fr; const float v = acc[i][j][e];
                        if (c < WM) { A.out[O_MKP + (size_t)r * WM + c] = v; MKb[(size_t)r * WM + c] = (bf16)f2bf(v); }
                        else { A.out[O_MVP + (size_t)r * WM + (c - WM)] = v; MVb[(size_t)r * WM + (c - WM)] = (bf16)f2bf(v); } }
        }
    }
}

struct EpiOut {
    static constexpr bool PERM = true, AFTER_DRAIN = false;
    const float* x; float* y;
    __device__ __forceinline__ void operator()(const pg8::f32x4 (&acc)[2][2][4][2], const pg8::Unit& u, int wr, int wc, int fr, int fq) const {
        const int col0 = u.pn * 256 + wc * 32 + 8 * fq, row0 = u.pm * 256 + wr * 64 + fr;
#pragma unroll
        for (int ai = 0; ai < 2; ++ai)
#pragma unroll
            for (int m = 0; m < 4; ++m) {
                const size_t ro = (size_t)(row0 + ai * 128 + m * 16) * DM;
#pragma unroll
                for (int bj = 0; bj < 2; ++bj) {
                    const size_t o = ro + col0 + bj * 128;
                    const f32x4 x0 = *(const GAS f32x4*)(x + o), x1 = *(const GAS f32x4*)(x + o + 4);
                    *(GAS f32x4*)(y + o) = x0 * ALPHA + acc[ai][bj][m][0]; *(GAS f32x4*)(y + o + 4) = x1 * ALPHA + acc[ai][bj][m][1];
                }
            }
    }
};
__device__ __forceinline__ void p5_small(const Args& A, int G) {
    const int tid = threadIdx.x, lane = tid & 63, wave = tid >> 6, fr = lane & 15, fq = lane >> 4;
    const bf16* CATb = (const bf16*)(A.ws + WS_CATB); const bf16* Wout = (const bf16*)(A.ws + WS_WOUT);
    const int gw = blockIdx.x * NWAVES + wave, NGW = G * NWAVES;
    for (int u = gw; u < DM / 32; u += NGW) {
        f32x4 acc[4][2];
        small_gemm<4, 2>(CATb, Wout, DM, MP, u * 32, lane, acc);
#pragma unroll
        for (int i = 0; i < 4; ++i)
#pragma unroll
            for (int j = 0; j < 2; ++j)
#pragma unroll
                for (int e = 0; e < 4; ++e) { const int r = 16 * i + 4 * fq + e, c = u * 32 + 16 * j + fr; A.out[O_YS + (size_t)r * DM + c] = ALPHA * A.x_sample[(size_t)r * DM + c] + acc[i][j][e]; }
    }
}
__device__ __forceinline__ float wave_sum(float v) {
#pragma unroll
    for (int o = 1; o < 64; o <<= 1) v += __shfl_xor(v, o);
    return v;
}
__device__ __forceinline__ void p6_layernorm(const Args& A, int G) {
    const int tid = threadIdx.x, lane = tid & 63, wave = tid >> 6;
    const int gw = blockIdx.x * NWAVES + wave, NGW = G * NWAVES;
    f32x4 g[8], bb[8];
#pragma unroll
    for (int j = 0; j < 8; ++j) { g[j] = *(const GAS f32x4*)(A.ln_g + 4 * lane + 256 * j); bb[j] = *(const GAS f32x4*)(A.ln_b + 4 * lane + 256 * j); }
    for (int row = gw; row < MR; row += NGW) {
        GAS f32x4* p = (GAS f32x4*)(A.out + O_YP + (size_t)row * DM) + lane;
        f32x4 v[8]; float s = 0.f;
#pragma unroll
        for (int j = 0; j < 8; ++j) { v[j] = p[64 * j]; s += (v[j][0] + v[j][1]) + (v[j][2] + v[j][3]); }
        const float mean = wave_sum(s) * (1.f / DM); float q = 0.f;
#pragma unroll
        for (int j = 0; j < 8; ++j) { v[j] = v[j] - mean; q += (v[j][0] * v[j][0] + v[j][1] * v[j][1]) + (v[j][2] * v[j][2] + v[j][3] * v[j][3]); }
        const float rstd = rsqrtf(wave_sum(q) * (1.f / DM) + LN_EPS);
#pragma unroll
        for (int j = 0; j < 8; ++j) p[64 * j] = v[j] * rstd * g[j] + bb[j];
    }
}

typedef float f32x16 __attribute__((ext_vector_type(16)));
typedef unsigned u32x2 __attribute__((ext_vector_type(2)));
__device__ __forceinline__ unsigned off_b(unsigned row, unsigned ch) { return 256u * row + 16u * (ch ^ (((row & 3u) << 2) | ((row >> 2) & 3u))); }
__device__ __forceinline__ void select_row(const float (&x)[32], int n, int lane, LAS float* scr, float& thr_v, int& thr_s) {
    const int NI = (n + 63) >> 6;
    float mn = INFINITY, mx = -INFINITY;
#pragma unroll
    for (int i = 0; i < 32; ++i) if (i < NI) { const bool ok = i * 64 + lane < n; mn = fminf(mn, ok ? x[i] : INFINITY); mx = fmaxf(mx, x[i]); }
#pragma unroll
    for (int o = 1; o < 64; o <<= 1) { mn = fminf(mn, __shfl_xor(mn, o)); mx = fmaxf(mx, __shfl_xor(mx, o)); }
    float lo = mn, hi = INFINITY; int c_lo = n, c_hi = 0;
    for (int it = 0; it < 96 && c_lo - c_hi > 64; ++it) {
        const float hf = (hi == INFINITY) ? mx : hi;
        const float mid = lo + 0.5f * (hf - lo);
        if (!(mid > lo) || (hi != INFINITY && !(mid < hi))) break;
        int c = 0;
#pragma unroll
        for (int i = 0; i < 32; ++i) if (i < NI) c += __popcll(__ballot(x[i] >= mid));
        if (c >= TOPK) { lo = mid; c_lo = c; } else { hi = mid; c_hi = c; }
    }
    const int m = c_lo - c_hi, r = TOPK - c_hi;
    int base = 0;
#pragma unroll
    for (int i = 0; i < 32; ++i) if (i < NI) {
        const bool cand = x[i] >= lo && x[i] < hi;
        const unsigned long long bal = __ballot(cand);
        if (cand) { const int pos = base + __popcll(bal & ((1ull << lane) - 1ull)); if (pos < 128) { scr[2 * pos] = x[i]; scr[2 * pos + 1] = __int_as_float(i * 64 + lane); } }
        base += __popcll(bal);
    }
    LDS_WAIT(); asm volatile("" ::: "memory");
    thr_v = lo; thr_s = 0x7fffffff;
    if (m <= 128) {
        float fv = 0.f; int fs = -1;
        for (int c0 = 0; c0 < m; c0 += 64) {
            const int cme = c0 + lane; const bool have = cme < m;
            const float v = have ? scr[2 * cme] : 0.f; const int sidx = have ? __float_as_int(scr[2 * cme + 1]) : 0;
            int rank = 0;
            for (int j = 0; j < m; ++j) { const float ov = scr[2 * j]; const int os = __float_as_int(scr[2 * j + 1]); rank += (ov > v || (ov == v && os < sidx)) ? 1 : 0; }
            const unsigned long long hit = __ballot(have && rank == r - 1);
            if (hit) { const int src = __ffsll((long long)hit) - 1; fv = __shfl(v, src); fs = __shfl(sidx, src); }
        }
        if (fs >= 0) { thr_v = fv; thr_s = fs; }
    }
    LDS_WAIT(); asm volatile("" ::: "memory");
}
__device__ __forceinline__ void p2_indexer(const Args& A, LAS unsigned char* lds, int unit) {
    const int tid = threadIdx.x, lane = tid & 63, wave = tid >> 6, r32 = lane & 31, hlf = lane >> 5;
    const bf16* IQb = (const bf16*)(A.ws + WS_IQB); const bf16* IKb = (const bf16*)(A.ws + WS_IKB); const float* IW = (const float*)(A.ws + WS_IW);
    unsigned* MASK = (unsigned*)(A.ws + WS_MASK);
    const int b = unit >> 6, p = unit & 63;
    LAS float* S = (LAS float*)(lds + RING_OFF);
    LAS unsigned char* kst = lds + AUX_OFF;
    LAS float* scr = (LAS float*)(lds + AUX_OFF + 16384 + wave * 1024);
    for (int half = 0; half < 2; ++half) {
        const int ti = half == 0 ? p : 127 - p, t0 = 16 * ti, nk = t0 + 16, n64 = (nk + 63) >> 6;
        const int qa = (r32 >> 2) & 1, ha = (r32 & 3) + 4 * (r32 >> 3);
        bf16x8 aq[4];
#pragma unroll
        for (int ks = 0; ks < 4; ++ks) aq[ks] = *(const GAS bf16x8*)(IQb + (size_t)(b * T + t0 + 2 * wave + qa) * WA + ha * DI + 16 * ks + 8 * hlf);
        float wv[16];
        { const GAS f32x4* wp = (const GAS f32x4*)(IW + (size_t)(b * T + t0 + 2 * wave + hlf) * HI);
#pragma unroll
          for (int q = 0; q < 4; ++q) { const f32x4 w4 = wp[q]; wv[4 * q] = w4[0]; wv[4 * q + 1] = w4[1]; wv[4 * q + 2] = w4[2]; wv[4 * q + 3] = w4[3]; } }
        const int tq = t0 + 2 * wave + hlf;
        const int srow = tid >> 3, sch = tid & 7;
        const GAS v4u* ksrc = (const GAS v4u*)(IKb + (size_t)(b * T) * DI) + (size_t)srow * 8 + (sch ^ ((srow >> 1) & 7));
        v4u stg = ksrc[0];
        *(LAS v4u*)(kst + tid * 16) = stg;
        LDS_WAIT(); __syncthreads();
        for (int kt = 0; kt < n64; ++kt) {
            if (kt + 1 < n64) stg = ksrc[(size_t)(kt + 1) * 512];
            const LAS unsigned char* kb = kst + (kt & 1) * 8192;
#pragma unroll
            for (int g = 0; g < 2; ++g) {
                f32x16 C;
#pragma unroll
                for (int i = 0; i < 16; ++i) C[i] = 0.f;
                const int krow = 32 * g + r32;
#pragma unroll
                for (int ks = 0; ks < 4; ++ks) { const bf16x8 kf = *(const LAS bf16x8*)(kb + krow * 128 + (((2 * ks + hlf) ^ ((krow >> 1) & 7)) << 4)); C = __builtin_amdgcn_mfma_f32_32x32x16_bf16(aq[ks], kf, C, 0, 0, 0); }
                float sc = 0.f;
#pragma unroll
                for (int i = 0; i < 16; ++i) sc = fmaf(wv[i], fmaxf(C[i], 0.f), sc);
                const int key = 64 * kt + krow;
                S[(2 * wave + hlf) * 2048 + key] = key <= tq ? sc : -INFINITY;
            }
            if (kt + 1 < n64) *(LAS v4u*)(kst + ((kt + 1) & 1) * 8192 + tid * 16) = stg;
            LDS_WAIT(); __syncthreads();
        }
        for (int qi = 0; qi < 2; ++qi) {
            const int t = t0 + 2 * wave + qi, n = t + 1, NI = (n + 63) >> 6;
            unsigned long long mk = 0ull;
            if (n <= TOPK) {
#pragma unroll
                for (int i = 0; i < 32; ++i) { const unsigned long long bal = __ballot(i * 64 + lane <= t); if (lane == i) mk = bal; }
            } else {
                float x[32];
#pragma unroll
                for (int i = 0; i < 32; ++i) x[i] = (i < NI && i * 64 + lane < n) ? S[(2 * wave + qi) * 2048 + i * 64 + lane] : -INFINITY;
                float thr_v; int thr_s;
                select_row(x, n, lane, scr, thr_v, thr_s);
#pragma unroll
                for (int i = 0; i < 32; ++i) { const int sidx = i * 64 + lane; const unsigned long long bal = __ballot(x[i] > thr_v || (x[i] == thr_v && sidx <= thr_s)); if (lane == i) mk = bal; }
            }
            if (lane < 32) *(GAS unsigned long long*)(MASK + (size_t)(b * T + t) * 64 + 2 * lane) = mk;
        }
    }
    __syncthreads();
}

struct AttnUnit {
    const bf16* Q; int ldq;
    const bf16* K; const bf16* V; int ldkv;
    const unsigned* mask;
    int qrow0, qrow1;
    int ntile0, ntile1;
    int pos0, pos1;
    bf16* cat; int ldc;
    const bf16* gate; int ldg;
    float* of32; int ldo;
};
__device__ __forceinline__ void attn_unit(const AttnUnit& U, LAS unsigned char* lds) {
    const int tid = threadIdx.x, lane = tid & 63, wave = tid >> 6, r32 = lane & 31, hlf = lane >> 5, wg = wave >> 2, ww = wave & 3;
    const int myrow = (wg ? U.qrow1 : U.qrow0) + 32 * ww + r32;
    int ntw = wg ? U.ntile1 : U.ntile0; { const int lastpos = (wg ? U.pos1 : U.pos0) + 32 * ww + 31; const int lim = (lastpos >> 6) + 1; ntw = lim < ntw ? lim : ntw; }
    const int maxt = U.ntile0 > U.ntile1 ? U.ntile0 : U.ntile1;
    bf16x8 qf[8];
#pragma unroll
    for (int ks = 0; ks < 8; ++ks) qf[ks] = *(const GAS bf16x8*)(U.Q + (size_t)myrow * U.ldq + 16 * ks + 8 * hlf);
    f32x16 O[4];
#pragma unroll
    for (int c = 0; c < 4; ++c)
#pragma unroll
        for (int i = 0; i < 16; ++i) O[c][i] = 0.f;
    float m_run = -1e30f, l_run = 0.f;
    LAS unsigned char* kbuf = lds + RING_OFF; LAS unsigned char* vbuf = lds + RING_OFF + 32768;
    unsigned soff[2]; size_t goff[2];
#pragma unroll
    for (int i = 0; i < 2; ++i) { const int cidx = tid + 512 * i, row = cidx >> 4, ch = cidx & 15; soff[i] = off_b(row, ch); goff[i] = (size_t)row * U.ldkv + ch * 8; }
    v4u sk[2], sv[2];
#pragma unroll
    for (int i = 0; i < 2; ++i) { sk[i] = *(const GAS v4u*)(U.K + goff[i]); sv[i] = *(const GAS v4u*)(U.V + goff[i]); }
#pragma unroll
    for (int i = 0; i < 2; ++i) { *(LAS v4u*)(kbuf + soff[i]) = sk[i]; *(LAS v4u*)(vbuf + soff[i]) = sv[i]; }
    LDS_WAIT(); __syncthreads();
    const unsigned blk = (lane >> 4) & 1, q4 = (lane & 15) >> 2, p4 = lane & 3;
    for (int kt = 0; kt < maxt; ++kt) {
        const bool more = kt + 1 < maxt;
        if (more) {
#pragma unroll
            for (int i = 0; i < 2; ++i) { sk[i] = *(const GAS v4u*)(U.K + (size_t)(kt + 1) * 64 * U.ldkv + goff[i]); sv[i] = *(const GAS v4u*)(U.V + (size_t)(kt + 1) * 64 * U.ldkv + goff[i]); }
        }
        if (kt < ntw) {
            const LAS unsigned char* kb = kbuf + (kt & 1) * 16384; const LAS unsigned char* vb = vbuf + (kt & 1) * 16384;
            unsigned mw0 = 0xffffffffu, mw1 = 0xffffffffu;
            if (U.mask) { const u32x2 mm = *(const GAS u32x2*)(U.mask + (size_t)myrow * 64 + 2 * kt); mw0 = mm.x; mw1 = mm.y; }
#pragma unroll
            for (int g = 0; g < 2; ++g) {
                f32x16 C;
#pragma unroll
                for (int i = 0; i < 16; ++i) C[i] = 0.f;
#pragma unroll
                for (int ks = 0; ks < 8; ++ks) { const bf16x8 kf = *(const LAS bf16x8*)(kb + off_b(32 * g + r32, 2 * ks + hlf)); C = __builtin_amdgcn_mfma_f32_32x32x16_bf16(kf, qf[ks], C, 0, 0, 0); }
                const unsigned mw = (g == 0 ? mw0 : mw1) >> (4 * hlf);
                float smax = -INFINITY;
#pragma unroll
                for (int i = 0; i < 16; ++i) { const int bit = (i & 3) + 8 * (i >> 2); C[i] = ((mw >> bit) & 1u) ? C[i] : -INFINITY; smax = fmaxf(smax, C[i]); }
                smax = fmaxf(smax, __shfl_xor(smax, 32));
                const float m_new = fmaxf(m_run, smax);
                if (!__all(m_new == m_run)) {
                    const float alpha = __builtin_amdgcn_exp2f(m_run - m_new);
                    l_run *= alpha;
#pragma unroll
                    for (int c = 0; c < 4; ++c)
#pragma unroll
                        for (int i = 0; i < 16; ++i) O[c][i] *= alpha;
                    m_run = m_new;
                }
                float psum = 0.f;
#pragma unroll
                for (int i = 0; i < 16; ++i) { C[i] = __builtin_amdgcn_exp2f(C[i] - m_run); psum += C[i]; }
                l_run += psum;
                bf16x8 pf[2];
#pragma unroll
                for (int s2 = 0; s2 < 2; ++s2) { v4u w; w.x = pg8::cvt_pk_bf16(C[8 * s2 + 0], C[8 * s2 + 1]); w.y = pg8::cvt_pk_bf16(C[8 * s2 + 2], C[8 * s2 + 3]); w.z = pg8::cvt_pk_bf16(C[8 * s2 + 4], C[8 * s2 + 5]); w.w = pg8::cvt_pk_bf16(C[8 * s2 + 6], C[8 * s2 + 7]); pf[s2] = __builtin_bit_cast(bf16x8, w); }
#pragma unroll
                for (int c = 0; c < 4; ++c)
#pragma unroll
                    for (int s2 = 0; s2 < 2; ++s2) {
                        typedef short s16x4 __attribute__((ext_vector_type(4)));
                        const unsigned a0 = off_b(32 * g + 16 * s2 + 4 * hlf + q4, 4 * c + 2 * blk + (p4 >> 1)) + 8 * (p4 & 1);
                        const unsigned a1 = off_b(32 * g + 16 * s2 + 8 + 4 * hlf + q4, 4 * c + 2 * blk + (p4 >> 1)) + 8 * (p4 & 1);
                        const s16x4 lo4 = __builtin_bit_cast(s16x4, __builtin_amdgcn_ds_read_tr16_b64_v4i16((LAS s16x4*)(vb + a0)));
                        const s16x4 hi4 = __builtin_bit_cast(s16x4, __builtin_amdgcn_ds_read_tr16_b64_v4i16((LAS s16x4*)(vb + a1)));
                        const bf16x8 vf = (bf16x8){lo4[0], lo4[1], lo4[2], lo4[3], hi4[0], hi4[1], hi4[2], hi4[3]};
                        O[c] = __builtin_amdgcn_mfma_f32_32x32x16_bf16(vf, pf[s2], O[c], 0, 0, 0);
                    }
            }
        }
        if (more) {
#pragma unroll
            for (int i = 0; i < 2; ++i) { *(LAS v4u*)(kbuf + ((kt + 1) & 1) * 16384 + soff[i]) = sk[i]; *(LAS v4u*)(vbuf + ((kt + 1) & 1) * 16384 + soff[i]) = sv[i]; }
        }
        LDS_WAIT(); __syncthreads();
    }
    const float l_tot = l_run + __shfl_xor(l_run, 32);
    const float inv = 1.f / l_tot;
#pragma unroll
    for (int c = 0; c < 4; ++c)
#pragma unroll
        for (int g4 = 0; g4 < 4; ++g4) {
            const int d = 32 * c + 8 * g4 + 4 * hlf;
            f32x4 o; o[0] = O[c][4 * g4] * inv; o[1] = O[c][4 * g4 + 1] * inv; o[2] = O[c][4 * g4 + 2] * inv; o[3] = O[c][4 * g4 + 3] * inv;
            if (U.of32) *(GAS f32x4*)(U.of32 + (size_t)myrow * U.ldo + d) = o;
            const u32x2 gg = *(const GAS u32x2*)(U.gate + (size_t)myrow * U.ldg + d);
            const float g0 = __uint_as_float(gg.x << 16), g1 = __uint_as_float(gg.x & 0xffff0000u), g2 = __uint_as_float(gg.y << 16), g3 = __uint_as_float(gg.y & 0xffff0000u);
            u32x2 w; w.x = pg8::cvt_pk_bf16(o[0] * g0, o[1] * g1); w.y = pg8::cvt_pk_bf16(o[2] * g2, o[3] * g3);
            *(GAS u32x2*)(U.cat + (size_t)myrow * U.ldc + d) = w;
        }
}
__device__ __forceinline__ void p3_dsa_attn(const Args& A, LAS unsigned char* lds, int unit, float* a_f32) {
    const int b = unit >> 6, h = (unit >> 3) & 7, j = unit & 7;
    AttnUnit U;
    U.Q = (const bf16*)(A.ws + WS_QB) + h * DH; U.ldq = WA;
    U.K = (const bf16*)(A.ws + WS_KB) + (size_t)(b * T) * WA + h * DH; U.V = (const bf16*)(A.ws + WS_VB) + (size_t)(b * T) * WA + h * DH; U.ldkv = WA;
    U.mask = (const unsigned*)(A.ws + WS_MASK);
    U.qrow0 = b * T + 128 * j; U.qrow1 = b * T + 128 * (15 - j);
    U.ntile0 = 2 * (j + 1); U.ntile1 = 2 * (16 - j);
    U.pos0 = 128 * j; U.pos1 = 128 * (15 - j);
    U.cat = (bf16*)(A.ws + WS_CATB) + h * DH; U.ldc = DM;
    U.gate = (const bf16*)(A.ws + WS_GA) + h * DH; U.ldg = WA;
    U.of32 = a_f32 ? a_f32 + h * DH : nullptr; U.ldo = WA;
    attn_unit(U, lds);
}

__device__ __forceinline__ void p2_memattn(const Args& A, LAS unsigned char* lds, int unit, float* m_f32) {
    const int b = unit >> 5, hm = (unit >> 3) & 3, jq = unit & 7;
    AttnUnit U;
    U.Q = (const bf16*)(A.ws + WS_MQB) + hm * DH; U.ldq = WM;
    U.K = (const bf16*)(A.ws + WS_MKB) + (size_t)(b * NMEM) * WM + hm * DH; U.V = (const bf16*)(A.ws + WS_MVB) + (size_t)(b * NMEM) * WM + hm * DH; U.ldkv = WM;
    U.mask = nullptr;
    U.qrow0 = b * T + 128 * jq; U.qrow1 = b * T + 128 * (jq + 8);
    U.ntile0 = NMEM / 64; U.ntile1 = NMEM / 64; U.pos0 = 1 << 28; U.pos1 = 1 << 28;
    U.cat = (bf16*)(A.ws + WS_CATB) + WA + WB + hm * DH; U.ldc = DM;
    U.gate = (const bf16*)(A.ws + WS_GM) + hm * DH; U.ldg = WM;
    U.of32 = m_f32 ? m_f32 + hm * DH : nullptr; U.ldo = WM;
    attn_unit(U, lds);
}

typedef short s16x4 __attribute__((ext_vector_type(4)));
__device__ __forceinline__ bf16x8 tr_frag(const LAS unsigned char* img, unsigned row0, unsigned rstep, unsigned ch, unsigned hlf, unsigned q4, unsigned p4) {
    const unsigned a0 = off_b(row0 + q4, ch) + 8 * (p4 & 1), a1 = off_b(row0 + rstep + q4, ch) + 8 * (p4 & 1);
    const s16x4 lo4 = __builtin_bit_cast(s16x4, __builtin_amdgcn_ds_read_tr16_b64_v4i16((LAS s16x4*)(img + a0)));
    const s16x4 hi4 = __builtin_bit_cast(s16x4, __builtin_amdgcn_ds_read_tr16_b64_v4i16((LAS s16x4*)(img + a1)));
    return (bf16x8){lo4[0], lo4[1], lo4[2], lo4[3], hi4[0], hi4[1], hi4[2], hi4[3]};
}
__device__ __forceinline__ void hgrn1_unit(const Args& A, LAS unsigned char* lds, int unit) {
    const int tid = threadIdx.x, lane = tid & 63, wave = tid >> 6, r32 = lane & 31, hlf = lane >> 5;
    const unsigned blk = (lane >> 4) & 1, q4 = (lane & 15) >> 2, p4 = lane & 3;
    const int b = unit / (HB * NCH), hd = (unit / NCH) % HB, c = unit % NCH, r0 = b * T + 64 * c, col0 = hd * DK;
    const float* HQ = (const float*)(A.ws + WS_HQ); const float* HG = (const float*)(A.ws + WS_HG); const bf16* HV = (const bf16*)(A.ws + WS_HV);
    bf16* QABS = (bf16*)(A.ws + WS_QABS); float* OT = (float*)(A.ws + WS_OT) + (size_t)unit * 128 * 64; float* KVT = (float*)(A.ws + WS_KVT) + (size_t)unit * 128 * 128; float* EG = (float*)(A.ws + WS_EG) + (size_t)unit * 128;
    LAS float* Gs = (LAS float*)(lds + RING_OFF);
    LAS unsigned char* QT = lds + RING_OFF + 32768;
    LAS unsigned char* KT = QT + 16384;
    LAS unsigned char* KD = KT + 16384;
    LAS unsigned char* VI = KD + 16384;
    LAS unsigned char* KH = VI + 16384;
    LAS float* tot = (LAS float*)(KH + 8192);
    { const int d = tid & 127, tq = tid >> 7; float gl[16]; float run = 0.f;
#pragma unroll
      for (int i = 0; i < 16; ++i) { run += HG[(size_t)(r0 + 16 * tq + i) * WB + col0 + d]; gl[i] = run; }
      tot[tq * 128 + d] = run; LDS_WAIT(); __syncthreads();
      float offs = 0.f;
#pragma unroll
      for (int j = 0; j < 3; ++j) offs += (j < tq) ? tot[j * 128 + d] : 0.f;
#pragma unroll
      for (int i = 0; i < 16; ++i) Gs[(16 * tq + i) * 128 + d] = gl[i] + offs;
      LDS_WAIT(); __syncthreads(); }
#pragma unroll
    for (int it = 0; it < 2; ++it) {
        const int item = tid + 512 * it, t = item >> 4, d8 = item & 15, d0 = 8 * d8;
        const size_t go = (size_t)(r0 + t) * WB + col0 + d0;
        f32x4 q0 = *(const GAS f32x4*)(HQ + go), q1 = *(const GAS f32x4*)(HQ + go + 4), g0 = *(const GAS f32x4*)(HG + go), g1 = *(const GAS f32x4*)(HG + go + 4);
        const f32x4 G0 = *(const LAS f32x4*)(Gs + t * 128 + d0), G1 = *(const LAS f32x4*)(Gs + t * 128 + d0 + 4);
        const f32x4 M0 = *(const LAS f32x4*)(Gs + 31 * 128 + d0), M1 = *(const LAS f32x4*)(Gs + 31 * 128 + d0 + 4);
        const f32x4 E0 = *(const LAS f32x4*)(Gs + 63 * 128 + d0), E1 = *(const LAS f32x4*)(Gs + 63 * 128 + d0 + 4);
        f32x4 qt0, qt1, kt0, kt1, kd0, kd1, kh0, kh1, qa0, qa1;
#pragma unroll
        for (int e = 0; e < 4; ++e) {
            { const float G = G0[e], gs = t < 32 ? 0.f : M0[e], k = 1.f - expf(g0[e]);
              qt0[e] = q0[e] * expf(G - gs); kt0[e] = k * expf(gs - G); kd0[e] = k * expf(E0[e] - G); kh0[e] = k * expf(M0[e] - G); qa0[e] = q0[e] * expf(G); }
            { const float G = G1[e], gs = t < 32 ? 0.f : M1[e], k = 1.f - expf(g1[e]);
              qt1[e] = q1[e] * expf(G - gs); kt1[e] = k * expf(gs - G); kd1[e] = k * expf(E1[e] - G); kh1[e] = k * expf(M1[e] - G); qa1[e] = q1[e] * expf(G); }
        }
        const unsigned o = off_b(t, d8);
        *(LAS v4u*)(QT + o) = pack8(qt0, qt1); *(LAS v4u*)(KT + o) = pack8(kt0, kt1); *(LAS v4u*)(KD + o) = pack8(kd0, kd1);
        if (t < 32) *(LAS v4u*)(KH + o) = pack8(kh0, kh1);
        *(LAS v4u*)(VI + o) = *(const GAS v4u*)(HV + go);
        *(GAS v4u*)(QABS + go) = pack8(qa0, qa1);
        if (t == 63) { f32x4 x0, x1;
#pragma unroll
            for (int e = 0; e < 4; ++e) { x0[e] = expf(E0[e]); x1[e] = expf(E1[e]); }
            *(GAS f32x4*)(EG + d0) = x0; *(GAS f32x4*)(EG + d0 + 4) = x1; }
    }
    LDS_WAIT(); __syncthreads();
    if (wave < 4) {
        f32x16 acc[4];
#pragma unroll
        for (int db = 0; db < 4; ++db)
#pragma unroll
            for (int i = 0; i < 16; ++i) acc[db][i] = 0.f;
#pragma unroll
        for (int ks = 0; ks < 4; ++ks) {
            const bf16x8 vf = tr_frag(VI, 16 * ks + 8 * hlf, 4, 4 * wave + 2 * blk + (p4 >> 1), 0, q4, p4);
#pragma unroll
            for (int db = 0; db < 4; ++db) { const bf16x8 kf = tr_frag(KD, 16 * ks + 8 * hlf, 4, 4 * db + 2 * blk + (p4 >> 1), 0, q4, p4); acc[db] = __builtin_amdgcn_mfma_f32_32x32x16_bf16(vf, kf, acc[db], 0, 0, 0); }
        }
#pragma unroll
        for (int db = 0; db < 4; ++db)
#pragma unroll
            for (int i = 0; i < 16; ++i) KVT[(size_t)(32 * wave + (i & 3) + 8 * (i >> 2) + 4 * hlf) * 128 + 32 * db + r32] = acc[db][i];
    } else {
        const int x = wave - 4, tb = x & 1, vh = x >> 1;
        f32x16 oacc[2];
#pragma unroll
        for (int j = 0; j < 2; ++j)
#pragma unroll
            for (int i = 0; i < 16; ++i) oacc[j][i] = 0.f;
#pragma unroll
        for (int sb = 0; sb < 2; ++sb) {
            if (sb <= tb) {
                f32x16 X;
#pragma unroll
                for (int i = 0; i < 16; ++i) X[i] = 0.f;
                const LAS unsigned char* kimg = (sb == tb) ? KT : KH;
                const unsigned krow = (sb == tb) ? 32 * sb + r32 : r32;
#pragma unroll
                for (int ks = 0; ks < 8; ++ks) { const bf16x8 kf = *(const LAS bf16x8*)(kimg + off_b(krow, 2 * ks + hlf)); const bf16x8 qf = *(const LAS bf16x8*)(QT + off_b(32 * tb + r32, 2 * ks + hlf)); X = __builtin_amdgcn_mfma_f32_32x32x16_bf16(kf, qf, X, 0, 0, 0); }
                if (sb == tb) {
#pragma unroll
                    for (int i = 0; i < 16; ++i) { const int sl = (i & 3) + 8 * (i >> 2) + 4 * hlf; X[i] = sl <= r32 ? X[i] : 0.f; }
                }
                bf16x8 pf[2];
#pragma unroll
                for (int s2 = 0; s2 < 2; ++s2) { v4u w; w.x = pg8::cvt_pk_bf16(X[8 * s2 + 0], X[8 * s2 + 1]); w.y = pg8::cvt_pk_bf16(X[8 * s2 + 2], X[8 * s2 + 3]); w.z = pg8::cvt_pk_bf16(X[8 * s2 + 4], X[8 * s2 + 5]); w.w = pg8::cvt_pk_bf16(X[8 * s2 + 6], X[8 * s2 + 7]); pf[s2] = __builtin_bit_cast(bf16x8, w); }
#pragma unroll
                for (int j = 0; j < 2; ++j)
#pragma unroll
                    for (int s2 = 0; s2 < 2; ++s2) { const bf16x8 vf = tr_frag(VI, 32 * sb + 16 * s2 + 4 * hlf, 8, 4 * (2 * vh + j) + 2 * blk + (p4 >> 1), 0, q4, p4); oacc[j] = __builtin_amdgcn_mfma_f32_32x32x16_bf16(vf, pf[s2], oacc[j], 0, 0, 0); }
            }
        }
#pragma unroll
        for (int j = 0; j < 2; ++j)
#pragma unroll
            for (int i = 0; i < 16; ++i) OT[(size_t)(32 * (2 * vh + j) + (i & 3) + 8 * (i >> 2) + 4 * hlf) * 64 + 32 * tb + r32] = oacc[j][i];
    }
    LDS_WAIT(); __syncthreads();
}
__device__ __forceinline__ void hgrn2_scan(const Args& A, int G) {
    const float* KVT = (const float*)(A.ws + WS_KVT); const float* EG = (const float*)(A.ws + WS_EG); bf16* SCT = (bf16*)(A.ws + WS_SCT);
    const size_t gtid = (size_t)blockIdx.x * 512 + threadIdx.x, gthreads = (size_t)G * 512;
    for (size_t e = gtid; e < (size_t)NB * HB * 128 * 128; e += gthreads) {
        const int bh = (int)(e >> 14), vd = (int)(e & 16383), d = vd & 127, v = vd >> 7;
        float kv[NCH], eg[NCH];
#pragma unroll
        for (int c = 0; c < NCH; ++c) { kv[c] = KVT[((size_t)(bh * NCH + c) << 14) + vd]; eg[c] = EG[(size_t)(bh * NCH + c) * 128 + d]; }
        float S = 0.f;
#pragma unroll
        for (int c = 0; c < NCH; ++c) { SCT[((size_t)(bh * NCH + c) << 14) + vd] = (bf16)f2bf(S); S = fmaf(eg[c], S, kv[c]); }
        A.out[O_HP + ((size_t)bh * DK + d) * DV + v] = S;
    }
}
__device__ __forceinline__ void hgrn3_unit(const Args& A, LAS unsigned char* lds, int unit, float* bo_f32) {
    const int tid = threadIdx.x, lane = tid & 63, wave = tid >> 6, r32 = lane & 31, hlf = lane >> 5, vb = wave & 3, tb = wave >> 2;
    const int b = unit / (HB * NCH), hd = (unit / NCH) % HB, c = unit % NCH, r0 = b * T + 64 * c, col0 = hd * DK;
    const float* OT = (const float*)(A.ws + WS_OT) + (size_t)unit * 128 * 64; const bf16* SCT = (const bf16*)(A.ws + WS_SCT) + (size_t)unit * 128 * 128; const bf16* QABS = (const bf16*)(A.ws + WS_QABS);
    LAS float* ssq = (LAS float*)(lds + RING_OFF);
    f32x16 acc;
#pragma unroll
    for (int i = 0; i < 16; ++i) acc[i] = OT[(size_t)(32 * vb + (i & 3) + 8 * (i >> 2) + 4 * hlf) * 64 + 32 * tb + r32];
    if (c > 0) {
#pragma unroll
        for (int ks = 0; ks < 8; ++ks) {
            const bf16x8 sf = *(const GAS bf16x8*)(SCT + (size_t)(32 * vb + r32) * 128 + 16 * ks + 8 * hlf);
            const bf16x8 qf = *(const GAS bf16x8*)(QABS + (size_t)(r0 + 32 * tb + r32) * WB + col0 + 16 * ks + 8 * hlf);
            acc = __builtin_amdgcn_mfma_f32_32x32x16_bf16(sf, qf, acc, 0, 0, 0);
        }
    }
    float sq = 0.f;
#pragma unroll
    for (int i = 0; i < 16; ++i) sq = fmaf(acc[i], acc[i], sq);
    sq += __shfl_xor(sq, 32);
    if (hlf == 0) ssq[(tb * 4 + vb) * 32 + r32] = sq;
    LDS_WAIT(); __syncthreads();
    const float tot = (ssq[(tb * 4 + 0) * 32 + r32] + ssq[(tb * 4 + 1) * 32 + r32]) + (ssq[(tb * 4 + 2) * 32 + r32] + ssq[(tb * 4 + 3) * 32 + r32]);
    const float rs = rsqrtf(tot * (1.f / DV) + RMS_EPS);
    const int row = r0 + 32 * tb + r32;
    const bf16* GB = (const bf16*)(A.ws + WS_GB); bf16* CATb = (bf16*)(A.ws + WS_CATB);
#pragma unroll
    for (int g4 = 0; g4 < 4; ++g4) {
        const int v = 32 * vb + 8 * g4 + 4 * hlf;
        f32x4 o; o[0] = acc[4 * g4]; o[1] = acc[4 * g4 + 1]; o[2] = acc[4 * g4 + 2]; o[3] = acc[4 * g4 + 3];
        if (bo_f32) *(GAS f32x4*)(bo_f32 + (size_t)row * WB + col0 + v) = o;
        const f32x4 ng = *(const GAS f32x4*)(A.norm_g + v);
        const u32x2 gg = *(const GAS u32x2*)(GB + (size_t)row * WB + col0 + v);
        const float g0 = __uint_as_float(gg.x << 16), g1 = __uint_as_float(gg.x & 0xffff0000u), g2 = __uint_as_float(gg.y << 16), g3 = __uint_as_float(gg.y & 0xffff0000u);
        u32x2 w; w.x = pg8::cvt_pk_bf16(o[0] * rs * ng[0] * g0, o[1] * rs * ng[1] * g1); w.y = pg8::cvt_pk_bf16(o[2] * rs * ng[2] * g2, o[3] * rs * ng[3] * g3);
        *(GAS u32x2*)(CATb + (size_t)row * DM + WA + col0 + v) = w;
    }
    LDS_WAIT(); __syncthreads();
}

__device__ __forceinline__ float bf2f(unsigned short h) { return __uint_as_float((unsigned)h << 16); }
__device__ __forceinline__ void s1_unit(const Args& A, int r) {
    const float* z = (const float*)(A.ws + WS_ZS) + (size_t)r * NIN; const float2* ropeA = (const float2*)(A.ws + WS_ROPEA) + (size_t)(T + (r & (ST - 1))) * 16;
    for (int c = threadIdx.x; c < WA; c += 512) {
        const int d = c & 127; float k = z[C_AK + c];
        if (d < 32) { const int j = d & 15; const bool lo = d < 16; const float x1 = z[C_AK + (lo ? c : c - 16)], x2 = z[C_AK + (lo ? c + 16 : c)]; const float2 cs = ropeA[j]; k = lo ? x1 * cs.x - x2 * cs.y : x2 * cs.x + x1 * cs.y; }
        A.out[O_KS + (size_t)r * WA + c] = k; A.out[O_VS + (size_t)r * WA + c] = z[C_AV + c];
    }
}
__device__ __forceinline__ void s2_unit(const Args& A, int unit) {
    const int tid = threadIdx.x, lane = tid & 63, wave = tid >> 6, r32 = lane & 31, hlf = lane >> 5, qp = wave & 3, kh = wave >> 2;
    const int b = unit >> 7, pg = unit & 127;
    const float* Zs = (const float*)(A.ws + WS_ZS); const float* IW = (const float*)(A.ws + WS_IW); const float2* ropeI = (const float2*)(A.ws + WS_ROPEI); float* SCs = (float*)(A.ws + WS_SCS);
    const int qa = (r32 >> 2) & 1, ha = (r32 & 3) + 4 * (r32 >> 3), qrow = b * ST + 2 * qp + qa;
    const float* src = Zs + (size_t)qrow * NIN + C_IQ + ha * DI;
    bf16x8 aq[4];
    { f32x4 x1a = *(const GAS f32x4*)(src), x1b = *(const GAS f32x4*)(src + 4), x2a = *(const GAS f32x4*)(src + 8), x2b = *(const GAS f32x4*)(src + 12);
      const GAS f32x4* cp = (const GAS f32x4*)(ropeI + (size_t)(T + 2 * qp + qa) * 8);
      f32x4 o0, o1;
#pragma unroll
      for (int q = 0; q < 2; ++q) { const f32x4 c01 = cp[q], c23 = cp[2 + q];
          const float a0 = x1a[2 * q], a1 = x1a[2 * q + 1], b0 = x2a[2 * q], b1 = x2a[2 * q + 1], a2 = x1b[2 * q], a3 = x1b[2 * q + 1], b2 = x2b[2 * q], b3 = x2b[2 * q + 1];
          o0[2 * q] = hlf == 0 ? a0 * c01[0] - b0 * c01[1] : b0 * c01[0] + a0 * c01[1]; o0[2 * q + 1] = hlf == 0 ? a1 * c01[2] - b1 * c01[3] : b1 * c01[2] + a1 * c01[3];
          o1[2 * q] = hlf == 0 ? a2 * c23[0] - b2 * c23[1] : b2 * c23[0] + a2 * c23[1]; o1[2 * q + 1] = hlf == 0 ? a3 * c23[2] - b3 * c23[3] : b3 * c23[2] + a3 * c23[3]; }
      aq[0] = __builtin_bit_cast(bf16x8, pack8(o0 * 0.125f, o1 * 0.125f)); }
#pragma unroll
    for (int ks = 1; ks < 4; ++ks) { const f32x4 v0 = *(const GAS f32x4*)(src + 16 * ks + 8 * hlf), v1 = *(const GAS f32x4*)(src + 16 * ks + 8 * hlf + 4); aq[ks] = __builtin_bit_cast(bf16x8, pack8(v0 * 0.125f, v1 * 0.125f)); }
    float wv[16];
    { const GAS f32x4* wp = (const GAS f32x4*)(IW + (size_t)(MP + b * ST + 2 * qp + hlf) * HI);
#pragma unroll
      for (int q = 0; q < 4; ++q) { const f32x4 w4 = wp[q]; wv[4 * q] = w4[0]; wv[4 * q + 1] = w4[1]; wv[4 * q + 2] = w4[2]; wv[4 * q + 3] = w4[3]; } }
    const int phys = A.page_table[b * NPAGES + pg];
#pragma unroll
    for (int g = 0; g < 2; ++g) {
        const int key = 64 * kh + 32 * g + r32;
        const float* kr = A.cache_idx_k + ((size_t)phys * PAGE + key) * DI;
        f32x16 C;
#pragma unroll
        for (int i = 0; i < 16; ++i) C[i] = 0.f;
#pragma unroll
        for (int ks = 0; ks < 4; ++ks) { const f32x4 v0 = *(const GAS f32x4*)(kr + 16 * ks + 8 * hlf), v1 = *(const GAS f32x4*)(kr + 16 * ks + 8 * hlf + 4); const bf16x8 kf = __builtin_bit_cast(bf16x8, pack8(v0, v1)); C = __builtin_amdgcn_mfma_f32_32x32x16_bf16(aq[ks], kf, C, 0, 0, 0); }
        float sc = 0.f;
#pragma unroll
        for (int i = 0; i < 16; ++i) sc = fmaf(wv[i], fmaxf(C[i], 0.f), sc);
        SCs[(size_t)(b * ST + 2 * qp + hlf) * LDSC + pg * PAGE + key] = sc;
    }
}
__device__ __forceinline__ void s2n_unit(const Args& A, int b) {
    const int tid = threadIdx.x, lane = tid & 63, t = tid >> 6, key = lane >> 3, hp = lane & 7;
    const float* Zs = (const float*)(A.ws + WS_ZS); const float* IW = (const float*)(A.ws + WS_IW); const float2* ropeI = (const float2*)(A.ws + WS_ROPEI) + (size_t)(T + t) * 8; float* SCs = (float*)(A.ws + WS_SCS);
    const float* kr = A.out + O_IKS + (size_t)(b * ST + key) * DI;
    float part = 0.f;
#pragma unroll
    for (int hh = 0; hh < 2; ++hh) {
        const int h = 2 * hp + hh; const float* q = Zs + (size_t)(b * ST + t) * NIN + C_IQ + h * DI;
        float dot = 0.f;
        for (int d = 0; d < DI; ++d) { float qv = q[d]; if (d < 16) { const int j = d & 7; const float x1 = q[j], x2 = q[j + 8]; const float2 cs = ropeI[j]; qv = d < 8 ? x1 * cs.x - x2 * cs.y : x2 * cs.x + x1 * cs.y; } dot = fmaf(qv, kr[d], dot); }
        part += IW[(size_t)(MP + b * ST + t) * HI + h] * fmaxf(dot * 0.125f, 0.f);
    }
    part += __shfl_xor(part, 1); part += __shfl_xor(part, 2); part += __shfl_xor(part, 4);
    if (hp == 0 && key <= t) SCs[(size_t)(b * ST + t) * LDSC + PAST + key] = part;
}
__device__ __forceinline__ void s3_unit(const Args& A, LAS unsigned char* lds, int unit, float* bo_f32) {
    const int tid = threadIdx.x, v = tid & 127, dq = tid >> 7, b = unit >> 2, hd = unit & 3;
    const float* Zs = (const float*)(A.ws + WS_ZS); const float* lbv = (const float*)(A.ws + WS_LB); bf16* CATb = (bf16*)(A.ws + WS_CATB);
    LAS float* qs = (LAS float*)(lds + RING_OFF); LAS float* fs = qs + 128; LAS float* ks = fs + 128; LAS float* vs = ks + 128; LAS float* red = vs + 128; LAS float* ssq = red + 512;
    float S[32];
#pragma unroll
    for (int i = 0; i < 32; ++i) S[i] = A.state_hgrn[(((size_t)b * HB + hd) * DK + dq * 32 + i) * DV + v];
    for (int t = 0; t < ST; ++t) {
        const int r = b * ST + t; const float* z = Zs + (size_t)r * NIN;
        __syncthreads();
        if (tid < 128) { qs[tid] = silu_f(z[C_BQ + hd * DK + tid]); const float lb = lbv[hd * DK + tid]; const float f = lb + (1.f - lb) * sigmoid_f(z[C_BF + hd * DK + tid]); fs[tid] = f; ks[tid] = 1.f - f; }
        else if (tid < 256) vs[tid - 128] = z[C_BI + hd * DV + (tid - 128)];
        LDS_WAIT(); __syncthreads();
        const float vv = vs[v]; float o = 0.f;
#pragma unroll
        for (int i = 0; i < 32; ++i) { const int d = dq * 32 + i; S[i] = fs[d] * S[i] + ks[d] * vv; o = fmaf(qs[d], S[i], o); }
        red[dq * 128 + v] = o;
        LDS_WAIT(); __syncthreads();
        float oo = 0.f;
        if (tid < 128) { oo = (red[v] + red[128 + v]) + (red[256 + v] + red[384 + v]); const float sq = wave_sum(oo * oo); if ((tid & 63) == 0) ssq[tid >> 6] = sq; }
        LDS_WAIT(); __syncthreads();
        if (tid < 128) { const float rs = rsqrtf((ssq[0] + ssq[1]) * (1.f / DV) + RMS_EPS);
            if (bo_f32) bo_f32[(size_t)(MP + r) * WB + hd * DV + v] = oo;
            CATb[(size_t)(MP + r) * DM + WA + hd * DV + v] = (bf16)f2bf(oo * rs * A.norm_g[v] * silu_f(z[C_BG + hd * DV + v])); }
    }
#pragma unroll
    for (int i = 0; i < 32; ++i) A.out[O_HS + (((size_t)b * HB + hd) * DK + dq * 32 + i) * DV + v] = S[i];
    __syncthreads();
}
__device__ __forceinline__ void s4_unit(const Args& A, LAS unsigned char* lds, int unit, float* m_f32) {
    const int tid = threadIdx.x, sub = tid >> 8, t8 = tid & 255, h = t8 >> 6, l = t8 & 63, r = unit * 2 + sub, b = r >> 3;
    const float* z = (const float*)(A.ws + WS_ZS) + (size_t)r * NIN; bf16* CATb = (bf16*)(A.ws + WS_CATB);
    LAS float* q = (LAS float*)(lds + RING_OFF) + sub * 512; LAS float* p = (LAS float*)(lds + RING_OFF) + 1024 + sub * 1024 + h * 256;
    for (int i = t8; i < WM; i += 256) q[i] = z[C_MQ + i];
    LDS_WAIT(); __syncthreads();
    float mx = -INFINITY;
    for (int n = l; n < NMEM; n += 64) {
        const GAS f32x4* kr = (const GAS f32x4*)(A.cache_mem_k + ((size_t)(b * NMEM + n) * HM + h) * DH);
        float dot = 0.f;
#pragma unroll 8
        for (int d4 = 0; d4 < DH / 4; ++d4) { const f32x4 kv = kr[d4]; const LAS float* qq = q + h * DH + d4 * 4; dot = fmaf(qq[0], kv[0], dot); dot = fmaf(qq[1], kv[1], dot); dot = fmaf(qq[2], kv[2], dot); dot = fmaf(qq[3], kv[3], dot); }
        dot *= SM_SCALE; p[n] = dot; mx = fmaxf(mx, dot);
    }
#pragma unroll
    for (int o = 32; o >= 1; o >>= 1) mx = fmaxf(mx, __shfl_xor(mx, o));
    float sum = 0.f;
    for (int n = l; n < NMEM; n += 64) { const float e = expf(p[n] - mx); p[n] = e; sum += e; }
    sum = wave_sum(sum);
    LDS_WAIT(); __syncthreads();
    float a0 = 0.f, a1 = 0.f;
    for (int n = 0; n < NMEM; ++n) { const float* vr = A.cache_mem_v + ((size_t)(b * NMEM + n) * HM + h) * DH + l * 2; const float pn = p[n]; a0 = fmaf(pn, vr[0], a0); a1 = fmaf(pn, vr[1], a1); }
    const float inv = 1.f / sum; a0 *= inv; a1 *= inv;
    if (m_f32) { m_f32[(size_t)(MP + r) * WM + h * DH + l * 2] = a0; m_f32[(size_t)(MP + r) * WM + h * DH + l * 2 + 1] = a1; }
    *(GAS unsigned*)(CATb + (size_t)(MP + r) * DM + WA + WB + h * DH + l * 2) = pk2(a0 * silu_f(z[C_MG + h * DH + l * 2]), a1 * silu_f(z[C_MG + h * DH + l * 2 + 1]));
    __syncthreads();
}
__device__ __forceinline__ void s5_unit(const Args& A, LAS unsigned char* lds, int r) {
    const int tid = threadIdx.x, lane = tid & 63, wave = tid >> 6, n = PAST + (r & (ST - 1)) + 1;
    const float* sc = (const float*)(A.ws + WS_SCS) + (size_t)r * LDSC; int* sel = (int*)(A.ws + WS_SELS) + (size_t)r * TOPK;
    LAS float* red = (LAS float*)(lds + RING_OFF);
    LAS int* cnts = (LAS int*)(lds + RING_OFF + 64);
    LAS int* ctr = (LAS int*)(lds + RING_OFF + 128);
    LAS float* cand = (LAS float*)(lds + RING_OFF + 256);
    constexpr int NV = (NKEYS_S + 511) / 512;
    float x[NV];
#pragma unroll
    for (int i = 0; i < NV; ++i) { const int s = i * 512 + tid; x[i] = s < n ? sc[s] : -INFINITY; }
    float mn = INFINITY, mx = -INFINITY;
#pragma unroll
    for (int i = 0; i < NV; ++i) { const int s = i * 512 + tid; mn = fminf(mn, s < n ? x[i] : INFINITY); mx = fmaxf(mx, x[i]); }
#pragma unroll
    for (int o = 1; o < 64; o <<= 1) { mn = fminf(mn, __shfl_xor(mn, o)); mx = fmaxf(mx, __shfl_xor(mx, o)); }
    if (lane == 0) { red[wave] = mn; red[8 + wave] = mx; }
    if (tid < 4) ctr[tid] = 0;
    LDS_WAIT(); __syncthreads();
    mn = red[0]; mx = red[8];
#pragma unroll
    for (int w = 1; w < 8; ++w) { mn = fminf(mn, red[w]); mx = fmaxf(mx, red[8 + w]); }
    float lo = mn, hi = INFINITY; int c_lo = n, c_hi = 0;
    for (int it = 0; it < 96 && c_lo - c_hi > 512; ++it) {
        const float hf = (hi == INFINITY) ? mx : hi;
        const float mid = lo + 0.5f * (hf - lo);
        if (!(mid > lo) || (hi != INFINITY && !(mid < hi))) break;
        int c = 0;
#pragma unroll
        for (int i = 0; i < NV; ++i) c += __popcll(__ballot(x[i] >= mid));
        __syncthreads();
        if (lane == 0) cnts[wave] = c;
        LDS_WAIT(); __syncthreads();
        c = 0;
#pragma unroll
        for (int w = 0; w < 8; ++w) c += cnts[w];
        if (c >= TOPK) { lo = mid; c_lo = c; } else { hi = mid; c_hi = c; }
    }
    const int m = c_lo - c_hi, rr = TOPK - c_hi;
#pragma unroll
    for (int i = 0; i < NV; ++i) { if (x[i] >= lo && x[i] < hi) { const int pos = __hip_atomic_fetch_add(ctr, 1, __ATOMIC_RELAXED, __HIP_MEMORY_SCOPE_WORKGROUP); if (pos < 1024) { cand[2 * pos] = x[i]; cand[2 * pos + 1] = __int_as_float(i * 512 + tid); } } }
    LDS_WAIT(); __syncthreads();
    float thr_v = lo; int thr_s = 0x7fffffff;
    if (m <= 1024) {
        LAS float* res = red;
        for (int c0 = 0; c0 < m; c0 += 512) {
            const int cme = c0 + tid; const bool have = cme < m;
            const float v = have ? cand[2 * cme] : 0.f; const int sidx = have ? __float_as_int(cand[2 * cme + 1]) : 0;
            int rank = 0;
            for (int j = 0; j < m; ++j) { const float ov = cand[2 * j]; const int os = __float_as_int(cand[2 * j + 1]); rank += (ov > v || (ov == v && os < sidx)) ? 1 : 0; }
            if (have && rank == rr - 1) { res[0] = v; res[1] = __int_as_float(sidx); }
        }
        LDS_WAIT(); __syncthreads();
        thr_v = red[0]; thr_s = __float_as_int(red[1]);
    }
    int tot = 0;
#pragma unroll
    for (int i = 0; i < NV; ++i) { const int s = i * 512 + tid; tot += __popcll(__ballot(x[i] > thr_v || (x[i] == thr_v && s <= thr_s))); }
    __syncthreads();
    if (lane == 0) cnts[wave] = tot;
    LDS_WAIT(); __syncthreads();
    int run = 0;
#pragma unroll
    for (int w = 0; w < 8; ++w) run += (w < wave) ? cnts[w] : 0;
#pragma unroll
    for (int i = 0; i < NV; ++i) { const int s = i * 512 + tid; const bool on = x[i] > thr_v || (x[i] == thr_v && s <= thr_s); const unsigned long long bal = __ballot(on);
        if (on) { const int pos = run + __popcll(bal & ((1ull << lane) - 1ull)); if (pos < TOPK) sel[pos] = s; }
        run += __popcll(bal); }
    __syncthreads();
}
__device__ __forceinline__ void s6_unit(const Args& A, LAS unsigned char* lds, int unit, float* a_f32) {
    const int tid = threadIdx.x, r = unit >> 3, h = unit & 7, b = r >> 3, t = r & 7;
    const float* z = (const float*)(A.ws + WS_ZS) + (size_t)r * NIN; const int* sel = (const int*)(A.ws + WS_SELS) + (size_t)r * TOPK; bf16* CATb = (bf16*)(A.ws + WS_CATB);
    const float2* ropeA = (const float2*)(A.ws + WS_ROPEA) + (size_t)(T + t) * 16;
    LAS float* q = (LAS float*)(lds + RING_OFF); LAS float* p = q + 128; LAS float* red = p + 256; LAS float* part = red + 32;
    LAS int* sl = (LAS int*)(part + 2048);
    if (tid < 128) { const int d = tid; float qv = z[C_AQ + h * DH + d];
        if (d < 32) { const int j = d & 15; const bool lo = d < 16; const float x1 = z[C_AQ + h * DH + j], x2 = z[C_AQ + h * DH + j + 16]; const float2 cs = ropeA[j]; qv = lo ? x1 * cs.x - x2 * cs.y : x2 * cs.x + x1 * cs.y; }
        q[d] = qv * SM_SCALE; }
    if (tid < 256) sl[tid] = sel[tid];
    LDS_WAIT(); __syncthreads();
    { const int kidx = tid >> 1, half = tid & 1, s = sl[kidx];
      const float* kr = s >= PAST ? A.out + O_KS + (size_t)(b * ST + (s - PAST)) * WA + h * DH : A.cache_k + ((size_t)A.page_table[b * NPAGES + (s >> 7)] * PAGE + (s & 127)) * WA + h * DH;
      const GAS f32x4* k4 = (const GAS f32x4*)(kr + 64 * half); float dot = 0.f;
#pragma unroll
      for (int d4 = 0; d4 < 16; ++d4) { const f32x4 kv = k4[d4]; const LAS float* qq = q + 64 * half + 4 * d4; dot = fmaf(qq[0], kv[0], dot); dot = fmaf(qq[1], kv[1], dot); dot = fmaf(qq[2], kv[2], dot); dot = fmaf(qq[3], kv[3], dot); }
      dot += __shfl_xor(dot, 1);
      if (half == 0) p[kidx] = dot; }
    LDS_WAIT(); __syncthreads();
    float mx = -INFINITY;
    if (tid < 256) mx = p[tid];
#pragma unroll
    for (int o = 1; o < 64; o <<= 1) mx = fmaxf(mx, __shfl_xor(mx, o));
    if ((tid & 63) == 0) red[tid >> 6] = mx;
    LDS_WAIT(); __syncthreads();
    mx = fmaxf(fmaxf(red[0], red[1]), fmaxf(red[2], red[3]));
    float e = 0.f;
    if (tid < 256) { e = expf(p[tid] - mx); }
    const float esum = wave_sum(e);
    __syncthreads();
    if (tid < 256) p[tid] = e;
    if ((tid & 63) == 0) red[8 + (tid >> 6)] = esum;
    LDS_WAIT(); __syncthreads();
    const float inv = 1.f / ((red[8] + red[9]) + (red[10] + red[11]));
    { const int d4 = tid & 31, kp = tid >> 5; f32x4 acc = (f32x4){0.f, 0.f, 0.f, 0.f};
#pragma unroll 4
      for (int i = 0; i < 16; ++i) { const int kidx = kp * 16 + i, s = sl[kidx];
          const float* vr = s >= PAST ? A.out + O_VS + (size_t)(b * ST + (s - PAST)) * WA + h * DH : A.cache_v + ((size_t)A.page_table[b * NPAGES + (s >> 7)] * PAGE + (s & 127)) * WA + h * DH;
          const f32x4 vv = *((const GAS f32x4*)vr + d4); acc = acc + vv * p[kidx]; }
      *(LAS f32x4*)(part + kp * 128 + 4 * d4) = acc; }
    LDS_WAIT(); __syncthreads();
    if (tid < 128) { float o = 0.f;
#pragma unroll
        for (int kp = 0; kp < 16; ++kp) o += part[kp * 128 + tid];
        o *= inv;
        if (a_f32) a_f32[(size_t)(MP + r) * WA + h * DH + tid] = o;
        CATb[(size_t)(MP + r) * DM + h * DH + tid] = (bf16)f2bf(o * silu_f(z[C_AG + h * DH + tid])); }
    __syncthreads();
}

__global__ void __launch_bounds__(NWAVES * 64, 2) mega_fwd(Args args) {
    extern __shared__ __attribute__((aligned(16))) unsigned char lds_raw[];
    LAS unsigned char* lds = (LAS unsigned char*)lds_raw;
    volatile LAS unsigned* MISC = (volatile LAS unsigned*)(lds + MISC_OFF);
    const int tid = threadIdx.x, G = gridDim.x;
    unsigned char* ws = args.ws;
    gu32* ctl = (gu32*)(ws + WS_CTL);
    for (int u = tid; u < (LDS_BYTES - LDSCTL_OFF) / 4; u += NWAVES * 64) ((LAS unsigned*)(lds + LDSCTL_OFF))[u] = 0u;
    __syncthreads();
    XcdBarrier bar = xcd_barrier_post((unsigned*)(ctl + CW_BAR) + args.li * XCD_BAR_WORDS, MISC + 8);
    const int lo = args.ph_lo, hi = args.ph_hi;
#define IN(k) (lo <= (k) && (k) < hi)
#define BOTH(k) (IN(k) && IN((k) + 1))
    if (IN(0)) { p0_prologue(args, lds, G); if (BOTH(0)) xcd_barrier(bar); }
    if (IN(1)) {
        pg8::Gemm g{(const pg8::bf16_t*)(ws + WS_XB), (const pg8::bf16_t*)(ws + WS_WMAIN), MP, NMAIN, DM};
        pg8::StaticOrder S; S.init(MP, NMAIN, G, (int)blockIdx.x);
        EpiIn E{args.out, (float*)(ws + WS_Z), (bf16*)(ws + WS_QB), (bf16*)(ws + WS_KB), (bf16*)(ws + WS_VB), (bf16*)(ws + WS_GA), (bf16*)(ws + WS_IQB), (bf16*)(ws + WS_HV), (bf16*)(ws + WS_GB),
                (bf16*)(ws + WS_MQB), (bf16*)(ws + WS_GM), (float*)(ws + WS_HQ), (float*)(ws + WS_HG), (const float2*)(ws + WS_ROPEA), (const float2*)(ws + WS_ROPEI), (const float*)(ws + WS_LB)};
        pg8::gemm_phase<EpiIn, pg8::StaticOrder, true, true>(lds + RING_OFF, g, S, E);
        p1_small(args, G);
        if (BOTH(1)) xcd_barrier(bar);
    }
    if (IN(2)) {
        for (int u = blockIdx.x; u < 256; u += G) p2_indexer(args, lds, u);
        for (int u = blockIdx.x; u < NHU; u += G) hgrn1_unit(args, lds, u);
        for (int u = (int)blockIdx.x - 128; u < 128; u += G) if (u >= 0) p2_memattn(args, lds, u, args.dbg_mout);
        for (int u = blockIdx.x; u < SB * NPAGES; u += G) s2_unit(args, u);
        for (int u = blockIdx.x; u < SB; u += G) s2n_unit(args, u);
        for (int u = (int)blockIdx.x - 8; u < MS; u += G) if (u >= 0) s1_unit(args, u);
        for (int u = (int)blockIdx.x - 72; u < SB * HB; u += G) if (u >= 0) s3_unit(args, lds, u, args.dbg_bo);
        for (int u = (int)blockIdx.x - 104; u < MS / 2; u += G) if (u >= 0) s4_unit(args, lds, u, args.dbg_mout);
        if (BOTH(2)) xcd_barrier(bar);
    }
    if (IN(3)) {
        for (int u = blockIdx.x; u < 256; u += G) p3_dsa_attn(args, lds, u, args.dbg_aout);
        hgrn2_scan(args, G);
        for (int u = (int)blockIdx.x - 192; u < MS; u += G) if (u >= 0) s5_unit(args, lds, u);
        if (BOTH(3)) xcd_barrier(bar);
    }
    if (IN(4)) {
        for (int u = blockIdx.x; u < NHU; u += G) hgrn3_unit(args, lds, u, args.dbg_bo);
        for (int u = blockIdx.x; u < MS * HA; u += G) s6_unit(args, lds, u, args.dbg_aout);
        if (BOTH(4)) xcd_barrier(bar);
    }
    if (IN(5)) {
        pg8::Gemm g{(const pg8::bf16_t*)(ws + WS_CATB), (const pg8::bf16_t*)(ws + WS_WOUT), MP, DM, DM};
        pg8::StaticOrder S; S.init(MP, DM, G, (int)blockIdx.x);
        EpiOut E{args.x_prompt, args.out + O_YP};
        pg8::gemm_phase<EpiOut, pg8::StaticOrder, true, true>(lds + RING_OFF, g, S, E);
        p5_small(args, G);
        if (BOTH(5)) xcd_barrier(bar);
    }
    if (IN(6)) { p6_layernorm(args, G); }
#undef IN
#undef BOTH
}

#if HYBRID
__global__ void __launch_bounds__(256) gemm_nn(const float* __restrict__ A, const float* __restrict__ B, float* __restrict__ C, int M, int N, int K, int lda, int ldb, int ldc) {
    __shared__ float As[16][64 + 4];
    __shared__ float Bs[16][64 + 4];
    const int tid = threadIdx.x, tx = tid & 15, ty = tid >> 4;
    const int m0 = blockIdx.y * 64, n0 = blockIdx.x * 64;
    float acc[4][4] = {};
    for (int k0 = 0; k0 < K; k0 += 16) {
        for (int i = tid; i < 64 * 16; i += 256) { const int r = i >> 4, c = i & 15; As[c][r] = A[(size_t)(m0 + r) * lda + k0 + c]; }
        for (int i = tid; i < 16 * 64; i += 256) { const int r = i >> 6, c = i & 63; Bs[r][c] = (n0 + c < N) ? B[(size_t)(k0 + r) * ldb + n0 + c] : 0.f; }
        __syncthreads();
#pragma unroll
        for (int kk = 0; kk < 16; ++kk) {
            float a[4], b[4];
#pragma unroll
            for (int i = 0; i < 4; ++i) { a[i] = As[kk][ty * 4 + i]; b[i] = Bs[kk][tx * 4 + i]; }
#pragma unroll
            for (int i = 0; i < 4; ++i)
#pragma unroll
                for (int j = 0; j < 4; ++j) acc[i][j] = fmaf(a[i], b[j], acc[i][j]);
        }
        __syncthreads();
    }
#pragma unroll
    for (int i = 0; i < 4; ++i)
#pragma unroll
        for (int j = 0; j < 4; ++j) { const int n = n0 + tx * 4 + j; if (n < N) C[(size_t)(m0 + ty * 4 + i) * ldc + n] = acc[i][j]; }
}
__device__ __forceinline__ int row_pos(int row) { return row < MP ? (row % T) : (PAST + ((row - MP) % ST)); }
__device__ __forceinline__ void rope_pair(float x1, float x2, int pos, int j, int half, float& o1, float& o2) {
    float c, s; rope_cs(pos, j, half, c, s);
    o1 = x1 * c - x2 * s; o2 = x2 * c + x1 * s;
}
__global__ void __launch_bounds__(256) post_rows(const float* __restrict__ Z, float* __restrict__ Qr, float* __restrict__ IQr, float* __restrict__ out, int write_prompt_out, int write_sample_idx) {
    const int row = blockIdx.x, pos = row_pos(row);
    const float* z = Z + (size_t)row * NIN;
    float* kout = row < MP ? out + O_KP + (size_t)row * WA : out + O_KS + (size_t)(row - MP) * WA;
    float* vout = row < MP ? out + O_VP + (size_t)row * WA : out + O_VS + (size_t)(row - MP) * WA;
    float* ikout = row < MP ? out + O_IKP + (size_t)row * DI : out + O_IKS + (size_t)(row - MP) * DI;
    const bool wkv = row < MP ? write_prompt_out != 0 : true;
    const bool wik = row < MP ? write_prompt_out != 0 : write_sample_idx != 0;
    for (int c = threadIdx.x; c < WA; c += 256) {
        const int d = c & 127;
        float q = z[C_AQ + c], k = z[C_AK + c];
        if (d < 32) {
            const int j = d & 15; const bool lo = d < 16; const int c1 = lo ? c : c - 16, c2 = c1 + 16;
            float o1, o2; rope_pair(z[C_AQ + c1], z[C_AQ + c2], pos, j, 16, o1, o2); q = lo ? o1 : o2;
            rope_pair(z[C_AK + c1], z[C_AK + c2], pos, j, 16, o1, o2); k = lo ? o1 : o2;
        }
        Qr[(size_t)row * WA + c] = q; if (wkv) { kout[c] = k; vout[c] = z[C_AV + c]; }
        const int di = c & 63;
        float iq = z[C_IQ + c];
        if (di < 16) { const int j = di & 7; const bool lo = di < 8; const int c1 = lo ? c : c - 8, c2 = c1 + 8; float o1, o2; rope_pair(z[C_IQ + c1], z[C_IQ + c2], pos, j, 8, o1, o2); iq = lo ? o1 : o2; }
        IQr[(size_t)row * WA + c] = iq;
    }
    if (wik) for (int c = threadIdx.x; c < DI; c += 256) {
        float ik = z[C_IK + c];
        if (c < 16) { const int j = c & 7; const bool lo = c < 8; const int c1 = lo ? c : c - 8, c2 = c1 + 8; float o1, o2; rope_pair(z[C_IK + c1], z[C_IK + c2], pos, j, 8, o1, o2); ik = lo ? o1 : o2; }
        ikout[c] = ik;
    }
}
__device__ __forceinline__ const float* idx_key_row(int row, int s, const float* out, const float* cache_idx_k, const int* page_table) {
    if (row < MP) { const int b = row / T; return out + O_IKP + (size_t)(b * T + s) * DI; }
    const int b = (row - MP) / ST;
    if (s >= PAST) return out + O_IKS + (size_t)(b * ST + (s - PAST)) * DI;
    const int pg = page_table[b * NPAGES + s / PAGE];
    return cache_idx_k + ((size_t)pg * PAGE + (s % PAGE)) * DI;
}
__global__ void __launch_bounds__(256) idx_scores(const float* __restrict__ Z, const float* __restrict__ IQr, const float* out, const float* __restrict__ cache_idx_k, const int* __restrict__ page_table,
                                                   float* __restrict__ SC, int row0, int ldsc) {
    __shared__ float q[HI * DI];
    __shared__ float w[HI];
    const int row = row0 + blockIdx.y;
    const int nk = row < MP ? (row % T) + 1 : PAST + ((row - MP) % ST) + 1;
    for (int i = threadIdx.x; i < HI * DI; i += 256) q[i] = IQr[(size_t)row * WA + i];
    if (threadIdx.x < HI) w[threadIdx.x] = Z[(size_t)row * NIN + C_IW + threadIdx.x] * 0.25f;
    __syncthreads();
    const int s = blockIdx.x * 256 + threadIdx.x;
    if (s >= nk) return;
    const float4* kr = (const float4*)idx_key_row(row, s, out, cache_idx_k, page_table);
    float acc = 0.f;
    for (int h = 0; h < HI; ++h) {
        float dot = 0.f;
#pragma unroll
        for (int d4 = 0; d4 < DI / 4; ++d4) { const float4 kv = kr[d4]; const float* qq = q + h * DI + d4 * 4;
            dot = fmaf(qq[0], kv.x, dot); dot = fmaf(qq[1], kv.y, dot); dot = fmaf(qq[2], kv.z, dot); dot = fmaf(qq[3], kv.w, dot); }
        dot *= 0.125f;
        acc += w[h] * fmaxf(dot, 0.f);
    }
    SC[(size_t)blockIdx.y * ldsc + s] = acc;
}
__global__ void __launch_bounds__(256) idx_select(const float* __restrict__ SC, int* __restrict__ sel, int row0, int ldsc) {
    __shared__ float tile[1024];
    const int row = row0 + blockIdx.y;
    const int nk = row < MP ? (row % T) + 1 : PAST + ((row - MP) % ST) + 1;
    const float* sc = SC + (size_t)blockIdx.y * ldsc;
    const int s = blockIdx.x * 256 + threadIdx.x;
    if (blockIdx.x * 256 >= nk) return;
    const float mine = s < nk ? sc[s] : 0.f;
    int rank = 0;
    for (int t0 = 0; t0 < nk; t0 += 1024) {
        __syncthreads();
        for (int i = threadIdx.x; i < 1024; i += 256) tile[i] = (t0 + i < nk) ? sc[t0 + i] : -INFINITY;
        __syncthreads();
        const int lim = min(1024, nk - t0);
        for (int i = 0; i < lim; ++i) { const float o = tile[i]; rank += (o > mine || (o == mine && (t0 + i) < s)) ? 1 : 0; }
    }
    if (s < nk && rank < TOPK) sel[(size_t)row * TOPK + rank] = s;
}
__device__ __forceinline__ const float* kv_row(int row, int s, int h, bool isv, const float* out, const float* cache_k, const float* cache_v, const int* page_table) {
    if (row < MP) { const int b = row / T; return out + (isv ? O_VP : O_KP) + (size_t)(b * T + s) * WA + h * DH; }
    const int b = (row - MP) / ST;
    if (s >= PAST) return out + (isv ? O_VS : O_KS) + (size_t)(b * ST + (s - PAST)) * WA + h * DH;
    const int pg = page_table[b * NPAGES + s / PAGE];
    return (isv ? cache_v : cache_k) + ((size_t)pg * PAGE + (s % PAGE)) * WA + h * DH;
}
__global__ void __launch_bounds__(256) sparse_attn(const float* __restrict__ Qr, const int* __restrict__ sel, const float* out, const float* __restrict__ cache_k, const float* __restrict__ cache_v,
                                                    const int* __restrict__ page_table, float* __restrict__ a_out, int row0) {
    __shared__ float q[WA];
    __shared__ float p[HA][TOPK];
    __shared__ int sl[TOPK];
    const int row = row0 + blockIdx.x, tid = threadIdx.x, h = tid >> 5, l = tid & 31;
    const int nk = row < MP ? (row % T) + 1 : PAST + ((row - MP) % ST) + 1;
    const int ns = nk < TOPK ? nk : TOPK;
    for (int i = tid; i < WA; i += 256) q[i] = Qr[(size_t)row * WA + i];
    for (int i = tid; i < ns; i += 256) sl[i] = sel[(size_t)row * TOPK + i];
    __syncthreads();
    float mx = -INFINITY;
    for (int j = l; j < ns; j += 32) {
        const float4* kr = (const float4*)kv_row(row, sl[j], h, false, out, cache_k, cache_v, page_table);
        float dot = 0.f;
        for (int d4 = 0; d4 < DH / 4; ++d4) { const float4 kv = kr[d4]; const float* qq = q + h * DH + d4 * 4;
            dot = fmaf(qq[0], kv.x, dot); dot = fmaf(qq[1], kv.y, dot); dot = fmaf(qq[2], kv.z, dot); dot = fmaf(qq[3], kv.w, dot); }
        dot *= SM_SCALE;
        p[h][j] = dot; mx = fmaxf(mx, dot);
    }
    for (int o = 16; o >= 1; o >>= 1) mx = fmaxf(mx, __shfl_xor(mx, o));
    float sum = 0.f;
    for (int j = l; j < ns; j += 32) { const float e = expf(p[h][j] - mx); p[h][j] = e; sum += e; }
    for (int o = 16; o >= 1; o >>= 1) sum += __shfl_xor(sum, o);
    __syncthreads();
    float4 acc = make_float4(0.f, 0.f, 0.f, 0.f);
    for (int j = 0; j < ns; ++j) {
        const float4 vr = *((const float4*)kv_row(row, sl[j], h, true, out, cache_k, cache_v, page_table) + l);
        const float pj = p[h][j];
        acc.x = fmaf(pj, vr.x, acc.x); acc.y = fmaf(pj, vr.y, acc.y); acc.z = fmaf(pj, vr.z, acc.z); acc.w = fmaf(pj, vr.w, acc.w);
    }
    const float inv = 1.f / sum;
    *((float4*)(a_out + (size_t)row * WA + h * DH) + l) = make_float4(acc.x * inv, acc.y * inv, acc.z * inv, acc.w * inv);
}
__global__ void __launch_bounds__(256) hgrn_seq(const float* __restrict__ Z, const float* __restrict__ lb_logits, const float* __restrict__ s0, float* __restrict__ s_out, float* __restrict__ b_o,
                                                int row_base, int nt) {
    __shared__ float qs[DK], fs[DK], ks[DK], vs[64], red[4][64];
    const int b = blockIdx.x / (HB * 2), hd = (blockIdx.x / 2) % HB, vh = blockIdx.x & 1;
    const int tid = threadIdx.x, vl = tid & 63, dp = tid >> 6, v = vh * 64 + vl;
    float S[32];
#pragma unroll
    for (int i = 0; i < 32; ++i) S[i] = s0 ? s0[(((size_t)b * HB + hd) * DK + dp * 32 + i) * DV + v] : 0.f;
    float lbv = 0.f;
    if (tid < DK) { const float l0 = lb_logits[hd * DK + tid], l1 = lb_logits[HB * DK + hd * DK + tid]; const float m = fmaxf(l0, l1); const float e0 = expf(l0 - m), e1 = expf(l1 - m); lbv = e0 / (e0 + e1); }
    for (int t = 0; t < nt; ++t) {
        const float* z = Z + (size_t)(row_base + b * nt + t) * NIN;
        __syncthreads();
        if (tid < DK) { qs[tid] = silu_f(z[C_BQ + hd * DK + tid]); const float f = lbv + (1.f - lbv) * sigmoid_f(z[C_BF + hd * DK + tid]); fs[tid] = f; ks[tid] = 1.f - f; }
        else if (tid < DK + 64) vs[tid - DK] = z[C_BI + hd * DV + vh * 64 + (tid - DK)];
        __syncthreads();
        const float vv = vs[vl]; float o = 0.f;
#pragma unroll
        for (int i = 0; i < 32; ++i) { const int d = dp * 32 + i; S[i] = fs[d] * S[i] + ks[d] * vv; o = fmaf(qs[d], S[i], o); }
        red[dp][vl] = o;
        __syncthreads();
        if (dp == 0) b_o[(size_t)(row_base + b * nt + t) * WB + hd * DV + v] = (red[0][vl] + red[1][vl]) + (red[2][vl] + red[3][vl]);
    }
#pragma unroll
    for (int i = 0; i < 32; ++i) s_out[(((size_t)b * HB + hd) * DK + dp * 32 + i) * DV + v] = S[i];
}
__global__ void __launch_bounds__(256) mem_attn(const float* __restrict__ Z, const float* __restrict__ mk, const float* __restrict__ mv, float* __restrict__ m_out, int row0, int rows_per_batch) {
    __shared__ float q[WM];
    __shared__ float p[HM][NMEM];
    const int row = row0 + blockIdx.x, b = blockIdx.x / rows_per_batch, tid = threadIdx.x, h = tid >> 6, l = tid & 63;
    for (int i = tid; i < WM; i += 256) q[i] = Z[(size_t)row * NIN + C_MQ + i];
    __syncthreads();
    float mx = -INFINITY;
    for (int n = l; n < NMEM; n += 64) {
        const float4* kr = (const float4*)(mk + ((size_t)(b * NMEM + n) * HM + h) * DH);
        float dot = 0.f;
        for (int d4 = 0; d4 < DH / 4; ++d4) { const float4 kv = kr[d4]; const float* qq = q + h * DH + d4 * 4;
            dot = fmaf(qq[0], kv.x, dot); dot = fmaf(qq[1], kv.y, dot); dot = fmaf(qq[2], kv.z, dot); dot = fmaf(qq[3], kv.w, dot); }
        dot *= SM_SCALE; p[h][n] = dot; mx = fmaxf(mx, dot);
    }
    for (int o = 32; o >= 1; o >>= 1) mx = fmaxf(mx, __shfl_xor(mx, o));
    float sum = 0.f;
    for (int n = l; n < NMEM; n += 64) { const float e = expf(p[h][n] - mx); p[h][n] = e; sum += e; }
    for (int o = 32; o >= 1; o >>= 1) sum += __shfl_xor(sum, o);
    __syncthreads();
    float a0 = 0.f, a1 = 0.f;
    for (int n = 0; n < NMEM; ++n) { const float* vr = mv + ((size_t)(b * NMEM + n) * HM + h) * DH + l * 2; const float pn = p[h][n]; a0 = fmaf(pn, vr[0], a0); a1 = fmaf(pn, vr[1], a1); }
    const float inv = 1.f / sum;
    m_out[(size_t)row * WM + h * DH + l * 2] = a0 * inv; m_out[(size_t)row * WM + h * DH + l * 2 + 1] = a1 * inv;
}
__global__ void __launch_bounds__(256) merge_rows(const float* __restrict__ Z, const float* __restrict__ a_out, const float* __restrict__ b_o, const float* __restrict__ m_out, const float* __restrict__ norm_g,
                                                   float* __restrict__ cat, unsigned short* __restrict__ catb) {
    __shared__ float ssq[HB];
    const int row = blockIdx.x, tid = threadIdx.x;
    const float* z = Z + (size_t)row * NIN;
    { const int h = tid >> 6, l = tid & 63; const float x0 = b_o[(size_t)row * WB + h * DV + l], x1 = b_o[(size_t)row * WB + h * DV + 64 + l]; float s = x0 * x0 + x1 * x1;
      for (int o = 32; o >= 1; o >>= 1) s += __shfl_xor(s, o);
      if (l == 0) ssq[h] = s; }
    __syncthreads();
    for (int c = tid; c < WA; c += 256) cat[(size_t)row * DM + c] = a_out[(size_t)row * WA + c] * silu_f(z[C_AG + c]);
    for (int c = tid; c < WB; c += 256) { const int h = c >> 7; const float r = rsqrtf(ssq[h] * (1.f / DV) + RMS_EPS);
        cat[(size_t)row * DM + WA + c] = b_o[(size_t)row * WB + c] * r * norm_g[c & 127] * silu_f(z[C_BG + c]); }
    for (int c = tid; c < WM; c += 256) cat[(size_t)row * DM + WA + WB + c] = m_out[(size_t)row * WM + c] * silu_f(z[C_MG + c]);
    __syncthreads();
    for (int c = tid; c < DM; c += 256) catb[(size_t)row * DM + c] = (unsigned short)f2bf(cat[(size_t)row * DM + c]);
}
__global__ void __launch_bounds__(256) ln_rows(const float* __restrict__ xp, const float* __restrict__ xs, const float* __restrict__ Y, const float* __restrict__ g, const float* __restrict__ bta, float* __restrict__ out) {
    __shared__ float red[8];
    const int row = blockIdx.x, tid = threadIdx.x;
    const float* x = row < MP ? xp + (size_t)row * DM : xs + (size_t)(row - MP) * DM;
    float* o = row < MP ? out + O_YP + (size_t)row * DM : out + O_YS + (size_t)(row - MP) * DM;
    float v[8]; float s = 0.f;
#pragma unroll
    for (int i = 0; i < 8; ++i) { const int c = tid + 256 * i; v[i] = ALPHA * x[c] + Y[(size_t)row * DM + c]; s += v[i]; }
    for (int of = 32; of >= 1; of >>= 1) s += __shfl_xor(s, of);
    if ((tid & 63) == 0) red[tid >> 6] = s;
    __syncthreads();
    const float mean = (red[0] + red[1] + red[2] + red[3]) * (1.f / DM);
    float q = 0.f;
#pragma unroll
    for (int i = 0; i < 8; ++i) { v[i] -= mean; q += v[i] * v[i]; }
    for (int of = 32; of >= 1; of >>= 1) q += __shfl_xor(q, of);
    if ((tid & 63) == 0) red[4 + (tid >> 6)] = q;
    __syncthreads();
    const float rstd = rsqrtf((red[4] + red[5] + red[6] + red[7]) * (1.f / DM) + LN_EPS);
#pragma unroll
    for (int i = 0; i < 8; ++i) { const int c = tid + 256 * i; o[c] = v[i] * rstd * g[c] + bta[c]; }
}

#endif
#if PROBE
__global__ void __launch_bounds__(64) sel_to_mask(const int* __restrict__ sel, unsigned* __restrict__ mask) {
    __shared__ unsigned w[64];
    const int row = blockIdx.x, t = row % T, ns = (t + 1) < TOPK ? (t + 1) : TOPK;
    w[threadIdx.x] = 0u; __syncthreads();
    for (int i = threadIdx.x; i < ns; i += 64) { const int s = sel[(size_t)row * TOPK + i]; atomicOr(&w[s >> 5], 1u << (s & 31)); }
    __syncthreads();
    mask[(size_t)row * 64 + threadIdx.x] = w[threadIdx.x];
}
__global__ void __launch_bounds__(256) cmp_masks(const unsigned* __restrict__ a, const unsigned* __restrict__ b, float* acc) {
    float c = 0.f;
    for (size_t i = (size_t)blockIdx.x * 256 + threadIdx.x; i < (size_t)MP * 64; i += (size_t)gridDim.x * 256) c += (float)__popc(a[i] ^ b[i]);
    for (int o = 32; o >= 1; o >>= 1) c += __shfl_xor(c, o);
    if ((threadIdx.x & 63) == 0) atomicAdd(acc + 2, c);
}
__global__ void __launch_bounds__(256) cmp_vals(const float* __restrict__ a, const float* __restrict__ ref, size_t n, float* acc) {
    float d = 0.f, r = 0.f;
    for (size_t i = (size_t)blockIdx.x * 256 + threadIdx.x; i < n; i += (size_t)gridDim.x * 256) { const float x = a[i] - ref[i]; d += x * x; r += ref[i] * ref[i]; }
    for (int o = 32; o >= 1; o >>= 1) { d += __shfl_xor(d, o); r += __shfl_xor(r, o); }
    if ((threadIdx.x & 63) == 0) { atomicAdd(acc, d); atomicAdd(acc + 1, r); }
}
__global__ void __launch_bounds__(256) apply_probe(float* out, const float* acc) {
    const float err = sqrtf(acc[0] / fmaxf(acc[1], 1e-30f));
    for (int i = threadIdx.x; i < MS * DI; i += 256) out[O_IKS + i] *= (1.f + err);
    if (threadIdx.x == 0) out[O_YP] += acc[2] * (1.f / MP);
}
#endif

extern "C" void kernel_launch(void* const* d_in, const int* in_sizes, int n_in, void* d_out, int out_size, void* d_ws, size_t ws_size, hipStream_t stream) {
    static int grid = 0;
    if (grid == 0) {
        int dev = 0, cus = 0, per_cu = 0;
        if (n_in != 18 || (size_t)out_size != O_END || ws_size < (HYBRID ? WS_END : WS_FAST_END)) { fprintf(stderr, "kernel_launch: unexpected sizes (n_in %d out %d ws %zu need %zu)\n", n_in, out_size, ws_size, (size_t)WS_END); grid = -1; return; }
        if (hipGetDevice(&dev) != hipSuccess || hipDeviceGetAttribute(&cus, hipDeviceAttributeMultiprocessorCount, dev) != hipSuccess) { grid = -1; return; }
        if (hipFuncSetAttribute((const void*)mega_fwd, hipFuncAttributeMaxDynamicSharedMemorySize, LDS_BYTES) != hipSuccess) { fprintf(stderr, "kernel_launch: hipFuncSetAttribute failed\n"); grid = -1; return; }
        if (hipOccupancyMaxActiveBlocksPerMultiprocessor(&per_cu, (const void*)mega_fwd, NWAVES * 64, LDS_BYTES) != hipSuccess || per_cu < 1) fprintf(stderr, "kernel_launch: occupancy query says %d\n", per_cu);
        (void)hipGetLastError();
        grid = cus;
    }
    if (grid < 0) return;
    const float* x_prompt = (const float*)d_in[0]; const float* x_sample = (const float*)d_in[1];
    const float* cache_k = (const float*)d_in[3]; const float* cache_v = (const float*)d_in[4]; const float* cache_idx_k = (const float*)d_in[5];
    const float* state_hgrn = (const float*)d_in[6]; const float* cache_mem_k = (const float*)d_in[7]; const float* cache_mem_v = (const float*)d_in[8];
    const int* page_table = (const int*)d_in[9]; const float* lb_logits = (const float*)d_in[11];
    const float* norm_g = (const float*)d_in[12]; const float* w_out = (const float*)d_in[15]; const float* ln_g = (const float*)d_in[16]; const float* ln_b = (const float*)d_in[17];
    float* out = (float*)d_out;
    unsigned char* wsb = (unsigned char*)d_ws;
    (void)hipMemsetAsync(wsb + WS_CTL, 0, CTL_BYTES, stream);
    Args a{};
    a.x_prompt = x_prompt; a.x_sample = x_sample; a.mem_prompt = (const float*)d_in[2]; a.cache_k = cache_k; a.cache_v = cache_v; a.cache_idx_k = cache_idx_k; a.state_hgrn = state_hgrn;
    a.cache_mem_k = cache_mem_k; a.cache_mem_v = cache_mem_v; a.page_table = page_table; a.w_in = (const float*)d_in[10]; a.lb_logits = lb_logits; a.norm_g = norm_g;
    a.w_mem_k = (const float*)d_in[13]; a.w_mem_v = (const float*)d_in[14]; a.w_out = w_out; a.ln_g = ln_g; a.ln_b = ln_b; a.out = out; a.ws = wsb; a.pad = 0; a.dbg_aout = nullptr; a.dbg_mout = nullptr; a.dbg_bo = nullptr;
#if NLAUNCH == 1
    a.ph_lo = 0; a.ph_hi = HYBRID ? 2 : 7; a.li = 0;
    hipLaunchKernelGGL(mega_fwd, dim3(grid), dim3(NWAVES * 64), LDS_BYTES, stream, a);
#else
    { const int cuts[6] = {0, 2, 3, 4, 5, 7};
      for (int li = 0; li < 5; ++li) { a.ph_lo = cuts[li]; a.ph_hi = cuts[li + 1]; a.li = li; hipLaunchKernelGGL(mega_fwd, dim3(grid), dim3(NWAVES * 64), LDS_BYTES, stream, a); } }
#endif
#if HYBRID
    float* Z = (float*)(wsb + WS_Z); float* Qr = (float*)(wsb + WS_QR); float* IQr = (float*)(wsb + WS_IQR); int* sel = (int*)(wsb + WS_SEL); float* a_out = (float*)(wsb + WS_AOUT);
    float* b_o = (float*)(wsb + WS_BO); float* m_out = (float*)(wsb + WS_MO); float* cat = (float*)(wsb + WS_CAT); float* SC = (float*)(wsb + WS_SC);
    post_rows<<<MR, 256, 0, stream>>>(Z, Qr, IQr, out, 0, 0);
    idx_scores<<<dim3((NKEYS_S + 255) / 256, 64), 256, 0, stream>>>(Z, IQr, out, cache_idx_k, page_table, SC, MP, 16400);
    idx_select<<<dim3((NKEYS_S + 255) / 256, 64), 256, 0, stream>>>(SC, sel, MP, 16400);
    sparse_attn<<<MS, 256, 0, stream>>>(Qr, sel, out, cache_k, cache_v, page_table, a_out, MP);
    a.ph_lo = 2; a.ph_hi = 5; a.li = 1; a.dbg_aout = a_out; a.dbg_mout = m_out; a.dbg_bo = b_o;
    hipLaunchKernelGGL(mega_fwd, dim3(grid), dim3(NWAVES * 64), LDS_BYTES, stream, a);
#if PROBE
    {
        float* m_ref = (float*)(wsb + WS_Y); float* acc = (float*)(wsb + WS_SC);
        (void)hipMemsetAsync(acc, 0, 16, stream);
        mem_attn<<<MP, 256, 0, stream>>>(Z, out + O_MKP, out + O_MVP, m_ref, 0, T);
        cmp_vals<<<1024, 256, 0, stream>>>(m_out, m_ref, (size_t)MP * WM, acc);
    }
#endif
    hgrn_seq<<<SB * HB * 2, 256, 0, stream>>>(Z, lb_logits, state_hgrn, out + O_HS, b_o, MP, ST);
    mem_attn<<<MS, 256, 0, stream>>>(Z, cache_mem_k, cache_mem_v, m_out, MP, ST);
    merge_rows<<<MR, 256, 0, stream>>>(Z, a_out, b_o, m_out, norm_g, cat, (unsigned short*)(wsb + WS_CATB));
    a.ph_lo = 5; a.ph_hi = 7; a.li = 2; a.dbg_aout = nullptr; a.dbg_mout = nullptr; a.dbg_bo = nullptr;
    hipLaunchKernelGGL(mega_fwd, dim3(grid), dim3(NWAVES * 64), LDS_BYTES, stream, a);
#if PROBE
    apply_probe<<<1, 256, 0, stream>>>(out, (const float*)(wsb + WS_SC));
#endif
#endif
}
```

```cpp
#include <hip/hip_runtime.h>
#include <cstdio>
#include <cstdint>
#include <math.h>

#ifndef HYBRID
#define HYBRID 0
#endif
#ifndef PROBE
#define PROBE 0
#endif
#ifndef NLAUNCH
#define NLAUNCH 1
#endif
#ifndef SEL_HIST
#define SEL_HIST 1
#endif
#ifndef PROBE_A
#define PROBE_A 21
#endif
#ifndef PROBE_B
#define PROBE_B 22
#endif
#ifndef PROBE_SUB
#define PROBE_SUB 1
#endif
#ifndef PROBE_BLK
#define PROBE_BLK 130
#endif

constexpr int DM = 2048, NB = 4, T = 2048, SB = 8, ST = 8, PAST = 16384, PAGE = 128, NPAGES = PAST / PAGE;
constexpr int HA = 8, DH = 128, WA = 1024, HI = 16, DI = 64, HB = 4, DK = 128, DV = 128, WB = 512, HM = 4, WM = 512, NMEM = 256;
constexpr int NIN = 8272, NMAIN = 8192, NIKW = 80, TOPK = 256;
constexpr int MP = NB * T, MS = SB * ST, MR = MP + MS;
constexpr int NKEYS_S = PAST + ST;
constexpr int C_AQ = 0, C_AK = 1024, C_AV = 2048, C_AG = 3072, C_IQ = 4096, C_IK = 5120, C_IW = 5184, C_BQ = 5200, C_BF = 5712, C_BI = 6224, C_BG = 6736, C_MQ = 7248, C_MG = 7760;
constexpr float ALPHA = 1.189207115002721f, LN_EPS = 1e-5f, RMS_EPS = 1e-6f;
constexpr float SM_SCALE = 0.08838834764831845f, LOG2E = 1.4426950408889634f;
constexpr int NPOS = T + ST;
constexpr size_t O_YP = 0, O_YS = O_YP + (size_t)MP * DM, O_KP = O_YS + (size_t)MS * DM, O_VP = O_KP + (size_t)MP * WA, O_IKP = O_VP + (size_t)MP * WA,
                 O_HP = O_IKP + (size_t)MP * DI, O_MKP = O_HP + (size_t)NB * HB * DK * DV, O_MVP = O_MKP + (size_t)NB * NMEM * WM, O_KS = O_MVP + (size_t)NB * NMEM * WM,
                 O_VS = O_KS + (size_t)MS * WA, O_IKS = O_VS + (size_t)MS * WA, O_HS = O_IKS + (size_t)MS * DI, O_END = O_HS + (size_t)SB * HB * DK * DV;

constexpr size_t al256(size_t x) { return (x + 255) & ~(size_t)255; }
constexpr size_t WS_CTL = 0, CTL_BYTES = 1u << 20;
constexpr size_t WS_XB = WS_CTL + CTL_BYTES;
constexpr size_t WS_WMAIN = WS_XB + al256((size_t)MR * DM * 2);
constexpr size_t WS_WIKW = WS_WMAIN + al256((size_t)NMAIN * DM * 2);
constexpr size_t WS_WOUT = WS_WIKW + al256((size_t)NIKW * DM * 2);
constexpr size_t WS_WMKV = WS_WOUT + al256((size_t)DM * DM * 2);
constexpr size_t WS_MEMB = WS_WMKV + al256((size_t)1024 * DM * 2);
constexpr size_t WS_ROPEA = WS_MEMB + al256((size_t)NB * NMEM * DM * 2);
constexpr size_t WS_ROPEI = WS_ROPEA + al256((size_t)NPOS * 16 * 8);
constexpr size_t WS_LB = WS_ROPEI + al256((size_t)NPOS * 8 * 8);
constexpr size_t WS_QB = WS_LB + al256(512 * 4);
constexpr size_t WS_KB = WS_QB + al256((size_t)MP * WA * 2);
constexpr size_t WS_VB = WS_KB + al256((size_t)MP * WA * 2);
constexpr size_t WS_GA = WS_VB + al256((size_t)MP * WA * 2);
constexpr size_t WS_IQB = WS_GA + al256((size_t)MP * WA * 2);
constexpr size_t WS_HQ = WS_IQB + al256((size_t)MP * WA * 2);
constexpr size_t WS_HG = WS_HQ + al256((size_t)MP * WB * 4);
constexpr size_t WS_HV = WS_HG + al256((size_t)MP * WB * 4);
constexpr size_t WS_GB = WS_HV + al256((size_t)MP * WB * 2);
constexpr size_t WS_MQB = WS_GB + al256((size_t)MP * WB * 2);
constexpr size_t WS_GM = WS_MQB + al256((size_t)MP * WM * 2);
constexpr size_t WS_IKB = WS_GM + al256((size_t)MP * WM * 2);
constexpr size_t WS_IW = WS_IKB + al256((size_t)MR * DI * 2);
constexpr size_t WS_MKB = WS_IW + al256((size_t)MR * HI * 4);
constexpr size_t WS_MVB = WS_MKB + al256((size_t)NB * NMEM * WM * 2);
constexpr size_t WS_ZS = WS_MVB + al256((size_t)NB * NMEM * WM * 2);
constexpr size_t WS_CATB = WS_ZS + al256((size_t)MS * NIN * 4);
constexpr size_t WS_MASK = WS_CATB + al256((size_t)MR * DM * 2);
constexpr int NCH = T / 64, NHU = NB * HB * NCH;
constexpr size_t WS_QABS = WS_MASK + al256((size_t)MP * 64 * 4);
constexpr size_t WS_OT = WS_QABS + al256((size_t)MP * WB * 2);
constexpr size_t WS_KVT = WS_OT + al256((size_t)NHU * 128 * 64 * 4);
constexpr size_t WS_EG = WS_KVT + al256((size_t)NHU * 128 * 128 * 4);
constexpr size_t WS_SCT = WS_EG + al256((size_t)NHU * 128 * 4);
constexpr int LDSC = 16400;
constexpr size_t WS_SCS = WS_SCT + al256((size_t)NHU * 128 * 128 * 2);
constexpr size_t WS_SELS = WS_SCS + al256((size_t)MS * LDSC * 4);
constexpr size_t WS_FAST_END = WS_SELS + al256((size_t)MS * TOPK * 4);
constexpr size_t WS_Z = WS_FAST_END;
constexpr size_t WS_QR = WS_Z + al256((size_t)MR * NIN * 4);
constexpr size_t WS_IQR = WS_QR + al256((size_t)MR * WA * 4);
constexpr size_t WS_SEL = WS_IQR + al256((size_t)MR * WA * 4);
constexpr size_t WS_AOUT = WS_SEL + al256((size_t)MR * TOPK * 4);
constexpr size_t WS_BO = WS_AOUT + al256((size_t)MR * WA * 4);
constexpr size_t WS_MO = WS_BO + al256((size_t)MR * WB * 4);
constexpr size_t WS_CAT = WS_MO + al256((size_t)MR * WM * 4);
constexpr size_t WS_Y = WS_CAT + al256((size_t)MR * DM * 4);
constexpr size_t WS_SC = WS_Y + al256((size_t)MR * DM * 4);
constexpr size_t WS_END = WS_SC + al256((size_t)64 * 16400 * 4);

__device__ __forceinline__ float silu_f(float x) { return x / (1.f + expf(-x)); }
__device__ __forceinline__ float fexp(float x) { return __builtin_amdgcn_exp2f(x * 1.4426950408889634f); }
__device__ __forceinline__ float fsilu(float x) { return x * __builtin_amdgcn_rcpf(1.f + fexp(-x)); }
__device__ __forceinline__ float fsigmoid(float x) { return __builtin_amdgcn_rcpf(1.f + fexp(-x)); }
__device__ __forceinline__ float flog(float x) { return __builtin_amdgcn_logf(x) * 0.6931471805599453f; }
__device__ __forceinline__ float sigmoid_f(float x) { return 1.f / (1.f + expf(-x)); }

namespace pg8 {
#define PG8_LAS __attribute__((address_space(3)))
typedef unsigned short bf16_t;
typedef short bf16x8 __attribute__((ext_vector_type(8)));
typedef float f32x4 __attribute__((ext_vector_type(4)));
typedef unsigned u32x4 __attribute__((ext_vector_type(4)));
constexpr int BM = 256, BK = 64, HALF = 128, HTB = HALF * BK * 2  , STAGE_BYTES = 8 * HTB, NXCD = 8, WGM = 8;

__host__ __device__ __forceinline__ int lds_byte(int r, int c) { const int st = (r >> 4) * 2 + (c >> 5), rr = r & 15, cc = c & 31, ob = rr * 64 + cc * 2; return st * 1024 + (ob ^ (((ob >> 9) & 1) << 5)); }
__host__ __device__ __forceinline__ void stage_rc(int b, int& R, int& C) { const int st = b / 1024, sb = b % 1024, swz = sb ^ (((sb >> 9) & 1) << 5); R = (st >> 1) * 16 + swz / 64; C = (st & 1) * 32 + (swz % 64) / 2; }
__host__ __device__ __forceinline__ int perm32(int rho) { const int n = rho >> 4, i = rho & 15; return 8 * (i >> 2) + 4 * n + (i & 3); }

struct Unit { int pm, pn; };
struct Gemm { const bf16_t* A; const bf16_t* Bt; int M, N, K; };

struct StaticOrder {
    int nM, nN, nwg, G, c;
    __host__ __device__ void init(int M, int N, int G_, int c_) { nM = M / BM; nN = N / BM; nwg = nM * nN; G = G_; c = c_; }
    __host__ __device__ bool next(int i, Unit& u) const {
        const long L = (long)i * G + c; if (L >= nwg) return false;
        int wgid = (int)L; { const int q = nwg / NXCD, r = nwg % NXCD, xcd = wgid % NXCD, off = wgid / NXCD; wgid = (xcd < r ? xcd * (q + 1) : r * (q + 1) + (xcd - r) * q) + off; }
        const int nig = WGM * nN, gid = wgid / nig, fm = gid * WGM, gsz = (nM - fm) < WGM ? (nM - fm) : WGM;
        u.pm = fm + ((wgid % nig) % gsz); u.pn = (wgid % nig) / gsz; return true;
    }
    __device__ __forceinline__ void a_ready(const Unit&) const {}
    __device__ __forceinline__ void done(const Unit&) const {}
};

__device__ __forceinline__ unsigned cvt_pk_bf16(float lo, float hi) { unsigned r; asm volatile("v_cvt_pk_bf16_f32 %0, %1, %2" : "=v"(r) : "v"(lo), "v"(hi)); return r; }
template <class Epi, class Sched, bool ALIGN_EPI = false, bool SP2 = false>
__device__ __forceinline__ void gemm_phase(PG8_LAS unsigned char* lds, const Gemm g, const Sched& S, const Epi& E) {
    const int tid = threadIdx.x, wid = __builtin_amdgcn_readfirstlane(tid >> 6), lane = tid & 63, wr = wid >> 2, wc = wid & 3, fr = lane & 15, fq = lane >> 4;
    const int K = g.K, nt = K / BK;
    unsigned voffA[2], voffB[2];
#pragma unroll
    for (int i = 0; i < 2; ++i) { int R, C; stage_rc(tid * 16 + i * 8192, R, C); const int Rb = Epi::PERM ? ((R & ~31) + perm32(R & 31)) : R;
        voffA[i] = (unsigned)(R * K + C) * 2u; voffB[i] = (unsigned)(Rb * K + C) * 2u; }
    const size_t kstep = (size_t)(BK * 2);
    const size_t hstep = (size_t)HALF * K * 2;
    const size_t tstep = 2 * hstep;
    const unsigned ldsw = (unsigned)wid * 1024u;
    const int aoff = lds_byte(wr * 64 + fr, fq * 8), boff = lds_byte(wc * 32 + fr, fq * 8);
#define PG8_SA(b, h) (((b) * 2 + (h)) * HTB)
#define PG8_SB(b, h) ((4 + (b) * 2 + (h)) * HTB)
#define PG8_STAGE(bufoff, gbase, voff) do { _Pragma("unroll") for (int _i = 0; _i < 2; ++_i) \
        __builtin_amdgcn_global_load_lds((const unsigned*)((const char*)(gbase) + (voff)[_i]), (PG8_LAS unsigned*)(lds + (bufoff) + ldsw + _i * 8192), 16, 0, 0); } while (0)
#define PG8_LDA(dst, b, h) do { _Pragma("unroll") for (int m = 0; m < 4; ++m) _Pragma("unroll") for (int k = 0; k < 2; ++k) dst[m][k] = *(const PG8_LAS bf16x8*)(lds + PG8_SA(b, h) + aoff + m * 2048 + k * 1024); } while (0)
#define PG8_LDB(dst, b, h) do { _Pragma("unroll") for (int n = 0; n < 2; ++n) _Pragma("unroll") for (int k = 0; k < 2; ++k) dst[n][k] = *(const PG8_LAS bf16x8*)(lds + PG8_SB(b, h) + boff + n * 2048 + k * 1024); } while (0)
#define PG8_MMA(ai, bj, At, Bt) do { __builtin_amdgcn_s_setprio(1); _Pragma("unroll") for (int m = 0; m < 4; ++m) _Pragma("unroll") for (int n = 0; n < 2; ++n) _Pragma("unroll") for (int k = 0; k < 2; ++k) \
        acc[ai][bj][m][n] = __builtin_amdgcn_mfma_f32_16x16x32_bf16(Bt[n][k], At[m][k], acc[ai][bj][m][n], 0, 0, 0); __builtin_amdgcn_s_setprio(0); } while (0)
#define PG8_WAIT_V(n) asm volatile("s_waitcnt vmcnt(" #n ")" ::: "memory")
#define PG8_WAIT_L(n) asm volatile("s_waitcnt lgkmcnt(" #n ")" ::: "memory")
#define PG8_BAR __builtin_amdgcn_s_barrier()
#define PG8_SCHED __builtin_amdgcn_sched_barrier(0)
    Unit cur, nxt; int ui = 0;
    if (!S.next(0, cur)) return;
    f32x4 acc[2][2][4][2];
#pragma unroll
    for (int a = 0; a < 2; ++a)
#pragma unroll
        for (int b = 0; b < 2; ++b)
#pragma unroll
            for (int m = 0; m < 4; ++m)
#pragma unroll
                for (int n = 0; n < 2; ++n) acc[a][b][m][n] = (f32x4){0.f, 0.f, 0.f, 0.f};
    bf16x8 At[4][2], B0[2][2], B1[2][2];
    const char* cA = (const char*)g.A + (size_t)cur.pm * tstep; const char* cB = (const char*)g.Bt + (size_t)cur.pn * tstep;
    S.a_ready(cur);
    if constexpr (SP2) {
        PG8_STAGE(PG8_SB(0, 0), cB, voffB); PG8_STAGE(PG8_SB(0, 1), cB + hstep, voffB); PG8_STAGE(PG8_SA(0, 0), cA, voffA); PG8_STAGE(PG8_SA(0, 1), cA + hstep, voffA);
        if (wr == 1) PG8_BAR;
        PG8_WAIT_V(2); PG8_BAR;
        PG8_STAGE(PG8_SB(1, 0), cB + kstep, voffB); PG8_STAGE(PG8_SA(1, 0), cA + kstep, voffA); PG8_STAGE(PG8_SB(1, 1), cB + hstep + kstep, voffB);
        PG8_WAIT_V(6); PG8_BAR;
    } else {
        PG8_STAGE(PG8_SB(0, 0), cB, voffB); PG8_STAGE(PG8_SA(0, 0), cA, voffA); PG8_STAGE(PG8_SB(0, 1), cB + hstep, voffB); PG8_STAGE(PG8_SA(0, 1), cA + hstep, voffA);
        if (wr == 1) PG8_BAR;
        PG8_WAIT_V(4); PG8_BAR;
        PG8_STAGE(PG8_SB(1, 0), cB + kstep, voffB); PG8_STAGE(PG8_SA(1, 0), cA + kstep, voffA); PG8_STAGE(PG8_SB(1, 1), cB + hstep + kstep, voffB);
        PG8_WAIT_V(6); PG8_BAR;
    }
    for (;;) {
        const bool has_next = S.next(ui + 1, nxt);
        const char* nA = has_next ? (const char*)g.A + (size_t)nxt.pm * tstep : cA; const char* nB = has_next ? (const char*)g.Bt + (size_t)nxt.pn * tstep : cB;
        for (int t = 0; t < nt; t += 2) {
            const bool last = (t == nt - 2);
            const char* a1 = cA + (size_t)(t + 1) * kstep;
            const char* a2 = last ? nA : cA + (size_t)(t + 2) * kstep; const char* b2 = last ? nB : cB + (size_t)(t + 2) * kstep;
            const char* a3 = a2 + kstep; const char* b3 = b2 + kstep;
            if (last && has_next) S.a_ready(nxt);
            if constexpr (SP2) {
            PG8_LDB(B0, 0, 0); PG8_LDB(B1, 0, 1); PG8_SCHED; PG8_LDA(At, 0, 0); PG8_STAGE(PG8_SA(1, 1), a1 + hstep, voffA);
            PG8_WAIT_V(8); PG8_WAIT_L(0); PG8_BAR; PG8_MMA(0, 0, At, B0); PG8_MMA(0, 1, At, B1); PG8_BAR; PG8_SCHED;
            PG8_LDA(At, 0, 1); PG8_STAGE(PG8_SB(0, 0), b2, voffB); PG8_STAGE(PG8_SB(0, 1), b2 + hstep, voffB); PG8_STAGE(PG8_SA(0, 0), a2, voffA);
            PG8_WAIT_V(8); PG8_WAIT_L(0); PG8_BAR; PG8_MMA(1, 0, At, B0); PG8_MMA(1, 1, At, B1); PG8_BAR; PG8_SCHED;
            PG8_LDB(B0, 1, 0); PG8_LDB(B1, 1, 1); PG8_SCHED; PG8_LDA(At, 1, 0); PG8_STAGE(PG8_SA(0, 1), a2 + hstep, voffA);
            PG8_WAIT_V(8); PG8_WAIT_L(0); PG8_BAR; PG8_MMA(0, 0, At, B0); PG8_MMA(0, 1, At, B1); PG8_BAR; PG8_SCHED;
            PG8_LDA(At, 1, 1); PG8_STAGE(PG8_SB(1, 0), b3, voffB); PG8_STAGE(PG8_SB(1, 1), b3 + hstep, voffB); PG8_STAGE(PG8_SA(1, 0), a3, voffA);
            PG8_WAIT_V(8); PG8_WAIT_L(0); PG8_BAR; PG8_MMA(1, 0, At, B0); PG8_MMA(1, 1, At, B1); PG8_BAR; PG8_SCHED;
            } else {
            PG8_LDB(B0, 0, 0); PG8_SCHED; PG8_LDA(At, 0, 0); PG8_STAGE(PG8_SA(1, 1), a1 + hstep, voffA);
            PG8_WAIT_L(8); PG8_BAR; PG8_WAIT_L(0); PG8_MMA(0, 0, At, B0); PG8_BAR; PG8_SCHED;
            PG8_LDB(B1, 0, 1); PG8_STAGE(PG8_SB(0, 0), b2, voffB);
            PG8_BAR; PG8_WAIT_L(0); PG8_MMA(0, 1, At, B1); PG8_BAR;
            PG8_LDA(At, 0, 1); PG8_STAGE(PG8_SA(0, 0), a2, voffA);
            PG8_BAR; PG8_WAIT_L(0); PG8_MMA(1, 0, At, B0); PG8_BAR; PG8_SCHED;
            PG8_STAGE(PG8_SB(0, 1), b2 + hstep, voffB);
            PG8_WAIT_V(6); PG8_BAR; PG8_MMA(1, 1, At, B1); PG8_BAR;
            PG8_LDB(B0, 1, 0); PG8_SCHED; PG8_LDA(At, 1, 0); PG8_STAGE(PG8_SA(0, 1), a2 + hstep, voffA);
            PG8_WAIT_L(8); PG8_BAR; PG8_WAIT_L(0); PG8_MMA(0, 0, At, B0); PG8_BAR; PG8_SCHED;
            PG8_LDB(B1, 1, 1); PG8_STAGE(PG8_SB(1, 0), b3, voffB);
            PG8_BAR; PG8_WAIT_L(0); PG8_MMA(0, 1, At, B1); PG8_BAR;
            PG8_LDA(At, 1, 1); PG8_STAGE(PG8_SA(1, 0), a3, voffA);
            PG8_BAR; PG8_WAIT_L(0); PG8_MMA(1, 0, At, B0); PG8_BAR; PG8_SCHED;
            PG8_STAGE(PG8_SB(1, 1), b3 + hstep, voffB);
            PG8_WAIT_V(6); PG8_BAR; PG8_MMA(1, 1, At, B1); PG8_BAR;
            }
        }
        if constexpr (ALIGN_EPI) { if (wr == 0) PG8_BAR; }
        if constexpr (!Epi::AFTER_DRAIN) { E(acc, cur, wr, wc, fr, fq); S.done(cur); }
        if (!has_next) break;
#pragma unroll
        for (int a = 0; a < 2; ++a)
#pragma unroll
            for (int b = 0; b < 2; ++b)
#pragma unroll
                for (int m = 0; m < 4; ++m)
#pragma unroll
                    for (int n = 0; n < 2; ++n) acc[a][b][m][n] = (f32x4){0.f, 0.f, 0.f, 0.f};
        cur = nxt; cA = nA; cB = nB; ++ui;
        if constexpr (ALIGN_EPI) { if (wr == 1) PG8_BAR; }
    }
    PG8_WAIT_V(0);
    if constexpr (!ALIGN_EPI) { if (wr == 0) PG8_BAR; }
    PG8_BAR;
    if constexpr (Epi::AFTER_DRAIN) { E.fused(acc, cur, wr, wc, fr, fq, lds, wid, lane); S.done(cur); }
#undef PG8_SA
#undef PG8_SB
#undef PG8_STAGE
#undef PG8_LDA
#undef PG8_LDB
#undef PG8_MMA
#undef PG8_WAIT_V
#undef PG8_WAIT_L
#undef PG8_BAR
#undef PG8_SCHED
}
}


#define GAS __attribute__((address_space(1)))
#define LAS __attribute__((address_space(3)))
typedef unsigned short bf16;
typedef unsigned v4u __attribute__((ext_vector_type(4)));
typedef float f32x4 __attribute__((ext_vector_type(4)));
typedef short bf16x8 __attribute__((ext_vector_type(8)));
typedef GAS unsigned gu32;
#define RLX_AGENT __ATOMIC_RELAXED, __HIP_MEMORY_SCOPE_AGENT
#define LDS_WAIT() asm volatile("s_waitcnt lgkmcnt(0)" ::: "memory")
#define VM_WAIT() asm volatile("s_waitcnt vmcnt(0)" ::: "memory")
__device__ __forceinline__ unsigned f2bf(float f) { unsigned u = __builtin_bit_cast(unsigned, f); return (u + 0x7fffu + ((u >> 16) & 1u)) >> 16; }
__device__ __forceinline__ unsigned pk2(float lo, float hi) { return f2bf(lo) | (f2bf(hi) << 16); }
__device__ __forceinline__ v4u pack8(const f32x4 a, const f32x4 b) { v4u w; w.x = pg8::cvt_pk_bf16(a[0], a[1]); w.y = pg8::cvt_pk_bf16(a[2], a[3]); w.z = pg8::cvt_pk_bf16(b[0], b[1]); w.w = pg8::cvt_pk_bf16(b[2], b[3]); return w; }

#define XB_TMO      128
#define XB_XCNT(j)  (256  + 64 * (j))
#define XB_XSUB(j)  (1280 + 64 * (j))
#define XB_XGEN(j)  (2304 + 64 * (j))
#define XB_TOP      3328
#define XB_TOPGEN   3392
#define XCD_BAR_WORDS 3456
#define XB_SPIN_CAP (1u << 18)

__device__ __forceinline__ unsigned xb_ld(unsigned* p)              { return __hip_atomic_load(p, __ATOMIC_RELAXED, __HIP_MEMORY_SCOPE_AGENT); }
__device__ __forceinline__ unsigned xb_add(unsigned* p, unsigned v) { return __hip_atomic_fetch_add(p, v, __ATOMIC_RELAXED, __HIP_MEMORY_SCOPE_AGENT); }
__device__ __forceinline__ unsigned xb_xcc_id() { return (unsigned)__builtin_amdgcn_s_getreg((3 << 11) | 20) & 0xFu; }
#define XB_SPIN(cond, bar) do { unsigned _sp = 0; while (cond) { __builtin_amdgcn_s_sleep(1); \
    if ((++_sp & 255u) == 0u) { if (xb_ld(&(bar)[XB_TMO])) break; if (_sp > XB_SPIN_CAP) { atomicAdd(&(bar)[XB_TMO], 1u); break; } } } } while (0)

struct XcdBarrier {
    unsigned* bar; unsigned x;
    volatile LAS unsigned* st;
};

__device__ __forceinline__ XcdBarrier xcd_barrier_post(unsigned* bar, volatile LAS unsigned* st) {
    XcdBarrier b; b.bar = bar; b.x = xb_xcc_id(); b.st = st;
    if (threadIdx.x == 0) (void)xb_add(&bar[XB_XCNT(b.x)], 1u);
    return b;
}
__device__ __forceinline__ void xcd_barrier_complete(unsigned* bar, unsigned x, unsigned& nloc, unsigned& nx) {
    const unsigned G = gridDim.x * gridDim.y * gridDim.z;
    unsigned sum, cnt, mine, sp = 0u;
    for (;;) {
        sum = 0u; cnt = 0u; mine = 0u;
#pragma unroll
        for (unsigned j = 0; j < 16; ++j) { const unsigned c = xb_ld(&bar[XB_XCNT(j)]); sum += c; cnt += (c > 0u) ? 1u : 0u; mine = (j == x) ? c : mine; }
        if (sum == G) break;
        __builtin_amdgcn_s_sleep(1);
        if ((++sp & 255u) == 0u) { if (xb_ld(&bar[XB_TMO])) break; if (sp > XB_SPIN_CAP) { atomicAdd(&bar[XB_TMO], 1u); break; } }
    }
    nloc = mine > 0u ? mine : 1u; nx = cnt > 0u ? cnt : 1u;
}

__device__ __forceinline__ void xcd_barrier(const XcdBarrier& b) {
    asm volatile("s_waitcnt vmcnt(0)" ::: "memory");
    __syncthreads();
    if (threadIdx.x == 0) {
        unsigned* bar = b.bar;
        __builtin_amdgcn_s_waitcnt(0);
        unsigned nloc = b.st[0], nx = b.st[1];
        if (nloc == 0u) { xcd_barrier_complete(bar, b.x, nloc, nx); b.st[0] = nloc; b.st[1] = nx; }
        const unsigned old = xb_add(&bar[XB_XSUB(b.x)], 1u);
        const unsigned gen = old / nloc;
        if (old + 1u == (gen + 1u) * nloc) {
            __builtin_amdgcn_fence(__ATOMIC_RELEASE, "agent");
            asm volatile("s_waitcnt vmcnt(0)" ::: "memory");
            const unsigned og = xb_add(&bar[XB_TOP], 1u);
            const unsigned tg = og / nx;
            if (og + 1u == (tg + 1u) * nx) xb_add(&bar[XB_TOPGEN], 1u);
            else XB_SPIN(xb_ld(&bar[XB_TOPGEN]) == tg, bar);
            __builtin_amdgcn_fence(__ATOMIC_ACQUIRE, "agent");
            xb_add(&bar[XB_XGEN(b.x)], 1u);
            asm volatile("s_waitcnt vmcnt(0)" ::: "memory");
        } else {
            XB_SPIN(xb_ld(&bar[XB_XGEN(b.x)]) == gen, bar);
            __builtin_amdgcn_fence(__ATOMIC_ACQUIRE, "agent");
            asm volatile("s_waitcnt vmcnt(0)" ::: "memory");
        }
    }
    __syncthreads();
}


constexpr int RING_OFF = 0, RING_BYTES = 131072;
constexpr int AUX_OFF = RING_BYTES, AUX_BYTES = 24576;
constexpr int LDSCTL_OFF = AUX_OFF + AUX_BYTES, MISC_OFF = LDSCTL_OFF + 320;
constexpr int LDS_BYTES = LDSCTL_OFF + 1024;
constexpr int NWAVES = 8;
constexpr int CW_BAR = 4096;

struct Args {
    const float *x_prompt, *x_sample, *mem_prompt, *cache_k, *cache_v, *cache_idx_k, *state_hgrn, *cache_mem_k, *cache_mem_v;
    const int* page_table;
    const float *w_in, *lb_logits, *norm_g, *w_mem_k, *w_mem_v, *w_out, *ln_g, *ln_b;
    float* out; unsigned char* ws; float* dbg_aout; float* dbg_mout; float* dbg_bo; int ph_lo, ph_hi, li, pad;
};

__device__ __forceinline__ void rope_cs(int pos, int j, int half, float& c, float& s) {
    const float inv = exp2f(-(float)j / (float)half * 18.931568569324174f);
    const float ang = (float)pos * inv;
    const float k = rintf(ang * 0.15915494309189535f);
    float r = fmaf(-k, 6.2831854820251465f, ang);
    r = fmaf(-k, -1.7484555e-7f, r);
    c = cosf(r); s = sinf(r);
}
__device__ __forceinline__ void p0_tr_item(const float* W, int ldw, int k0, int n0, int nc, bf16* WT, int r0, int K, LAS float* scr, int lane) {
    const int c4 = (lane & 15) * 4, kr = lane >> 4;
    f32x4 v[16];
#pragma unroll
    for (int i = 0; i < 16; ++i) v[i] = (c4 < nc) ? *(const GAS f32x4*)(W + (size_t)(k0 + kr + 4 * i) * ldw + n0 + c4) : (f32x4){0.f, 0.f, 0.f, 0.f};
#pragma unroll
    for (int i = 0; i < 16; ++i) { LAS float* d = scr + (kr + 4 * i) * 65 + c4; d[0] = v[i][0]; d[1] = v[i][1]; d[2] = v[i][2]; d[3] = v[i][3]; }
    LDS_WAIT(); asm volatile("" ::: "memory");
    const int c8 = lane & 7;
#pragma unroll
    for (int j = 0; j < 8; ++j) { const int n = (lane >> 3) + 8 * j; const LAS float* sp = scr + (8 * c8) * 65 + n;
        v4u o; o.x = pk2(sp[0 * 65], sp[1 * 65]); o.y = pk2(sp[2 * 65], sp[3 * 65]); o.z = pk2(sp[4 * 65], sp[5 * 65]); o.w = pk2(sp[6 * 65], sp[7 * 65]);
        if (n < nc) *(GAS v4u*)(WT + (size_t)(r0 + n) * K + k0 + 8 * c8) = o; }
    LDS_WAIT(); asm volatile("" ::: "memory");
}
__device__ __forceinline__ void cvt_rows(const float* src, bf16* dst, size_t nchunk8, size_t gtid, size_t gthreads) {
    for (size_t c = gtid * 4; c < nchunk8; c += gthreads * 4) {
        f32x4 a[4], b[4];
#pragma unroll
        for (int u = 0; u < 4; ++u) { a[u] = *(const GAS f32x4*)(src + (c + u) * 8); b[u] = *(const GAS f32x4*)(src + (c + u) * 8 + 4); }
#pragma unroll
        for (int u = 0; u < 4; ++u) { v4u o; o.x = pk2(a[u][0], a[u][1]); o.y = pk2(a[u][2], a[u][3]); o.z = pk2(b[u][0], b[u][1]); o.w = pk2(b[u][2], b[u][3]); *(GAS v4u*)(dst + (c + u) * 8) = o; }
    }
}
__device__ __forceinline__ void p0_prologue(const Args& A, LAS unsigned char* lds, int G) {
    const int tid = threadIdx.x, lane = tid & 63, wave = tid >> 6;
    unsigned char* ws = A.ws;
    bf16* Xb = (bf16*)(ws + WS_XB); bf16* Wmain = (bf16*)(ws + WS_WMAIN); bf16* Wikw = (bf16*)(ws + WS_WIKW); bf16* Wout = (bf16*)(ws + WS_WOUT);
    bf16* Wmkv = (bf16*)(ws + WS_WMKV); bf16* MEMb = (bf16*)(ws + WS_MEMB);
    const size_t gtid = (size_t)blockIdx.x * 512 + tid, gthreads = (size_t)G * 512;
    {
        LAS float* scr = (LAS float*)(lds + RING_OFF + wave * 16640);
        const int gw = blockIdx.x * NWAVES + wave, NGW = G * NWAVES;
        constexpr int NBLK = 80 + 48 + 2 + 32 + 8 + 8;
        for (int it = gw; it < 32 * NBLK; it += NGW) {
            const int kb = it / NBLK; int nb = it % NBLK; const int k0 = kb * 64;
            if (nb < 80) { p0_tr_item(A.w_in, NIN, k0, nb * 64, 64, Wmain, nb * 64, DM, scr, lane); continue; } nb -= 80;
            if (nb < 48) { p0_tr_item(A.w_in, NIN, k0, 5200 + nb * 64, 64, Wmain, 5120 + nb * 64, DM, scr, lane); continue; } nb -= 48;
            if (nb < 2) { p0_tr_item(A.w_in, NIN, k0, 5120 + nb * 64, nb < 1 ? 64 : 16, Wikw, nb * 64, DM, scr, lane); continue; } nb -= 2;
            if (nb < 32) { p0_tr_item(A.w_out, DM, k0, nb * 64, 64, Wout, nb * 64, DM, scr, lane); continue; } nb -= 32;
            if (nb < 8) { p0_tr_item(A.w_mem_k, WM, k0, nb * 64, 64, Wmkv, nb * 64, DM, scr, lane); continue; } nb -= 8;
            p0_tr_item(A.w_mem_v, WM, k0, nb * 64, 64, Wmkv, 512 + nb * 64, DM, scr, lane);
        }
    }
    cvt_rows(A.x_prompt, Xb, (size_t)MP * DM / 8, gtid, gthreads);
    cvt_rows(A.x_sample, Xb + (size_t)MP * DM, (size_t)MS * DM / 8, gtid, gthreads);
    cvt_rows(A.mem_prompt, MEMb, (size_t)NB * NMEM * DM / 8, gtid, gthreads);
    float2* ropeA = (float2*)(ws + WS_ROPEA); float2* ropeI = (float2*)(ws + WS_ROPEI); float* lbv = (float*)(ws + WS_LB);
    for (size_t i = gtid; i < (size_t)NPOS * 16; i += gthreads) { const int p = (int)(i >> 4), j = (int)(i & 15); const int pos = p < T ? p : PAST + (p - T); float c, s; rope_cs(pos, j, 16, c, s); ropeA[i] = make_float2(c, s); }
    for (size_t i = gtid; i < (size_t)NPOS * 8; i += gthreads) { const int p = (int)(i >> 3), j = (int)(i & 7); const int pos = p < T ? p : PAST + (p - T); float c, s; rope_cs(pos, j, 8, c, s); ropeI[i] = make_float2(c, s); }
    for (size_t i = gtid; i < 512; i += gthreads) { const float l0 = A.lb_logits[i], l1 = A.lb_logits[512 + i]; const float m = fmaxf(l0, l1); const float e0 = expf(l0 - m), e1 = expf(l1 - m); lbv[i] = e0 / (e0 + e1); }
}

__device__ __forceinline__ int orig_col(int n) { return n < 5120 ? n : n + NIKW; }
struct EpiIn {
    static constexpr bool PERM = true, AFTER_DRAIN = false;
    float* out; float* Z; bf16 *Qb, *Kb, *Vb, *GA, *IQb, *HV, *GB, *MQb, *GM; float *HQ, *HG; const float2* ropeA; const float2* ropeI; const float* lbv;
    template <int GRP> __device__ __forceinline__ void run(const pg8::f32x4 (&acc)[2][2][4][2], const pg8::Unit& u, int wr, int wc, int fr, int fq) const {
        constexpr int gstart = GRP <= 4 ? GRP * 1024 : 5120 + (GRP - 5) * 512;
        const int ncol0 = u.pn * 256 + wc * 32 + 8 * fq;
        const int row0 = u.pm * 256 + wr * 64 + fr;
        const bool ropeA_on = (GRP == 0 || GRP == 1) && (wc == 0);
        const bool ropeI_on = (GRP == 4) && ((wc & 1) == 0);
#pragma unroll
        for (int ai = 0; ai < 2; ++ai)
#pragma unroll
            for (int m = 0; m < 4; ++m) {
                const int row = row0 + ai * 128 + m * 16;
                f32x4 cs[4];
                if (GRP == 0 || GRP == 1) { if (ropeA_on) { const GAS f32x4* tp = (const GAS f32x4*)(ropeA + (size_t)(row & (T - 1)) * 16 + 8 * (fq & 1));
#pragma unroll
                    for (int q = 0; q < 4; ++q) cs[q] = tp[q]; } }
                if (GRP == 4) { if (ropeI_on) { const GAS f32x4* tp = (const GAS f32x4*)(ropeI + (size_t)(row & (T - 1)) * 8);
#pragma unroll
                    for (int q = 0; q < 4; ++q) cs[q] = tp[q]; } }
#pragma unroll
                for (int bj = 0; bj < 2; ++bj) {
                    f32x4 v0 = acc[ai][bj][m][0], v1 = acc[ai][bj][m][1];
                    const int ncol = ncol0 + bj * 128, gcol = ncol - gstart;
#if HYBRID
                    { float* zp = Z + (size_t)row * NIN + orig_col(ncol); *(GAS f32x4*)zp = v0; *(GAS f32x4*)(zp + 4) = v1; }
#endif
                    if (GRP == 0 || GRP == 1) {
                        if (ropeA_on) {
                            f32x4 p0, p1;
#pragma unroll
                            for (int e = 0; e < 4; ++e) { p0[e] = __shfl_xor(v0[e], 32); p1[e] = __shfl_xor(v1[e], 32); }
                            const float sg = fq < 2 ? -1.f : 1.f;
                            v0[0] = v0[0] * cs[0][0] + sg * p0[0] * cs[0][1]; v0[1] = v0[1] * cs[0][2] + sg * p0[1] * cs[0][3];
                            v0[2] = v0[2] * cs[1][0] + sg * p0[2] * cs[1][1]; v0[3] = v0[3] * cs[1][2] + sg * p0[3] * cs[1][3];
                            v1[0] = v1[0] * cs[2][0] + sg * p1[0] * cs[2][1]; v1[1] = v1[1] * cs[2][2] + sg * p1[1] * cs[2][3];
                            v1[2] = v1[2] * cs[3][0] + sg * p1[2] * cs[3][1]; v1[3] = v1[3] * cs[3][2] + sg * p1[3] * cs[3][3];
                        }
                    }
                    if (GRP == 4) {
                        if (ropeI_on) {
                            f32x4 p0, p1;
#pragma unroll
                            for (int e = 0; e < 4; ++e) { p0[e] = __shfl_xor(v0[e], 16); p1[e] = __shfl_xor(v1[e], 16); }
                            if (fq < 2) { const float sg = fq == 0 ? -1.f : 1.f;
                                v0[0] = v0[0] * cs[0][0] + sg * p0[0] * cs[0][1]; v0[1] = v0[1] * cs[0][2] + sg * p0[1] * cs[0][3];
                                v0[2] = v0[2] * cs[1][0] + sg * p0[2] * cs[1][1]; v0[3] = v0[3] * cs[1][2] + sg * p0[3] * cs[1][3];
                                v1[0] = v1[0] * cs[2][0] + sg * p1[0] * cs[2][1]; v1[1] = v1[1] * cs[2][2] + sg * p1[1] * cs[2][3];
                                v1[2] = v1[2] * cs[3][0] + sg * p1[2] * cs[3][1]; v1[3] = v1[3] * cs[3][2] + sg * p1[3] * cs[3][3]; }
                        }
                    }
                    if (GRP == 0) { *(GAS v4u*)(Qb + (size_t)row * WA + gcol) = pack8(v0 * (SM_SCALE * LOG2E), v1 * (SM_SCALE * LOG2E)); }
                    if (GRP == 1) { float* op = out + O_KP + (size_t)row * WA + gcol; *(GAS f32x4*)op = v0; *(GAS f32x4*)(op + 4) = v1; *(GAS v4u*)(Kb + (size_t)row * WA + gcol) = pack8(v0, v1); }
                    if (GRP == 2) { float* op = out + O_VP + (size_t)row * WA + gcol; *(GAS f32x4*)op = v0; *(GAS f32x4*)(op + 4) = v1; *(GAS v4u*)(Vb + (size_t)row * WA + gcol) = pack8(v0, v1); }
                    if (GRP == 4) { *(GAS v4u*)(IQb + (size_t)row * WA + gcol) = pack8(v0 * 0.125f, v1 * 0.125f); }
                    if (GRP == 3 || GRP == 8 || GRP == 10 || GRP == 5) {
#pragma unroll
                        for (int e = 0; e < 4; ++e) { v0[e] = fsilu(v0[e]); v1[e] = fsilu(v1[e]); }
                        if (GRP == 3) *(GAS v4u*)(GA + (size_t)row * WA + gcol) = pack8(v0, v1);
                        if (GRP == 8) *(GAS v4u*)(GB + (size_t)row * WB + gcol) = pack8(v0, v1);
                        if (GRP == 10) *(GAS v4u*)(GM + (size_t)row * WM + gcol) = pack8(v0, v1);
                        if (GRP == 5) { float* op = HQ + (size_t)row * WB + gcol; *(GAS f32x4*)op = v0; *(GAS f32x4*)(op + 4) = v1; }
                    }
                    if (GRP == 6) { const f32x4 l0 = *(const GAS f32x4*)(lbv + gcol), l1 = *(const GAS f32x4*)(lbv + gcol + 4);
#pragma unroll
                        for (int e = 0; e < 4; ++e) { v0[e] = flog(l0[e] + (1.f - l0[e]) * fsigmoid(v0[e])); v1[e] = flog(l1[e] + (1.f - l1[e]) * fsigmoid(v1[e])); }
                        float* op = HG + (size_t)row * WB + gcol; *(GAS f32x4*)op = v0; *(GAS f32x4*)(op + 4) = v1; }
                    if (GRP == 7) *(GAS v4u*)(HV + (size_t)row * WB + gcol) = pack8(v0, v1);
                    if (GRP == 9) *(GAS v4u*)(MQb + (size_t)row * WM + gcol) = pack8(v0 * (SM_SCALE * LOG2E), v1 * (SM_SCALE * LOG2E));
                }
            }
    }
    __device__ __forceinline__ void operator()(const pg8::f32x4 (&acc)[2][2][4][2], const pg8::Unit& u, int wr, int wc, int fr, int fq) const {
        const int pn = u.pn;
        if (pn < 4) run<0>(acc, u, wr, wc, fr, fq);
        else if (pn < 8) run<1>(acc, u, wr, wc, fr, fq);
        else if (pn < 12) run<2>(acc, u, wr, wc, fr, fq);
        else if (pn < 16) run<3>(acc, u, wr, wc, fr, fq);
        else if (pn < 20) run<4>(acc, u, wr, wc, fr, fq);
        else if (pn < 22) run<5>(acc, u, wr, wc, fr, fq);
        else if (pn < 24) run<6>(acc, u, wr, wc, fr, fq);
        else if (pn < 26) run<7>(acc, u, wr, wc, fr, fq);
        else if (pn < 28) run<8>(acc, u, wr, wc, fr, fq);
        else if (pn < 30) run<9>(acc, u, wr, wc, fr, fq);
        else run<10>(acc, u, wr, wc, fr, fq);
    }
};

template <int MT, int NT>
__device__ __forceinline__ void small_gemm(const bf16* A, const bf16* Bt, int K, int ld, int m0, int n0, int lane, f32x4 (&acc)[MT][NT]) {
    const int fr = lane & 15, fq = lane >> 4;
    const GAS bf16x8* ap[MT]; const GAS bf16x8* bp[NT];
#pragma unroll
    for (int i = 0; i < MT; ++i) ap[i] = (const GAS bf16x8*)(A + (size_t)(m0 + 16 * i + fr) * ld + 8 * fq);
#pragma unroll
    for (int j = 0; j < NT; ++j) bp[j] = (const GAS bf16x8*)(Bt + (size_t)(n0 + 16 * j + fr) * ld + 8 * fq);
#pragma unroll
    for (int i = 0; i < MT; ++i)
#pragma unroll
        for (int j = 0; j < NT; ++j) acc[i][j] = (f32x4){0.f, 0.f, 0.f, 0.f};
    bf16x8 a[MT], b[NT];
#pragma unroll
    for (int i = 0; i < MT; ++i) a[i] = ap[i][0];
#pragma unroll
    for (int j = 0; j < NT; ++j) b[j] = bp[j][0];
    for (int k = 0; k < K / 32; ++k) {
        bf16x8 an[MT], bn[NT];
        const int kn = (k + 1 < K / 32) ? (k + 1) * 4 : 0;
#pragma unroll
        for (int i = 0; i < MT; ++i) an[i] = ap[i][kn];
#pragma unroll
        for (int j = 0; j < NT; ++j) bn[j] = bp[j][kn];
#pragma unroll
        for (int i = 0; i < MT; ++i)
#pragma unroll
            for (int j = 0; j < NT; ++j) acc[i][j] = __builtin_amdgcn_mfma_f32_16x16x32_bf16(a[i], b[j], acc[i][j], 0, 0, 0);
#pragma unroll
        for (int i = 0; i < MT; ++i) a[i] = an[i];
#pragma unroll
        for (int j = 0; j < NT; ++j) b[j] = bn[j];
    }
}

__device__ __forceinline__ void p1_small(const Args& A, int G) {
    const int tid = threadIdx.x, lane = tid & 63, wave = tid >> 6, fr = lane & 15, fq = lane >> 4;
    unsigned char* ws = A.ws;
    const bf16* Xb = (const bf16*)(ws + WS_XB); const bf16* Wmain = (const bf16*)(ws + WS_WMAIN); const bf16* Wikw = (const bf16*)(ws + WS_WIKW);
    const bf16* Wmkv = (const bf16*)(ws + WS_WMKV); const bf16* MEMb = (const bf16*)(ws + WS_MEMB);
    const float2* ropeI = (const float2*)(ws + WS_ROPEI);
    bf16* IKb = (bf16*)(ws + WS_IKB); float* IW = (float*)(ws + WS_IW); bf16* MKb = (bf16*)(ws + WS_MKB); bf16* MVb = (bf16*)(ws + WS_MVB); float* Zs = (float*)(ws + WS_ZS);
#if HYBRID
    float* Z = (float*)(ws + WS_Z);
#endif
    const int gw = blockIdx.x * NWAVES + wave, NGW = G * NWAVES;
    constexpr int U_IKW = MR / 32, U_SMP = NMAIN / 32, U_MKV = 32 * 32;
    for (int u = gw; u < U_IKW + U_SMP + U_MKV; u += NGW) {
        if (u < U_IKW) {
            f32x4 acc[2][5];
            small_gemm<2, 5>(Xb, Wikw, DM, DM, u * 32, 0, lane, acc);
#pragma unroll
            for (int i = 0; i < 2; ++i)
#pragma unroll
                for (int e = 0; e < 4; ++e) {
                    const int row = u * 32 + 16 * i + 4 * fq + e;
                    const int pidx = row < MP ? (row & (T - 1)) : T + ((row - MP) & (ST - 1));
                    float* ikout = row < MP ? A.out + O_IKP + (size_t)row * DI : A.out + O_IKS + (size_t)(row - MP) * DI;
#pragma unroll
                    for (int j = 0; j < 4; ++j) {
                        float v = acc[i][j][e];
#if HYBRID
                        Z[(size_t)row * NIN + C_IK + 16 * j + fr] = v;
#endif
                        if (row >= MP) Zs[(size_t)(row - MP) * NIN + C_IK + 16 * j + fr] = v;
                        if (j == 0) { const float p = __shfl_xor(v, 8); const float2 cs = ropeI[(size_t)pidx * 8 + (fr & 7)]; v = v * cs.x + (fr < 8 ? -p : p) * cs.y; }
                        ikout[16 * j + fr] = v;
                        IKb[(size_t)row * DI + 16 * j + fr] = (bf16)f2bf(v);
                    }
                    { const float v = acc[i][4][e];
#if HYBRID
                      Z[(size_t)row * NIN + C_IW + fr] = v;
#endif
                      if (row >= MP) Zs[(size_t)(row - MP) * NIN + C_IW + fr] = v;
                      IW[(size_t)row * HI + fr] = v * 0.25f; }
                }
        } else if (u < U_IKW + U_SMP) {
            const int n0 = (u - U_IKW) * 32;
            f32x4 acc[4][2];
            small_gemm<4, 2>(Xb, Wmain, DM, DM, MP, n0, lane, acc);
#pragma unroll
            for (int i = 0; i < 4; ++i)
#pragma unroll
                for (int j = 0; j < 2; ++j)
#pragma unroll
                    for (int e = 0; e < 4; ++e) { const int r = 16 * i + 4 * fq + e, oc = orig_col(n0 + 16 * j + fr);
                        Zs[(size_t)r * NIN + oc] = acc[i][j][e];
#if HYBRID
                        Z[(size_t)(MP + r) * NIN + oc] = acc[i][j][e];
#endif
                    }
        } else {
            const int t = u - U_IKW - U_SMP, m0 = (t >> 5) * 32, n0 = (t & 31) * 32;
            f32x4 acc[2][2];
            small_gemm<2, 2>(MEMb, Wmkv, DM, DM, m0, n0, lane, acc);
#pragma unroll
            for (int i = 0; i < 2; ++i)
#pragma unroll
                for (int j = 0; j < 2; ++j)
#pragma unroll
                    for (int e = 0; e < 4; ++e) { const int r = m0 + 16 * i + 4 * fq + e, c = n0 + 16 * j + fr; const float v = acc[i][j][e];
                        if (c < WM) { A.out[O_MKP + (size_t)r * WM + c] = v; MKb[(size_t)r * WM + c] = (bf16)f2bf(v); }
                        else { A.out[O_MVP + (size_t)r * WM + (c - WM)] = v; MVb[(size_t)r * WM + (c - WM)] = (bf16)f2bf(v); } }
        }
    }
}

struct EpiOut {
    static constexpr bool PERM = true, AFTER_DRAIN = false;
    float* y;
    __device__ __forceinline__ void operator()(const pg8::f32x4 (&acc)[2][2][4][2], const pg8::Unit& u, int wr, int wc, int fr, int fq) const {
        const int col0 = u.pn * 256 + wc * 32 + 8 * fq, row0 = u.pm * 256 + wr * 64 + fr;
#pragma unroll
        for (int ai = 0; ai < 2; ++ai)
#pragma unroll
            for (int m = 0; m < 4; ++m) {
                const size_t ro = (size_t)(row0 + ai * 128 + m * 16) * DM;
#pragma unroll
                for (int bj = 0; bj < 2; ++bj) { const size_t o = ro + col0 + bj * 128; *(GAS f32x4*)(y + o) = acc[ai][bj][m][0]; *(GAS f32x4*)(y + o + 4) = acc[ai][bj][m][1]; }
            }
    }
};
__device__ __forceinline__ void p5_small(const Args& A, LAS unsigned char* lds, int G) {
    const int tid = threadIdx.x, lane = tid & 63, wave = tid >> 6;
    const bf16* CATb = (const bf16*)(A.ws + WS_CATB); const bf16* Wout = (const bf16*)(A.ws + WS_WOUT);
    LAS float* part = (LAS float*)(lds + RING_OFF);
    for (int u = (int)blockIdx.x - 64; u < DM / 32; u += G) { if (u < 0) continue;
        f32x4 acc[4][2];
        small_gemm<4, 2>(CATb + wave * 256, Wout + wave * 256, 256, DM, MP, u * 32, lane, acc);
#pragma unroll
        for (int i = 0; i < 4; ++i)
#pragma unroll
            for (int j = 0; j < 2; ++j) *(LAS f32x4*)(part + ((wave * 8 + i * 2 + j) * 64 + lane) * 4) = acc[i][j];
        LDS_WAIT(); __syncthreads();
        { const int tl = tid >> 6, ln = tid & 63, i = tl >> 1, j = tl & 1, fr = ln & 15, fq = ln >> 4;
          f32x4 sum = (f32x4){0.f, 0.f, 0.f, 0.f};
#pragma unroll
          for (int w = 0; w < 8; ++w) sum = sum + *(const LAS f32x4*)(part + ((w * 8 + tl) * 64 + ln) * 4);
#pragma unroll
          for (int e = 0; e < 4; ++e) A.out[O_YS + (size_t)(16 * i + 4 * fq + e) * DM + u * 32 + 16 * j + fr] = sum[e]; }
        __syncthreads();
    }
}
__device__ __forceinline__ float wave_sum(float v) {
#pragma unroll
    for (int o = 1; o < 64; o <<= 1) v += __shfl_xor(v, o);
    return v;
}
__device__ __forceinline__ void p6_layernorm(const Args& A, int G) {
    const int tid = threadIdx.x, lane = tid & 63, wave = tid >> 6;
    const int gw = blockIdx.x * NWAVES + wave, NGW = G * NWAVES;
    f32x4 g[8], bb[8];
#pragma unroll
    for (int j = 0; j < 8; ++j) { g[j] = *(const GAS f32x4*)(A.ln_g + 4 * lane + 256 * j); bb[j] = *(const GAS f32x4*)(A.ln_b + 4 * lane + 256 * j); }
    for (int row = gw; row < MR; row += NGW) {
        GAS f32x4* p = (GAS f32x4*)(A.out + O_YP + (size_t)row * DM) + lane;
        const GAS f32x4* xp = (const GAS f32x4*)(row < MP ? A.x_prompt + (size_t)row * DM : A.x_sample + (size_t)(row - MP) * DM) + lane;
        f32x4 v[8]; float s = 0.f;
#pragma unroll
        for (int j = 0; j < 8; ++j) { v[j] = xp[64 * j] * ALPHA + p[64 * j]; s += (v[j][0] + v[j][1]) + (v[j][2] + v[j][3]); }
        const float mean = wave_sum(s) * (1.f / DM); float q = 0.f;
#pragma unroll
        for (int j = 0; j < 8; ++j) { v[j] = v[j] - mean; q += (v[j][0] * v[j][0] + v[j][1] * v[j][1]) + (v[j][2] * v[j][2] + v[j][3] * v[j][3]); }
        const float rstd = rsqrtf(wave_sum(q) * (1.f / DM) + LN_EPS);
#pragma unroll
        for (int j = 0; j < 8; ++j) p[64 * j] = v[j] * rstd * g[j] + bb[j];
    }
}

typedef float f32x16 __attribute__((ext_vector_type(16)));
typedef unsigned u32x2 __attribute__((ext_vector_type(2)));
__device__ __forceinline__ unsigned off_b(unsigned row, unsigned ch) { return 256u * row + 16u * (ch ^ (((row & 3u) << 2) | ((row >> 2) & 3u))); }
#if !SEL_HIST
__device__ __forceinline__ void select_row(const float (&x)[32], int n, int lane, LAS float* scr, float& thr_v, int& thr_s) {
    const int NI = (n + 63) >> 6;
    float mn = INFINITY, mx = -INFINITY;
#pragma unroll
    for (int i = 0; i < 32; ++i) if (i < NI) { const bool ok = i * 64 + lane < n; mn = fminf(mn, ok ? x[i] : INFINITY); mx = fmaxf(mx, x[i]); }
#pragma unroll
    for (int o = 1; o < 64; o <<= 1) { mn = fminf(mn, __shfl_xor(mn, o)); mx = fmaxf(mx, __shfl_xor(mx, o)); }
    float lo = mn, hi = INFINITY; int c_lo = n, c_hi = 0;
    for (int it = 0; it < 96 && c_lo - c_hi > 64; ++it) {
        const float hf = (hi == INFINITY) ? mx : hi;
        const float mid = lo + 0.5f * (hf - lo);
        if (!(mid > lo) || (hi != INFINITY && !(mid < hi))) break;
        int c = 0;
#pragma unroll
        for (int i = 0; i < 32; ++i) if (i < NI) c += __popcll(__ballot(x[i] >= mid));
        if (c >= TOPK) { lo = mid; c_lo = c; } else { hi = mid; c_hi = c; }
    }
    const int m = c_lo - c_hi, r = TOPK - c_hi;
    int base = 0;
#pragma unroll
    for (int i = 0; i < 32; ++i) if (i < NI) {
        const bool cand = x[i] >= lo && x[i] < hi;
        const unsigned long long bal = __ballot(cand);
        if (cand) { const int pos = base + __popcll(bal & ((1ull << lane) - 1ull)); if (pos < 128) { scr[2 * pos] = x[i]; scr[2 * pos + 1] = __int_as_float(i * 64 + lane); } }
        base += __popcll(bal);
    }
    LDS_WAIT(); asm volatile("" ::: "memory");
    thr_v = lo; thr_s = 0x7fffffff;
    if (m <= 128) {
        float fv = 0.f; int fs = -1;
        for (int c0 = 0; c0 < m; c0 += 64) {
            const int cme = c0 + lane; const bool have = cme < m;
            const float v = have ? scr[2 * cme] : 0.f; const int sidx = have ? __float_as_int(scr[2 * cme + 1]) : 0;
            int rank = 0;
            for (int j = 0; j < m; ++j) { const float ov = scr[2 * j]; const int os = __float_as_int(scr[2 * j + 1]); rank += (ov > v || (ov == v && os < sidx)) ? 1 : 0; }
            const unsigned long long hit = __ballot(have && rank == r - 1);
            if (hit) { const int src = __ffsll((long long)hit) - 1; fv = __shfl(v, src); fs = __shfl(sidx, src); }
        }
        if (fs >= 0) { thr_v = fv; thr_s = fs; }
    }
    LDS_WAIT(); asm volatile("" ::: "memory");
}
#else
#define DPP_F(v, ctrl) __builtin_bit_cast(float, __builtin_amdgcn_update_dpp(0, __builtin_bit_cast(int, (v)), (ctrl), 0xf, 0xf, false))
__device__ __forceinline__ float wave_min_all(float v) {
    v = fminf(v, DPP_F(v, 0xB1)); v = fminf(v, DPP_F(v, 0x4E)); v = fminf(v, DPP_F(v, 0x141)); v = fminf(v, DPP_F(v, 0x140));
    const int vi = __builtin_bit_cast(int, v);
    const float r0 = __builtin_bit_cast(float, __builtin_amdgcn_readlane(vi, 0)), r1 = __builtin_bit_cast(float, __builtin_amdgcn_readlane(vi, 16)), r2 = __builtin_bit_cast(float, __builtin_amdgcn_readlane(vi, 32)), r3 = __builtin_bit_cast(float, __builtin_amdgcn_readlane(vi, 48));
    return fminf(fminf(r0, r1), fminf(r2, r3));
}
__device__ __forceinline__ float wave_max_all(float v) {
    v = fmaxf(v, DPP_F(v, 0xB1)); v = fmaxf(v, DPP_F(v, 0x4E)); v = fmaxf(v, DPP_F(v, 0x141)); v = fmaxf(v, DPP_F(v, 0x140));
    const int vi = __builtin_bit_cast(int, v);
    const float r0 = __builtin_bit_cast(float, __builtin_amdgcn_readlane(vi, 0)), r1 = __builtin_bit_cast(float, __builtin_amdgcn_readlane(vi, 16)), r2 = __builtin_bit_cast(float, __builtin_amdgcn_readlane(vi, 32)), r3 = __builtin_bit_cast(float, __builtin_amdgcn_readlane(vi, 48));
    return fmaxf(fmaxf(r0, r1), fmaxf(r2, r3));
}
__device__ __forceinline__ unsigned wave_prefix_incl(unsigned v, int lane) {
    v += (unsigned)__builtin_amdgcn_update_dpp(0, (int)v, 0x111, 0xf, 0xf, true);
    v += (unsigned)__builtin_amdgcn_update_dpp(0, (int)v, 0x112, 0xf, 0xf, true);
    v += (unsigned)__builtin_amdgcn_update_dpp(0, (int)v, 0x114, 0xf, 0xf, true);
    v += (unsigned)__builtin_amdgcn_update_dpp(0, (int)v, 0x118, 0xf, 0xf, true);
    const unsigned r0 = (unsigned)__builtin_amdgcn_readlane((int)v, 15), r1 = (unsigned)__builtin_amdgcn_readlane((int)v, 31), r2 = (unsigned)__builtin_amdgcn_readlane((int)v, 47);
    return v + (lane >= 16 ? r0 : 0u) + (lane >= 32 ? r1 : 0u) + (lane >= 48 ? r2 : 0u);
}
__device__ __forceinline__ void select_row(const float (&x)[32], int n, int lane, LAS float* scr, float& thr_v, int& thr_s) {
    LAS unsigned* hist = (LAS unsigned*)scr;
    unsigned act = 0u;
#pragma unroll
    for (int i = 0; i < 32; ++i) act |= (i * 64 + lane < n) ? (1u << i) : 0u;
    int need = TOPK;
    int m = n;
    for (int pass = 0; pass < 8 && m > 64; ++pass) {
        float mn = INFINITY, mx = -INFINITY;
#pragma unroll
        for (int i = 0; i < 32; ++i) { const bool on = (act >> i) & 1u; mn = fminf(mn, on ? x[i] : INFINITY); mx = fmaxf(mx, on ? x[i] : -INFINITY); }
        mn = wave_min_all(mn); mx = wave_max_all(mx);
        if (!(mx > mn)) break;
        const float scale = 255.f / (mx - mn);
        *(LAS v4u*)(hist + lane * 4) = (v4u){0u, 0u, 0u, 0u};
        LDS_WAIT(); asm volatile("" ::: "memory");
#pragma unroll
        for (int i = 0; i < 32; ++i) { if ((act >> i) & 1u) { int bn = (int)((x[i] - mn) * scale); bn = bn > 255 ? 255 : bn; __hip_atomic_fetch_add(hist + bn, 1u, __ATOMIC_RELAXED, __HIP_MEMORY_SCOPE_WAVEFRONT); } }
        LDS_WAIT(); asm volatile("" ::: "memory");
        const v4u hc = *(const LAS v4u*)(hist + (63 - lane) * 4);
        const unsigned tot4 = (hc.x + hc.y) + (hc.z + hc.w);
        const unsigned above_lane = wave_prefix_incl(tot4, lane) - tot4;
        const unsigned a3 = above_lane, a2 = a3 + hc.w, a1 = a2 + hc.z, a0 = a1 + hc.y;
        int jb = -1; unsigned ab = 0u, cb = 0u;
        if (a3 < (unsigned)need && (unsigned)need <= a3 + hc.w) { jb = 3; ab = a3; cb = hc.w; }
        else if (a2 < (unsigned)need && (unsigned)need <= a2 + hc.z) { jb = 2; ab = a2; cb = hc.z; }
        else if (a1 < (unsigned)need && (unsigned)need <= a1 + hc.y) { jb = 1; ab = a1; cb = hc.y; }
        else if (a0 < (unsigned)need && (unsigned)need <= a0 + hc.x) { jb = 0; ab = a0; cb = hc.x; }
        const unsigned long long who = __ballot(jb >= 0);
        const int src = __ffsll((long long)who) - 1;
        const int bstar = __builtin_amdgcn_readlane((63 - lane) * 4 + jb, src); const unsigned above = (unsigned)__builtin_amdgcn_readlane((int)ab, src);
        const unsigned cnt = (unsigned)__builtin_amdgcn_readlane((int)cb, src);
#pragma unroll
        for (int i = 0; i < 32; ++i) { const float xv = ((act >> i) & 1u) ? x[i] : mn; int bn = (int)((xv - mn) * scale); bn = bn > 255 ? 255 : bn; act &= (bn == bstar) ? 0xffffffffu : ~(1u << i); }
        need -= (int)above; m = (int)cnt;
    }
    int base = 0;
#pragma unroll
    for (int i = 0; i < 32; ++i) {
        const bool cand = (act >> i) & 1u;
        const unsigned long long bal = __ballot(cand);
        if (cand) { const int pos = base + __popcll(bal & ((1ull << lane) - 1ull)); if (pos < 128) { scr[2 * pos] = x[i]; scr[2 * pos + 1] = __int_as_float(i * 64 + lane); } }
        base += __popcll(bal);
    }
    LDS_WAIT(); asm volatile("" ::: "memory");
    thr_v = scr[0]; thr_s = 0x7fffffff;
    if (m <= 128) {
        float fv = 0.f; int fs = -1;
        for (int c0 = 0; c0 < m; c0 += 64) {
            const int cme = c0 + lane; const bool have = cme < m;
            const float v = have ? scr[2 * cme] : 0.f; const int sidx = have ? __float_as_int(scr[2 * cme + 1]) : 0;
            int rank = 0;
            for (int j = 0; j < m; ++j) { const float ov = scr[2 * j]; const int os = __float_as_int(scr[2 * j + 1]); rank += (ov > v || (ov == v && os < sidx)) ? 1 : 0; }
            const unsigned long long hit = __ballot(have && rank == need - 1);
            if (hit) { const int src = __ffsll((long long)hit) - 1; fv = __builtin_bit_cast(float, __builtin_amdgcn_readlane(__builtin_bit_cast(int, v), src)); fs = __builtin_amdgcn_readlane(sidx, src); }
        }
        if (fs >= 0) { thr_v = fv; thr_s = fs; }
    }
    LDS_WAIT(); asm volatile("" ::: "memory");
}
#endif
#if PROBE == 2
#define ISUB(k) do { if (blockIdx.x == PROBE_BLK && threadIdx.x == 0) ((unsigned long long*)(A.ws + WS_CTL + 800000))[16 + (k)] = __builtin_amdgcn_s_memrealtime(); } while (0)
#else
#define ISUB(k) do { } while (0)
#endif
__device__ __forceinline__ void p2_indexer(const Args& A, LAS unsigned char* lds, int unit) {
    const int tid = threadIdx.x, lane = tid & 63, wave = tid >> 6, r32 = lane & 31, hlf = lane >> 5;
    const bf16* IQb = (const bf16*)(A.ws + WS_IQB); const bf16* IKb = (const bf16*)(A.ws + WS_IKB); const float* IW = (const float*)(A.ws + WS_IW);
    unsigned* MASK = (unsigned*)(A.ws + WS_MASK);
    const int b = unit >> 6, p = unit & 63;
    LAS float* S = (LAS float*)(lds + RING_OFF);
    LAS unsigned char* kst = lds + AUX_OFF;
    LAS float* scr = (LAS float*)(lds + AUX_OFF + 16384 + wave * 1024);
    for (int half = 0; half < 2; ++half) {
        const int ti = half == 0 ? p : 127 - p, t0 = 16 * ti, nk = t0 + 16, n64 = (nk + 63) >> 6;
        const int qa = (r32 >> 2) & 1, ha = (r32 & 3) + 4 * (r32 >> 3);
        bf16x8 aq[4];
#pragma unroll
        for (int ks = 0; ks < 4; ++ks) aq[ks] = *(const GAS bf16x8*)(IQb + (size_t)(b * T + t0 + 2 * wave + qa) * WA + ha * DI + 16 * ks + 8 * hlf);
        float wv[16];
        { const GAS f32x4* wp = (const GAS f32x4*)(IW + (size_t)(b * T + t0 + 2 * wave + hlf) * HI);
#pragma unroll
          for (int q = 0; q < 4; ++q) { const f32x4 w4 = wp[q]; wv[4 * q] = w4[0]; wv[4 * q + 1] = w4[1]; wv[4 * q + 2] = w4[2]; wv[4 * q + 3] = w4[3]; } }
        const int tq = t0 + 2 * wave + hlf;
        const int srow = tid >> 3, sch = tid & 7;
        const GAS v4u* ksrc = (const GAS v4u*)(IKb + (size_t)(b * T) * DI) + (size_t)srow * 8 + (sch ^ ((srow >> 1) & 7));
        v4u stg = ksrc[0];
        *(LAS v4u*)(kst + tid * 16) = stg;
        v4u s1 = ksrc[(size_t)(1 < n64 ? 1 : 0) * 512], s2 = ksrc[(size_t)(2 < n64 ? 2 : 0) * 512], s3 = ksrc[(size_t)(3 < n64 ? 3 : 0) * 512];
        LDS_WAIT(); __syncthreads();
        for (int kt = 0; kt < n64; ++kt) {
            const LAS unsigned char* kb = kst + (kt & 1) * 8192;
            bf16x8 kf[2][4];
#pragma unroll
            for (int g = 0; g < 2; ++g)
#pragma unroll
                for (int ks = 0; ks < 4; ++ks) { const int krow = 32 * g + r32; kf[g][ks] = *(const LAS bf16x8*)(kb + krow * 128 + (((2 * ks + hlf) ^ ((krow >> 1) & 7)) << 4)); }
            __builtin_amdgcn_sched_barrier(0);
#pragma unroll
            for (int g = 0; g < 2; ++g) {
                f32x16 C;
#pragma unroll
                for (int i = 0; i < 16; ++i) C[i] = 0.f;
#pragma unroll
                for (int ks = 0; ks < 4; ++ks) C = __builtin_amdgcn_mfma_f32_32x32x16_bf16(aq[ks], kf[g][ks], C, 0, 0, 0);
                float sc = 0.f;
#pragma unroll
                for (int i = 0; i < 16; ++i) sc = fmaf(wv[i], fmaxf(C[i], 0.f), sc);
                const int key = 64 * kt + 32 * g + r32;
                S[(2 * wave + hlf) * 2048 + key] = key <= tq ? sc : -INFINITY;
            }
            if (kt + 1 < n64) *(LAS v4u*)(kst + ((kt + 1) & 1) * 8192 + tid * 16) = s1;
            s1 = s2; s2 = s3;
            if (kt + 4 < n64) s3 = ksrc[(size_t)(kt + 4) * 512];
            LDS_WAIT(); __syncthreads();
        }
        ISUB(20 + 2 * half);
        for (int qi = 0; qi < 2; ++qi) {
            const int t = t0 + 2 * wave + qi, n = t + 1, NI = (n + 63) >> 6;
            unsigned long long mk = 0ull;
            if (n <= TOPK) {
#pragma unroll
                for (int i = 0; i < 32; ++i) { const unsigned long long bal = __ballot(i * 64 + lane <= t); if (lane == i) mk = bal; }
            } else {
                float x[32];
#pragma unroll
                for (int i = 0; i < 32; ++i) x[i] = (i * 64 + lane < n) ? S[(2 * wave + qi) * 2048 + i * 64 + lane] : -INFINITY;
                float thr_v; int thr_s;
                select_row(x, n, lane, scr, thr_v, thr_s);
#pragma unroll
                for (int i = 0; i < 32; ++i) { const int sidx = i * 64 + lane; const unsigned long long bal = __ballot(x[i] > thr_v || (x[i] == thr_v && sidx <= thr_s)); if (lane == i) mk = bal; }
            }
            if (lane < 32) *(GAS unsigned long long*)(MASK + (size_t)(b * T + t) * 64 + 2 * lane) = mk;
        }
        ISUB(21 + 2 * half);
    }
    __syncthreads();
}

struct AttnUnit {
    const bf16* Q; int ldq;
    const bf16* K; const bf16* V; int ldkv;
    const unsigned* mask;
    int qrow0, qrow1;
    int ntile0, ntile1;
    int pos0, pos1;
    bf16* cat; int ldc;
    const bf16* gate; int ldg;
    float* of32; int ldo;
};
__device__ __forceinline__ void attn_unit(const AttnUnit& U, LAS unsigned char* lds) {
    const int tid = threadIdx.x, lane = tid & 63, wave = __builtin_amdgcn_readfirstlane(tid >> 6), r32 = lane & 31, hlf = lane >> 5, wg = wave >> 2, ww = wave & 3;
    const int myrow = (wg ? U.qrow1 : U.qrow0) + 32 * ww + r32;
    int ntw = wg ? U.ntile1 : U.ntile0; { const int lastpos = (wg ? U.pos1 : U.pos0) + 32 * ww + 31; const int lim = (lastpos >> 7) + 1; ntw = lim < ntw ? lim : ntw; }
    const int maxt = U.ntile0 > U.ntile1 ? U.ntile0 : U.ntile1;
    bf16x8 qf[8];
#pragma unroll
    for (int ks = 0; ks < 8; ++ks) qf[ks] = *(const GAS bf16x8*)(U.Q + (size_t)myrow * U.ldq + 16 * ks + 8 * hlf);
    f32x16 O[4];
#pragma unroll
    for (int c = 0; c < 4; ++c)
#pragma unroll
        for (int i = 0; i < 16; ++i) O[c][i] = 0.f;
    float m_run = -1e30f, l_run = 0.f;
    unsigned gofs[4];
#pragma unroll
    for (int i = 0; i < 4; ++i) { const unsigned row = 16u * wave + 4u * i + (lane >> 4), chs = lane & 15u, f = ((row & 3u) << 2) | ((row >> 2) & 3u); gofs[i] = row * (unsigned)U.ldkv + ((chs ^ f) << 3); }
    const size_t tstep = (size_t)128 * U.ldkv;
#define ATT_STAGE(kt_, st_) do { _Pragma("unroll") for (int _i = 0; _i < 4; ++_i) { \
        __builtin_amdgcn_global_load_lds((const unsigned*)(U.K + (size_t)(kt_) * tstep + gofs[_i]), (LAS unsigned*)(lds + RING_OFF + (st_) * 65536 + (wave * 4 + _i) * 1024), 16, 0, 0); \
        __builtin_amdgcn_global_load_lds((const unsigned*)(U.V + (size_t)(kt_) * tstep + gofs[_i]), (LAS unsigned*)(lds + RING_OFF + (st_) * 65536 + 32768 + (wave * 4 + _i) * 1024), 16, 0, 0); } } while (0)
    unsigned kofs[8];
#pragma unroll
    for (int ks = 0; ks < 8; ++ks) kofs[ks] = off_b(r32, 2 * ks + hlf);
    const unsigned blk = (lane >> 4) & 1, q4 = (lane & 15) >> 2, p4 = lane & 3;
    unsigned vb2[2], vx[4];
#pragma unroll
    for (int t = 0; t < 2; ++t) vb2[t] = 256u * (8 * t + 4 * hlf + q4) + 16u * ((2 * blk + (p4 >> 1)) ^ ((2 * t + hlf) & 3)) + 8u * (p4 & 1);
#pragma unroll
    for (int c = 0; c < 4; ++c) vx[c] = 64u * (c ^ q4);
    v4u mnext = (v4u){0xffffffffu, 0xffffffffu, 0xffffffffu, 0xffffffffu};
    if (U.mask) mnext = *(const GAS v4u*)(U.mask + (size_t)myrow * 64);
    ATT_STAGE(0, 0);
    asm volatile("s_waitcnt vmcnt(0) lgkmcnt(0)" ::: "memory"); __builtin_amdgcn_s_barrier(); asm volatile("" ::: "memory");
    typedef short s16x4 __attribute__((ext_vector_type(4)));
    for (int kt = 0; kt < maxt; ++kt) {
        const bool more = kt + 1 < maxt;
        v4u mcur = mnext;
        asm volatile("" : "+v"(mcur));
        if (more) {
            ATT_STAGE(kt + 1, (kt + 1) & 1);
            if (U.mask) mnext = *(const GAS v4u*)(U.mask + (size_t)myrow * 64 + 4 * (kt + 1));
        }
        if (kt < ntw) {
            const LAS unsigned char* kb = lds + RING_OFF + (kt & 1) * 65536; const unsigned vbase = (unsigned)(RING_OFF + (kt & 1) * 65536 + 32768);
#pragma unroll
            for (int g = 0; g < 4; ++g) {
                bf16x8 kf[8];
#pragma unroll
                for (int ks = 0; ks < 8; ++ks) kf[ks] = *(const LAS bf16x8*)(kb + 8192 * g + kofs[ks]);
                __builtin_amdgcn_sched_barrier(0);
                f32x16 C;
#pragma unroll
                for (int i = 0; i < 16; ++i) C[i] = 0.f;
#pragma unroll
                for (int ks = 0; ks < 8; ++ks) C = __builtin_amdgcn_mfma_f32_32x32x16_bf16(kf[ks], qf[ks], C, 0, 0, 0);
                __builtin_amdgcn_sched_barrier(0);
                s16x4 vlo[8], vhi[8];
#pragma unroll
                for (int c = 0; c < 4; ++c)
#pragma unroll
                    for (int s2 = 0; s2 < 2; ++s2) {
                        const unsigned a0 = vbase + vb2[0] + vx[c], a1 = vbase + vb2[1] + vx[c];
                        asm volatile("ds_read_b64_tr_b16 %0, %1 offset:%c2" : "=&v"(vlo[c * 2 + s2]) : "v"(a0), "i"(256 * (32 * g + 16 * s2)) : "memory");
                        asm volatile("ds_read_b64_tr_b16 %0, %1 offset:%c2" : "=&v"(vhi[c * 2 + s2]) : "v"(a1), "i"(256 * (32 * g + 16 * s2)) : "memory");
                    }
                __builtin_amdgcn_sched_barrier(0);
                const unsigned mw = (g == 0 ? mcur.x : g == 1 ? mcur.y : g == 2 ? mcur.z : mcur.w) >> (4 * hlf);
                float smax = -INFINITY;
#pragma unroll
                for (int i = 0; i < 16; ++i) { const int bit = (i & 3) + 8 * (i >> 2); C[i] = ((mw >> bit) & 1u) ? C[i] : -INFINITY; smax = fmaxf(smax, C[i]); }
                { auto rr = __builtin_amdgcn_permlane32_swap(__float_as_uint(smax), __float_as_uint(smax), false, false); smax = fmaxf(__uint_as_float(rr[0]), __uint_as_float(rr[1])); }
                const float m_new = fmaxf(m_run, smax);
                if (!__all(m_new == m_run)) {
                    const float alpha = __builtin_amdgcn_exp2f(m_run - m_new);
                    l_run *= alpha;
#pragma unroll
                    for (int c = 0; c < 4; ++c)
#pragma unroll
                        for (int i = 0; i < 16; ++i) O[c][i] *= alpha;
                    m_run = m_new;
                }
                float psum = 0.f;
#pragma unroll
                for (int i = 0; i < 16; ++i) { C[i] = __builtin_amdgcn_exp2f(C[i] - m_run); psum += C[i]; }
                l_run += psum;
                bf16x8 pf[2];
#pragma unroll
                for (int s2 = 0; s2 < 2; ++s2) { v4u w; w.x = pg8::cvt_pk_bf16(C[8 * s2 + 0], C[8 * s2 + 1]); w.y = pg8::cvt_pk_bf16(C[8 * s2 + 2], C[8 * s2 + 3]); w.z = pg8::cvt_pk_bf16(C[8 * s2 + 4], C[8 * s2 + 5]); w.w = pg8::cvt_pk_bf16(C[8 * s2 + 6], C[8 * s2 + 7]); pf[s2] = __builtin_bit_cast(bf16x8, w); }
                __builtin_amdgcn_sched_barrier(0);
                asm volatile("s_waitcnt lgkmcnt(0)" : "+v"(vlo[0]), "+v"(vlo[1]), "+v"(vlo[2]), "+v"(vlo[3]), "+v"(vlo[4]), "+v"(vlo[5]), "+v"(vlo[6]), "+v"(vlo[7]),
                                                       "+v"(vhi[0]), "+v"(vhi[1]), "+v"(vhi[2]), "+v"(vhi[3]), "+v"(vhi[4]), "+v"(vhi[5]), "+v"(vhi[6]), "+v"(vhi[7]) :: "memory");
                __builtin_amdgcn_sched_barrier(0);
#pragma unroll
                for (int c = 0; c < 4; ++c)
#pragma unroll
                    for (int s2 = 0; s2 < 2; ++s2) {
                        const s16x4 lo4 = vlo[c * 2 + s2], hi4 = vhi[c * 2 + s2];
                        const bf16x8 vf = (bf16x8){lo4[0], lo4[1], lo4[2], lo4[3], hi4[0], hi4[1], hi4[2], hi4[3]};
                        O[c] = __builtin_amdgcn_mfma_f32_32x32x16_bf16(vf, pf[s2], O[c], 0, 0, 0);
                    }
                __builtin_amdgcn_sched_barrier(0);
            }
        }
        asm volatile("s_waitcnt vmcnt(0) lgkmcnt(0)" ::: "memory"); __builtin_amdgcn_s_barrier(); asm volatile("" ::: "memory");
    }
#undef ATT_STAGE
    const float l_tot = l_run + __shfl_xor(l_run, 32);
    const float inv = 1.f / l_tot;
#pragma unroll
    for (int c = 0; c < 4; ++c)
#pragma unroll
        for (int g4 = 0; g4 < 4; ++g4) {
            const int d = 32 * c + 8 * g4 + 4 * hlf;
            f32x4 o; o[0] = O[c][4 * g4] * inv; o[1] = O[c][4 * g4 + 1] * inv; o[2] = O[c][4 * g4 + 2] * inv; o[3] = O[c][4 * g4 + 3] * inv;
            if (U.of32) *(GAS f32x4*)(U.of32 + (size_t)myrow * U.ldo + d) = o;
            const u32x2 gg = *(const GAS u32x2*)(U.gate + (size_t)myrow * U.ldg + d);
            const float g0 = __uint_as_float(gg.x << 16), g1 = __uint_as_float(gg.x & 0xffff0000u), g2 = __uint_as_float(gg.y << 16), g3 = __uint_as_float(gg.y & 0xffff0000u);
            u32x2 w; w.x = pg8::cvt_pk_bf16(o[0] * g0, o[1] * g1); w.y = pg8::cvt_pk_bf16(o[2] * g2, o[3] * g3);
            *(GAS u32x2*)(U.cat + (size_t)myrow * U.ldc + d) = w;
        }
    __syncthreads();
}
__device__ __forceinline__ void p3_dsa_attn(const Args& A, LAS unsigned char* lds, int unit, float* a_f32) {
    const int b = unit >> 6, h = (unit >> 3) & 7, j = unit & 7;
    AttnUnit U;
    U.Q = (const bf16*)(A.ws + WS_QB) + h * DH; U.ldq = WA;
    U.K = (const bf16*)(A.ws + WS_KB) + (size_t)(b * T) * WA + h * DH; U.V = (const bf16*)(A.ws + WS_VB) + (size_t)(b * T) * WA + h * DH; U.ldkv = WA;
    U.mask = (const unsigned*)(A.ws + WS_MASK);
    U.qrow0 = b * T + 128 * j; U.qrow1 = b * T + 128 * (15 - j);
    U.ntile0 = j + 1; U.ntile1 = 16 - j;
    U.pos0 = 128 * j; U.pos1 = 128 * (15 - j);
    U.cat = (bf16*)(A.ws + WS_CATB) + h * DH; U.ldc = DM;
    U.gate = (const bf16*)(A.ws + WS_GA) + h * DH; U.ldg = WA;
    U.of32 = a_f32 ? a_f32 + h * DH : nullptr; U.ldo = WA;
    attn_unit(U, lds);
}

__device__ __forceinline__ void p2_memattn(const Args& A, LAS unsigned char* lds, int unit, float* m_f32) {
    const int b = unit >> 5, hm = (unit >> 3) & 3, jq = unit & 7;
    AttnUnit U;
    U.Q = (const bf16*)(A.ws + WS_MQB) + hm * DH; U.ldq = WM;
    U.K = (const bf16*)(A.ws + WS_MKB) + (size_t)(b * NMEM) * WM + hm * DH; U.V = (const bf16*)(A.ws + WS_MVB) + (size_t)(b * NMEM) * WM + hm * DH; U.ldkv = WM;
    U.mask = nullptr;
    U.qrow0 = b * T + 128 * jq; U.qrow1 = b * T + 128 * (jq + 8);
    U.ntile0 = NMEM / 128; U.ntile1 = NMEM / 128; U.pos0 = 1 << 28; U.pos1 = 1 << 28;
    U.cat = (bf16*)(A.ws + WS_CATB) + WA + WB + hm * DH; U.ldc = DM;
    U.gate = (const bf16*)(A.ws + WS_GM) + hm * DH; U.ldg = WM;
    U.of32 = m_f32 ? m_f32 + hm * DH : nullptr; U.ldo = WM;
    attn_unit(U, lds);
}

typedef short s16x4 __attribute__((ext_vector_type(4)));
__device__ __forceinline__ bf16x8 tr_frag(const LAS unsigned char* img, unsigned row0, unsigned rstep, unsigned ch, unsigned hlf, unsigned q4, unsigned p4) {
    const unsigned a0 = off_b(row0 + q4, ch) + 8 * (p4 & 1), a1 = off_b(row0 + rstep + q4, ch) + 8 * (p4 & 1);
    const s16x4 lo4 = __builtin_bit_cast(s16x4, __builtin_amdgcn_ds_read_tr16_b64_v4i16((LAS s16x4*)(img + a0)));
    const s16x4 hi4 = __builtin_bit_cast(s16x4, __builtin_amdgcn_ds_read_tr16_b64_v4i16((LAS s16x4*)(img + a1)));
    return (bf16x8){lo4[0], lo4[1], lo4[2], lo4[3], hi4[0], hi4[1], hi4[2], hi4[3]};
}
__device__ __forceinline__ void hgrn1_unit(const Args& A, LAS unsigned char* lds, int unit) {
    const int tid = threadIdx.x, lane = tid & 63, wave = tid >> 6, r32 = lane & 31, hlf = lane >> 5;
    const unsigned blk = (lane >> 4) & 1, q4 = (lane & 15) >> 2, p4 = lane & 3;
    const int b = unit / (HB * NCH), hd = (unit / NCH) % HB, c = unit % NCH, r0 = b * T + 64 * c, col0 = hd * DK;
    const float* HQ = (const float*)(A.ws + WS_HQ); const float* HG = (const float*)(A.ws + WS_HG); const bf16* HV = (const bf16*)(A.ws + WS_HV);
    bf16* QABS = (bf16*)(A.ws + WS_QABS); float* OT = (float*)(A.ws + WS_OT) + (size_t)unit * 128 * 64; float* KVT = (float*)(A.ws + WS_KVT) + (size_t)unit * 128 * 128; float* EG = (float*)(A.ws + WS_EG) + (size_t)unit * 128;
    LAS float* Gs = (LAS float*)(lds + RING_OFF);
    LAS unsigned char* QT = lds + RING_OFF + 32768;
    LAS unsigned char* KT = QT + 16384;
    LAS unsigned char* KD = KT + 16384;
    LAS unsigned char* VI = KD + 16384;
    LAS unsigned char* KH = VI + 16384;
    LAS float* tot = (LAS float*)(KH + 8192);
    { const int d = tid & 127, tq = tid >> 7; float gl[16]; float run = 0.f;
#pragma unroll
      for (int i = 0; i < 16; ++i) { run += HG[(size_t)(r0 + 16 * tq + i) * WB + col0 + d]; gl[i] = run; }
      tot[tq * 128 + d] = run; LDS_WAIT(); __syncthreads();
      float offs = 0.f;
#pragma unroll
      for (int j = 0; j < 3; ++j) offs += (j < tq) ? tot[j * 128 + d] : 0.f;
#pragma unroll
      for (int i = 0; i < 16; ++i) Gs[(16 * tq + i) * 128 + d] = gl[i] + offs;
      LDS_WAIT(); __syncthreads(); }
#pragma unroll
    for (int it = 0; it < 2; ++it) {
        const int item = tid + 512 * it, t = item >> 4, d8 = item & 15, d0 = 8 * d8;
        const size_t go = (size_t)(r0 + t) * WB + col0 + d0;
        f32x4 q0 = *(const GAS f32x4*)(HQ + go), q1 = *(const GAS f32x4*)(HQ + go + 4), g0 = *(const GAS f32x4*)(HG + go), g1 = *(const GAS f32x4*)(HG + go + 4);
        const f32x4 G0 = *(const LAS f32x4*)(Gs + t * 128 + d0), G1 = *(const LAS f32x4*)(Gs + t * 128 + d0 + 4);
        const f32x4 M0 = *(const LAS f32x4*)(Gs + 31 * 128 + d0), M1 = *(const LAS f32x4*)(Gs + 31 * 128 + d0 + 4);
        const f32x4 E0 = *(const LAS f32x4*)(Gs + 63 * 128 + d0), E1 = *(const LAS f32x4*)(Gs + 63 * 128 + d0 + 4);
        f32x4 qt0, qt1, kt0, kt1, kd0, kd1, kh0, kh1, qa0, qa1;
#pragma unroll
        for (int e = 0; e < 4; ++e) {
            { const float G = G0[e], gs = t < 32 ? 0.f : M0[e], k = 1.f - fexp(g0[e]);
              qt0[e] = q0[e] * fexp(G - gs); kt0[e] = k * fexp(gs - G); kd0[e] = k * fexp(E0[e] - G); kh0[e] = k * fexp(M0[e] - G); qa0[e] = q0[e] * fexp(G); }
            { const float G = G1[e], gs = t < 32 ? 0.f : M1[e], k = 1.f - fexp(g1[e]);
              qt1[e] = q1[e] * fexp(G - gs); kt1[e] = k * fexp(gs - G); kd1[e] = k * fexp(E1[e] - G); kh1[e] = k * fexp(M1[e] - G); qa1[e] = q1[e] * fexp(G); }
        }
        const unsigned o = off_b(t, d8);
        *(LAS v4u*)(QT + o) = pack8(qt0, qt1); *(LAS v4u*)(KT + o) = pack8(kt0, kt1); *(LAS v4u*)(KD + o) = pack8(kd0, kd1);
        if (t < 32) *(LAS v4u*)(KH + o) = pack8(kh0, kh1);
        *(LAS v4u*)(VI + o) = *(const GAS v4u*)(HV + go);
        *(GAS v4u*)(QABS + go) = pack8(qa0, qa1);
        if (t == 63) { f32x4 x0, x1;
#pragma unroll
            for (int e = 0; e < 4; ++e) { x0[e] = fexp(E0[e]); x1[e] = fexp(E1[e]); }
            *(GAS f32x4*)(EG + d0) = x0; *(GAS f32x4*)(EG + d0 + 4) = x1; }
    }
    LDS_WAIT(); __syncthreads();
    if (wave < 4) {
        f32x16 acc[4];
#pragma unroll
        for (int db = 0; db < 4; ++db)
#pragma unroll
            for (int i = 0; i < 16; ++i) acc[db][i] = 0.f;
#pragma unroll
        for (int ks = 0; ks < 4; ++ks) {
            const bf16x8 vf = tr_frag(VI, 16 * ks + 8 * hlf, 4, 4 * wave + 2 * blk + (p4 >> 1), 0, q4, p4);
#pragma unroll
            for (int db = 0; db < 4; ++db) { const bf16x8 kf = tr_frag(KD, 16 * ks + 8 * hlf, 4, 4 * db + 2 * blk + (p4 >> 1), 0, q4, p4); acc[db] = __builtin_amdgcn_mfma_f32_32x32x16_bf16(vf, kf, acc[db], 0, 0, 0); }
        }
#pragma unroll
        for (int db = 0; db < 4; ++db)
#pragma unroll
            for (int i = 0; i < 16; ++i) KVT[(size_t)(32 * wave + (i & 3) + 8 * (i >> 2) + 4 * hlf) * 128 + 32 * db + r32] = acc[db][i];
    } else {
        const int x = wave - 4, tb = x & 1, vh = x >> 1;
        f32x16 oacc[2];
#pragma unroll
        for (int j = 0; j < 2; ++j)
#pragma unroll
            for (int i = 0; i < 16; ++i) oacc[j][i] = 0.f;
#pragma unroll
        for (int sb = 0; sb < 2; ++sb) {
            if (sb <= tb) {
                f32x16 X;
#pragma unroll
                for (int i = 0; i < 16; ++i) X[i] = 0.f;
                const LAS unsigned char* kimg = (sb == tb) ? KT : KH;
                const unsigned krow = (sb == tb) ? 32 * sb + r32 : r32;
#pragma unroll
                for (int ks = 0; ks < 8; ++ks) { const bf16x8 kf = *(const LAS bf16x8*)(kimg + off_b(krow, 2 * ks + hlf)); const bf16x8 qf = *(const LAS bf16x8*)(QT + off_b(32 * tb + r32, 2 * ks + hlf)); X = __builtin_amdgcn_mfma_f32_32x32x16_bf16(kf, qf, X, 0, 0, 0); }
                if (sb == tb) {
#pragma unroll
                    for (int i = 0; i < 16; ++i) { const int sl = (i & 3) + 8 * (i >> 2) + 4 * hlf; X[i] = sl <= r32 ? X[i] : 0.f; }
                }
                bf16x8 pf[2];
#pragma unroll
                for (int s2 = 0; s2 < 2; ++s2) { v4u w; w.x = pg8::cvt_pk_bf16(X[8 * s2 + 0], X[8 * s2 + 1]); w.y = pg8::cvt_pk_bf16(X[8 * s2 + 2], X[8 * s2 + 3]); w.z = pg8::cvt_pk_bf16(X[8 * s2 + 4], X[8 * s2 + 5]); w.w = pg8::cvt_pk_bf16(X[8 * s2 + 6], X[8 * s2 + 7]); pf[s2] = __builtin_bit_cast(bf16x8, w); }
#pragma unroll
                for (int j = 0; j < 2; ++j)
#pragma unroll
                    for (int s2 = 0; s2 < 2; ++s2) { const bf16x8 vf = tr_frag(VI, 32 * sb + 16 * s2 + 4 * hlf, 8, 4 * (2 * vh + j) + 2 * blk + (p4 >> 1), 0, q4, p4); oacc[j] = __builtin_amdgcn_mfma_f32_32x32x16_bf16(vf, pf[s2], oacc[j], 0, 0, 0); }
            }
        }
#pragma unroll
        for (int j = 0; j < 2; ++j)
#pragma unroll
            for (int i = 0; i < 16; ++i) OT[(size_t)(32 * (2 * vh + j) + (i & 3) + 8 * (i >> 2) + 4 * hlf) * 64 + 32 * tb + r32] = oacc[j][i];
    }
    LDS_WAIT(); __syncthreads();
}
__device__ __forceinline__ void hgrn2_scan(const Args& A, int G) {
    const float* KVT = (const float*)(A.ws + WS_KVT); const float* EG = (const float*)(A.ws + WS_EG); bf16* SCT = (bf16*)(A.ws + WS_SCT);
    const size_t gtid = (size_t)blockIdx.x * 512 + threadIdx.x, gthreads = (size_t)G * 512;
    for (size_t e = gtid; e < (size_t)NB * HB * 128 * 128; e += gthreads) {
        const int bh = (int)(e >> 14), vd = (int)(e & 16383), d = vd & 127, v = vd >> 7;
        float kv[NCH], eg[NCH];
#pragma unroll
        for (int c = 0; c < NCH; ++c) { kv[c] = KVT[((size_t)(bh * NCH + c) << 14) + vd]; eg[c] = EG[(size_t)(bh * NCH + c) * 128 + d]; }
        float S = 0.f;
#pragma unroll
        for (int c = 0; c < NCH; ++c) { SCT[((size_t)(bh * NCH + c) << 14) + vd] = (bf16)f2bf(S); S = fmaf(eg[c], S, kv[c]); }
        A.out[O_HP + ((size_t)bh * DK + d) * DV + v] = S;
    }
}
__device__ __forceinline__ void hgrn3_unit(const Args& A, LAS unsigned char* lds, int unit, float* bo_f32) {
    const int tid = threadIdx.x, lane = tid & 63, wave = tid >> 6, r32 = lane & 31, hlf = lane >> 5, vb = wave & 3, tb = wave >> 2;
    const int b = unit / (HB * NCH), hd = (unit / NCH) % HB, c = unit % NCH, r0 = b * T + 64 * c, col0 = hd * DK;
    const float* OT = (const float*)(A.ws + WS_OT) + (size_t)unit * 128 * 64; const bf16* SCT = (const bf16*)(A.ws + WS_SCT) + (size_t)unit * 128 * 128; const bf16* QABS = (const bf16*)(A.ws + WS_QABS);
    LAS float* ssq = (LAS float*)(lds + RING_OFF);
    f32x16 acc;
#pragma unroll
    for (int i = 0; i < 16; ++i) acc[i] = OT[(size_t)(32 * vb + (i & 3) + 8 * (i >> 2) + 4 * hlf) * 64 + 32 * tb + r32];
    if (c > 0) {
#pragma unroll
        for (int ks = 0; ks < 8; ++ks) {
            const bf16x8 sf = *(const GAS bf16x8*)(SCT + (size_t)(32 * vb + r32) * 128 + 16 * ks + 8 * hlf);
            const bf16x8 qf = *(const GAS bf16x8*)(QABS + (size_t)(r0 + 32 * tb + r32) * WB + col0 + 16 * ks + 8 * hlf);
            acc = __builtin_amdgcn_mfma_f32_32x32x16_bf16(sf, qf, acc, 0, 0, 0);
        }
    }
    float sq = 0.f;
#pragma unroll
    for (int i = 0; i < 16; ++i) sq = fmaf(acc[i], acc[i], sq);
    sq += __shfl_xor(sq, 32);
    if (hlf == 0) ssq[(tb * 4 + vb) * 32 + r32] = sq;
    LDS_WAIT(); __syncthreads();
    const float tot = (ssq[(tb * 4 + 0) * 32 + r32] + ssq[(tb * 4 + 1) * 32 + r32]) + (ssq[(tb * 4 + 2) * 32 + r32] + ssq[(tb * 4 + 3) * 32 + r32]);
    const float rs = rsqrtf(tot * (1.f / DV) + RMS_EPS);
    const int row = r0 + 32 * tb + r32;
    const bf16* GB = (const bf16*)(A.ws + WS_GB); bf16* CATb = (bf16*)(A.ws + WS_CATB);
#pragma unroll
    for (int g4 = 0; g4 < 4; ++g4) {
        const int v = 32 * vb + 8 * g4 + 4 * hlf;
        f32x4 o; o[0] = acc[4 * g4]; o[1] = acc[4 * g4 + 1]; o[2] = acc[4 * g4 + 2]; o[3] = acc[4 * g4 + 3];
        if (bo_f32) *(GAS f32x4*)(bo_f32 + (size_t)row * WB + col0 + v) = o;
        const f32x4 ng = *(const GAS f32x4*)(A.norm_g + v);
        const u32x2 gg = *(const GAS u32x2*)(GB + (size_t)row * WB + col0 + v);
        const float g0 = __uint_as_float(gg.x << 16), g1 = __uint_as_float(gg.x & 0xffff0000u), g2 = __uint_as_float(gg.y << 16), g3 = __uint_as_float(gg.y & 0xffff0000u);
        u32x2 w; w.x = pg8::cvt_pk_bf16(o[0] * rs * ng[0] * g0, o[1] * rs * ng[1] * g1); w.y = pg8::cvt_pk_bf16(o[2] * rs * ng[2] * g2, o[3] * rs * ng[3] * g3);
        *(GAS u32x2*)(CATb + (size_t)row * DM + WA + col0 + v) = w;
    }
    LDS_WAIT(); __syncthreads();
}

__device__ __forceinline__ float bf2f(unsigned short h) { return __uint_as_float((unsigned)h << 16); }
__device__ __forceinline__ void s1_unit(const Args& A, int r) {
    const float* z = (const float*)(A.ws + WS_ZS) + (size_t)r * NIN; const float2* ropeA = (const float2*)(A.ws + WS_ROPEA) + (size_t)(T + (r & (ST - 1))) * 16;
    for (int c = threadIdx.x; c < WA; c += 512) {
        const int d = c & 127; float k = z[C_AK + c];
        if (d < 32) { const int j = d & 15; const bool lo = d < 16; const float x1 = z[C_AK + (lo ? c : c - 16)], x2 = z[C_AK + (lo ? c + 16 : c)]; const float2 cs = ropeA[j]; k = lo ? x1 * cs.x - x2 * cs.y : x2 * cs.x + x1 * cs.y; }
        A.out[O_KS + (size_t)r * WA + c] = k; A.out[O_VS + (size_t)r * WA + c] = z[C_AV + c];
    }
}
__device__ __forceinline__ void s2_unit(const Args& A, int unit) {
    const int tid = threadIdx.x, lane = tid & 63, wave = tid >> 6, r32 = lane & 31, hlf = lane >> 5, qp = wave & 3, kh = wave >> 2;
    const int b = unit >> 7, pg = unit & 127;
    const float* Zs = (const float*)(A.ws + WS_ZS); const float* IW = (const float*)(A.ws + WS_IW); const float2* ropeI = (const float2*)(A.ws + WS_ROPEI); float* SCs = (float*)(A.ws + WS_SCS);
    const int qa = (r32 >> 2) & 1, ha = (r32 & 3) + 4 * (r32 >> 3), qrow = b * ST + 2 * qp + qa;
    const float* src = Zs + (size_t)qrow * NIN + C_IQ + ha * DI;
    bf16x8 aq[4];
    { f32x4 x1a = *(const GAS f32x4*)(src), x1b = *(const GAS f32x4*)(src + 4), x2a = *(const GAS f32x4*)(src + 8), x2b = *(const GAS f32x4*)(src + 12);
      const GAS f32x4* cp = (const GAS f32x4*)(ropeI + (size_t)(T + 2 * qp + qa) * 8);
      f32x4 o0, o1;
#pragma unroll
      for (int q = 0; q < 2; ++q) { const f32x4 c01 = cp[q], c23 = cp[2 + q];
          const float a0 = x1a[2 * q], a1 = x1a[2 * q + 1], b0 = x2a[2 * q], b1 = x2a[2 * q + 1], a2 = x1b[2 * q], a3 = x1b[2 * q + 1], b2 = x2b[2 * q], b3 = x2b[2 * q + 1];
          o0[2 * q] = hlf == 0 ? a0 * c01[0] - b0 * c01[1] : b0 * c01[0] + a0 * c01[1]; o0[2 * q + 1] = hlf == 0 ? a1 * c01[2] - b1 * c01[3] : b1 * c01[2] + a1 * c01[3];
          o1[2 * q] = hlf == 0 ? a2 * c23[0] - b2 * c23[1] : b2 * c23[0] + a2 * c23[1]; o1[2 * q + 1] = hlf == 0 ? a3 * c23[2] - b3 * c23[3] : b3 * c23[2] + a3 * c23[3]; }
      aq[0] = __builtin_bit_cast(bf16x8, pack8(o0 * 0.125f, o1 * 0.125f)); }
#pragma unroll
    for (int ks = 1; ks < 4; ++ks) { const f32x4 v0 = *(const GAS f32x4*)(src + 16 * ks + 8 * hlf), v1 = *(const GAS f32x4*)(src + 16 * ks + 8 * hlf + 4); aq[ks] = __builtin_bit_cast(bf16x8, pack8(v0 * 0.125f, v1 * 0.125f)); }
    float wv[16];
    { const GAS f32x4* wp = (const GAS f32x4*)(IW + (size_t)(MP + b * ST + 2 * qp + hlf) * HI);
#pragma unroll
      for (int q = 0; q < 4; ++q) { const f32x4 w4 = wp[q]; wv[4 * q] = w4[0]; wv[4 * q + 1] = w4[1]; wv[4 * q + 2] = w4[2]; wv[4 * q + 3] = w4[3]; } }
    const int phys = A.page_table[b * NPAGES + pg];
    f32x4 kv[2][8];
#pragma unroll
    for (int g = 0; g < 2; ++g) { const float* kr = A.cache_idx_k + ((size_t)phys * PAGE + 64 * kh + 32 * g + r32) * DI;
#pragma unroll
        for (int ks = 0; ks < 4; ++ks) { kv[g][2 * ks] = *(const GAS f32x4*)(kr + 16 * ks + 8 * hlf); kv[g][2 * ks + 1] = *(const GAS f32x4*)(kr + 16 * ks + 8 * hlf + 4); } }
    __builtin_amdgcn_sched_barrier(0);
#pragma unroll
    for (int g = 0; g < 2; ++g) {
        const int key = 64 * kh + 32 * g + r32;
        f32x16 C;
#pragma unroll
        for (int i = 0; i < 16; ++i) C[i] = 0.f;
#pragma unroll
        for (int ks = 0; ks < 4; ++ks) { const bf16x8 kf = __builtin_bit_cast(bf16x8, pack8(kv[g][2 * ks], kv[g][2 * ks + 1])); C = __builtin_amdgcn_mfma_f32_32x32x16_bf16(aq[ks], kf, C, 0, 0, 0); }
        float sc = 0.f;
#pragma unroll
        for (int i = 0; i < 16; ++i) sc = fmaf(wv[i], fmaxf(C[i], 0.f), sc);
        SCs[(size_t)(b * ST + 2 * qp + hlf) * LDSC + pg * PAGE + key] = sc;
    }
}
__device__ __forceinline__ void s2n_unit(const Args& A, int b) {
    const int tid = threadIdx.x, lane = tid & 63, t = tid >> 6, key = lane >> 3, hp = lane & 7;
    const float* Zs = (const float*)(A.ws + WS_ZS); const float* IW = (const float*)(A.ws + WS_IW); const float2* ropeI = (const float2*)(A.ws + WS_ROPEI) + (size_t)(T + t) * 8; float* SCs = (float*)(A.ws + WS_SCS);
    const float* kr = A.out + O_IKS + (size_t)(b * ST + key) * DI;
    float part = 0.f;
#pragma unroll
    for (int hh = 0; hh < 2; ++hh) {
        const int h = 2 * hp + hh; const float* q = Zs + (size_t)(b * ST + t) * NIN + C_IQ + h * DI;
        float dot = 0.f;
        for (int d = 0; d < DI; ++d) { float qv = q[d]; if (d < 16) { const int j = d & 7; const float x1 = q[j], x2 = q[j + 8]; const float2 cs = ropeI[j]; qv = d < 8 ? x1 * cs.x - x2 * cs.y : x2 * cs.x + x1 * cs.y; } dot = fmaf(qv, kr[d], dot); }
        part += IW[(size_t)(MP + b * ST + t) * HI + h] * fmaxf(dot * 0.125f, 0.f);
    }
    part += __shfl_xor(part, 1); part += __shfl_xor(part, 2); part += __shfl_xor(part, 4);
    if (hp == 0 && key <= t) SCs[(size_t)(b * ST + t) * LDSC + PAST + key] = part;
}
__device__ __forceinline__ void s3_unit(const Args& A, LAS unsigned char* lds, int unit, float* bo_f32) {
    const int tid = threadIdx.x, v = tid & 127, dq = tid >> 7, b = unit >> 2, hd = unit & 3;
    const float* Zs = (const float*)(A.ws + WS_ZS); const float* lbv = (const float*)(A.ws + WS_LB); bf16* CATb = (bf16*)(A.ws + WS_CATB);
    LAS float* qs = (LAS float*)(lds + RING_OFF); LAS float* fs = qs + 128; LAS float* ks = fs + 128; LAS float* vs = ks + 128; LAS float* red = vs + 128; LAS float* ssq = red + 512;
    float S[32];
#pragma unroll
    for (int i = 0; i < 32; ++i) S[i] = A.state_hgrn[(((size_t)b * HB + hd) * DK + dq * 32 + i) * DV + v];
    for (int t = 0; t < ST; ++t) {
        const int r = b * ST + t; const float* z = Zs + (size_t)r * NIN;
        __syncthreads();
        if (tid < 128) { qs[tid] = silu_f(z[C_BQ + hd * DK + tid]); const float lb = lbv[hd * DK + tid]; const float f = lb + (1.f - lb) * sigmoid_f(z[C_BF + hd * DK + tid]); fs[tid] = f; ks[tid] = 1.f - f; }
        else if (tid < 256) vs[tid - 128] = z[C_BI + hd * DV + (tid - 128)];
        LDS_WAIT(); __syncthreads();
        const float vv = vs[v]; float o = 0.f;
#pragma unroll
        for (int i = 0; i < 32; ++i) { const int d = dq * 32 + i; S[i] = fs[d] * S[i] + ks[d] * vv; o = fmaf(qs[d], S[i], o); }
        red[dq * 128 + v] = o;
        LDS_WAIT(); __syncthreads();
        float oo = 0.f;
        if (tid < 128) { oo = (red[v] + red[128 + v]) + (red[256 + v] + red[384 + v]); const float sq = wave_sum(oo * oo); if ((tid & 63) == 0) ssq[tid >> 6] = sq; }
        LDS_WAIT(); __syncthreads();
        if (tid < 128) { const float rs = rsqrtf((ssq[0] + ssq[1]) * (1.f / DV) + RMS_EPS);
            if (bo_f32) bo_f32[(size_t)(MP + r) * WB + hd * DV + v] = oo;
            CATb[(size_t)(MP + r) * DM + WA + hd * DV + v] = (bf16)f2bf(oo * rs * A.norm_g[v] * silu_f(z[C_BG + hd * DV + v])); }
    }
#pragma unroll
    for (int i = 0; i < 32; ++i) A.out[O_HS + (((size_t)b * HB + hd) * DK + dq * 32 + i) * DV + v] = S[i];
    __syncthreads();
}
__device__ __forceinline__ void s4_unit(const Args& A, LAS unsigned char* lds, int unit, float* m_f32) {
    const int tid = threadIdx.x, sub = tid >> 8, t8 = tid & 255, h = t8 >> 6, l = t8 & 63, r = unit * 2 + sub, b = r >> 3;
    const float* z = (const float*)(A.ws + WS_ZS) + (size_t)r * NIN; bf16* CATb = (bf16*)(A.ws + WS_CATB);
    LAS float* q = (LAS float*)(lds + RING_OFF) + sub * 512; LAS float* p = (LAS float*)(lds + RING_OFF) + 1024 + sub * 1024 + h * 256;
    for (int i = t8; i < WM; i += 256) q[i] = z[C_MQ + i];
    LDS_WAIT(); __syncthreads();
    float mx = -INFINITY;
    for (int n = l; n < NMEM; n += 64) {
        const GAS f32x4* kr = (const GAS f32x4*)(A.cache_mem_k + ((size_t)(b * NMEM + n) * HM + h) * DH);
        float dot = 0.f;
#pragma unroll 8
        for (int d4 = 0; d4 < DH / 4; ++d4) { const f32x4 kv = kr[d4]; const LAS float* qq = q + h * DH + d4 * 4; dot = fmaf(qq[0], kv[0], dot); dot = fmaf(qq[1], kv[1], dot); dot = fmaf(qq[2], kv[2], dot); dot = fmaf(qq[3], kv[3], dot); }
        dot *= SM_SCALE; p[n] = dot; mx = fmaxf(mx, dot);
    }
#pragma unroll
    for (int o = 32; o >= 1; o >>= 1) mx = fmaxf(mx, __shfl_xor(mx, o));
    float sum = 0.f;
    for (int n = l; n < NMEM; n += 64) { const float e = expf(p[n] - mx); p[n] = e; sum += e; }
    sum = wave_sum(sum);
    LDS_WAIT(); __syncthreads();
    float a0 = 0.f, a1 = 0.f;
    for (int n = 0; n < NMEM; ++n) { const float* vr = A.cache_mem_v + ((size_t)(b * NMEM + n) * HM + h) * DH + l * 2; const float pn = p[n]; a0 = fmaf(pn, vr[0], a0); a1 = fmaf(pn, vr[1], a1); }
    const float inv = 1.f / sum; a0 *= inv; a1 *= inv;
    if (m_f32) { m_f32[(size_t)(MP + r) * WM + h * DH + l * 2] = a0; m_f32[(size_t)(MP + r) * WM + h * DH + l * 2 + 1] = a1; }
    *(GAS unsigned*)(CATb + (size_t)(MP + r) * DM + WA + WB + h * DH + l * 2) = pk2(a0 * silu_f(z[C_MG + h * DH + l * 2]), a1 * silu_f(z[C_MG + h * DH + l * 2 + 1]));
    __syncthreads();
}
__device__ __forceinline__ void s5_unit(const Args& A, LAS unsigned char* lds, int r) {
    const int tid = threadIdx.x, lane = tid & 63, wave = tid >> 6, n = PAST + (r & (ST - 1)) + 1;
    const float* sc = (const float*)(A.ws + WS_SCS) + (size_t)r * LDSC; int* sel = (int*)(A.ws + WS_SELS) + (size_t)r * TOPK;
    LAS float* red = (LAS float*)(lds + RING_OFF);
    LAS int* cnts = (LAS int*)(lds + RING_OFF + 64);
    LAS int* ctr = (LAS int*)(lds + RING_OFF + 128);
    LAS float* cand = (LAS float*)(lds + RING_OFF + 256);
    constexpr int NV = (NKEYS_S + 511) / 512;
    float x[NV];
#pragma unroll
    for (int i = 0; i < NV; ++i) { const int s = i * 512 + tid; x[i] = s < n ? sc[s] : -INFINITY; }
    float mn = INFINITY, mx = -INFINITY;
#pragma unroll
    for (int i = 0; i < NV; ++i) { const int s = i * 512 + tid; mn = fminf(mn, s < n ? x[i] : INFINITY); mx = fmaxf(mx, x[i]); }
#pragma unroll
    for (int o = 1; o < 64; o <<= 1) { mn = fminf(mn, __shfl_xor(mn, o)); mx = fmaxf(mx, __shfl_xor(mx, o)); }
    if (lane == 0) { red[wave] = mn; red[8 + wave] = mx; }
    if (tid < 4) ctr[tid] = 0;
    LDS_WAIT(); __syncthreads();
    mn = red[0]; mx = red[8];
#pragma unroll
    for (int w = 1; w < 8; ++w) { mn = fminf(mn, red[w]); mx = fmaxf(mx, red[8 + w]); }
    float lo = mn, hi = INFINITY; int c_lo = n, c_hi = 0;
    for (int it = 0; it < 96 && c_lo - c_hi > 512; ++it) {
        const float hf = (hi == INFINITY) ? mx : hi;
        const float mid = lo + 0.5f * (hf - lo);
        if (!(mid > lo) || (hi != INFINITY && !(mid < hi))) break;
        int c = 0;
#pragma unroll
        for (int i = 0; i < NV; ++i) c += __popcll(__ballot(x[i] >= mid));
        __syncthreads();
        if (lane == 0) cnts[wave] = c;
        LDS_WAIT(); __syncthreads();
        c = 0;
#pragma unroll
        for (int w = 0; w < 8; ++w) c += cnts[w];
        if (c >= TOPK) { lo = mid; c_lo = c; } else { hi = mid; c_hi = c; }
    }
    const int m = c_lo - c_hi, rr = TOPK - c_hi;
#pragma unroll
    for (int i = 0; i < NV; ++i) { if (x[i] >= lo && x[i] < hi) { const int pos = __hip_atomic_fetch_add(ctr, 1, __ATOMIC_RELAXED, __HIP_MEMORY_SCOPE_WORKGROUP); if (pos < 1024) { cand[2 * pos] = x[i]; cand[2 * pos + 1] = __int_as_float(i * 512 + tid); } } }
    LDS_WAIT(); __syncthreads();
    float thr_v = lo; int thr_s = 0x7fffffff;
    if (m <= 1024) {
        LAS float* res = red;
        for (int c0 = 0; c0 < m; c0 += 512) {
            const int cme = c0 + tid; const bool have = cme < m;
            const float v = have ? cand[2 * cme] : 0.f; const int sidx = have ? __float_as_int(cand[2 * cme + 1]) : 0;
            int rank = 0;
            for (int j = 0; j < m; ++j) { const float ov = cand[2 * j]; const int os = __float_as_int(cand[2 * j + 1]); rank += (ov > v || (ov == v && os < sidx)) ? 1 : 0; }
            if (have && rank == rr - 1) { res[0] = v; res[1] = __int_as_float(sidx); }
        }
        LDS_WAIT(); __syncthreads();
        thr_v = red[0]; thr_s = __float_as_int(red[1]);
    }
    int tot = 0;
#pragma unroll
    for (int i = 0; i < NV; ++i) { const int s = i * 512 + tid; tot += __popcll(__ballot(x[i] > thr_v || (x[i] == thr_v && s <= thr_s))); }
    __syncthreads();
    if (lane == 0) cnts[wave] = tot;
    LDS_WAIT(); __syncthreads();
    int run = 0;
#pragma unroll
    for (int w = 0; w < 8; ++w) run += (w < wave) ? cnts[w] : 0;
#pragma unroll
    for (int i = 0; i < NV; ++i) { const int s = i * 512 + tid; const bool on = x[i] > thr_v || (x[i] == thr_v && s <= thr_s); const unsigned long long bal = __ballot(on);
        if (on) { const int pos = run + __popcll(bal & ((1ull << lane) - 1ull)); if (pos < TOPK) sel[pos] = s; }
        run += __popcll(bal); }
    __syncthreads();
}
__device__ __forceinline__ void s6_unit(const Args& A, LAS unsigned char* lds, int unit, float* a_f32) {
    const int tid = threadIdx.x, r = unit >> 3, h = unit & 7, b = r >> 3, t = r & 7;
    const float* z = (const float*)(A.ws + WS_ZS) + (size_t)r * NIN; const int* sel = (const int*)(A.ws + WS_SELS) + (size_t)r * TOPK; bf16* CATb = (bf16*)(A.ws + WS_CATB);
    const float2* ropeA = (const float2*)(A.ws + WS_ROPEA) + (size_t)(T + t) * 16;
    LAS float* q = (LAS float*)(lds + RING_OFF); LAS float* p = q + 128; LAS float* red = p + 256; LAS float* part = red + 32;
    LAS int* sl = (LAS int*)(part + 2048);
    if (tid < 128) { const int d = tid; float qv = z[C_AQ + h * DH + d];
        if (d < 32) { const int j = d & 15; const bool lo = d < 16; const float x1 = z[C_AQ + h * DH + j], x2 = z[C_AQ + h * DH + j + 16]; const float2 cs = ropeA[j]; qv = lo ? x1 * cs.x - x2 * cs.y : x2 * cs.x + x1 * cs.y; }
        q[d] = qv * SM_SCALE; }
    if (tid < 256) sl[tid] = sel[tid];
    LDS_WAIT(); __syncthreads();
    { const int kidx = tid >> 1, half = tid & 1, s = sl[kidx];
      const float* kr = s >= PAST ? A.out + O_KS + (size_t)(b * ST + (s - PAST)) * WA + h * DH : A.cache_k + ((size_t)A.page_table[b * NPAGES + (s >> 7)] * PAGE + (s & 127)) * WA + h * DH;
      const GAS f32x4* k4 = (const GAS f32x4*)(kr + 64 * half); float dot = 0.f;
#pragma unroll
      for (int d4 = 0; d4 < 16; ++d4) { const f32x4 kv = k4[d4]; const LAS float* qq = q + 64 * half + 4 * d4; dot = fmaf(qq[0], kv[0], dot); dot = fmaf(qq[1], kv[1], dot); dot = fmaf(qq[2], kv[2], dot); dot = fmaf(qq[3], kv[3], dot); }
      dot += __shfl_xor(dot, 1);
      if (half == 0) p[kidx] = dot; }
    LDS_WAIT(); __syncthreads();
    float mx = -INFINITY;
    if (tid < 256) mx = p[tid];
#pragma unroll
    for (int o = 1; o < 64; o <<= 1) mx = fmaxf(mx, __shfl_xor(mx, o));
    if ((tid & 63) == 0) red[tid >> 6] = mx;
    LDS_WAIT(); __syncthreads();
    mx = fmaxf(fmaxf(red[0], red[1]), fmaxf(red[2], red[3]));
    float e = 0.f;
    if (tid < 256) { e = expf(p[tid] - mx); }
    const float esum = wave_sum(e);
    __syncthreads();
    if (tid < 256) p[tid] = e;
    if ((tid & 63) == 0) red[8 + (tid >> 6)] = esum;
    LDS_WAIT(); __syncthreads();
    const float inv = 1.f / ((red[8] + red[9]) + (red[10] + red[11]));
    { const int d4 = tid & 31, kp = tid >> 5; f32x4 acc = (f32x4){0.f, 0.f, 0.f, 0.f};
#pragma unroll 4
      for (int i = 0; i < 16; ++i) { const int kidx = kp * 16 + i, s = sl[kidx];
          const float* vr = s >= PAST ? A.out + O_VS + (size_t)(b * ST + (s - PAST)) * WA + h * DH : A.cache_v + ((size_t)A.page_table[b * NPAGES + (s >> 7)] * PAGE + (s & 127)) * WA + h * DH;
          const f32x4 vv = *((const GAS f32x4*)vr + d4); acc = acc + vv * p[kidx]; }
      *(LAS f32x4*)(part + kp * 128 + 4 * d4) = acc; }
    LDS_WAIT(); __syncthreads();
    if (tid < 128) { float o = 0.f;
#pragma unroll
        for (int kp = 0; kp < 16; ++kp) o += part[kp * 128 + tid];
        o *= inv;
        if (a_f32) a_f32[(size_t)(MP + r) * WA + h * DH + tid] = o;
        CATb[(size_t)(MP + r) * DM + h * DH + tid] = (bf16)f2bf(o * silu_f(z[C_AG + h * DH + tid])); }
    __syncthreads();
}

__global__ void __launch_bounds__(NWAVES * 64, 2) mega_fwd(Args args) {
    extern __shared__ __attribute__((aligned(16))) unsigned char lds_raw[];
    LAS unsigned char* lds = (LAS unsigned char*)lds_raw;
    volatile LAS unsigned* MISC = (volatile LAS unsigned*)(lds + MISC_OFF);
    const int tid = threadIdx.x, G = gridDim.x;
    unsigned char* ws = args.ws;
    gu32* ctl = (gu32*)(ws + WS_CTL);
    for (int u = tid; u < (LDS_BYTES - LDSCTL_OFF) / 4; u += NWAVES * 64) ((LAS unsigned*)(lds + LDSCTL_OFF))[u] = 0u;
    __syncthreads();
    XcdBarrier bar = xcd_barrier_post((unsigned*)(ctl + CW_BAR) + args.li * XCD_BAR_WORDS, MISC + 8);
    const int lo = args.ph_lo, hi = args.ph_hi;
#if PROBE == 2
    unsigned long long* stamps = (unsigned long long*)(ws + WS_CTL + 800000);
#define STAMP(k) do { if (blockIdx.x == 0 && tid == 0) stamps[k] = __builtin_amdgcn_s_memrealtime(); } while (0)
#define SUB(k) do { if (blockIdx.x == PROBE_BLK && tid == 0) stamps[16 + (k)] = __builtin_amdgcn_s_memrealtime(); } while (0)
#else
#define STAMP(k) do { } while (0)
#define SUB(k) do { } while (0)
#endif
    STAMP(0);
#define IN(k) (lo <= (k) && (k) < hi)
#define BOTH(k) (IN(k) && IN((k) + 1))
    if (IN(0)) { p0_prologue(args, lds, G); if (BOTH(0)) xcd_barrier(bar); }
    STAMP(1);
    if (IN(1)) {
        pg8::Gemm g{(const pg8::bf16_t*)(ws + WS_XB), (const pg8::bf16_t*)(ws + WS_WMAIN), MP, NMAIN, DM};
        pg8::StaticOrder S; S.init(MP, NMAIN, G, (int)blockIdx.x);
        EpiIn E{args.out, (float*)(ws + WS_Z), (bf16*)(ws + WS_QB), (bf16*)(ws + WS_KB), (bf16*)(ws + WS_VB), (bf16*)(ws + WS_GA), (bf16*)(ws + WS_IQB), (bf16*)(ws + WS_HV), (bf16*)(ws + WS_GB),
                (bf16*)(ws + WS_MQB), (bf16*)(ws + WS_GM), (float*)(ws + WS_HQ), (float*)(ws + WS_HG), (const float2*)(ws + WS_ROPEA), (const float2*)(ws + WS_ROPEI), (const float*)(ws + WS_LB)};
        pg8::gemm_phase<EpiIn, pg8::StaticOrder, true, true>(lds + RING_OFF, g, S, E);
        p1_small(args, G);
        if (BOTH(1)) xcd_barrier(bar);
    }
    STAMP(2);
    if (IN(2)) {
        SUB(0);
        for (int u = blockIdx.x; u < 256; u += G) p2_indexer(args, lds, u);
        SUB(1);
        for (int u = blockIdx.x; u < NHU; u += G) hgrn1_unit(args, lds, u);
        SUB(2);
        for (int u = (int)blockIdx.x - 128; u < 128; u += G) if (u >= 0) p2_memattn(args, lds, u, args.dbg_mout);
        SUB(3);
        if (G == 256) { const int bid = blockIdx.x; const int u0 = bid < 128 ? bid * 5 : 640 + (bid - 128) * 3, nu = bid < 128 ? 5 : 3;
            for (int u = u0; u < u0 + nu; ++u) s2_unit(args, u); }
        else for (int u = blockIdx.x; u < SB * NPAGES; u += G) s2_unit(args, u);
        SUB(4);
        for (int u = blockIdx.x; u < SB; u += G) s2n_unit(args, u);
        for (int u = (int)blockIdx.x - 8; u < MS; u += G) if (u >= 0) s1_unit(args, u);
        for (int u = (int)blockIdx.x - 64; u < SB * HB; u += G) if (u >= 0) s3_unit(args, lds, u, args.dbg_bo);
        for (int u = (int)blockIdx.x - 96; u < MS / 2; u += G) if (u >= 0) s4_unit(args, lds, u, args.dbg_mout);
        SUB(5);
        if (BOTH(2)) xcd_barrier(bar);
        SUB(6);
    }
    STAMP(3);
    if (IN(3)) {
        for (int u = blockIdx.x; u < 256; u += G) p3_dsa_attn(args, lds, u, args.dbg_aout);
        SUB(7);
        hgrn2_scan(args, G);
        SUB(8);
        if (G == 256) { const int bid = blockIdx.x; if ((bid & 7) >= 6) s5_unit(args, lds, (bid >> 3) * 2 + ((bid & 7) - 6)); }
        else for (int u = blockIdx.x; u < MS; u += G) s5_unit(args, lds, u);
        SUB(9);
        if (BOTH(3)) xcd_barrier(bar);
        SUB(10);
    }
    STAMP(4);
    if (IN(4)) {
        for (int u = blockIdx.x; u < NHU; u += G) hgrn3_unit(args, lds, u, args.dbg_bo);
        SUB(11);
        for (int u = blockIdx.x; u < MS * HA; u += G) s6_unit(args, lds, u, args.dbg_aout);
        SUB(12);
        if (BOTH(4)) xcd_barrier(bar);
        SUB(13);
    }
    STAMP(5);
    if (IN(5)) {
        pg8::Gemm g{(const pg8::bf16_t*)(ws + WS_CATB), (const pg8::bf16_t*)(ws + WS_WOUT), MP, DM, DM};
        pg8::StaticOrder S; S.init(MP, DM, G, (int)blockIdx.x);
        EpiOut E{args.out + O_YP};
        pg8::gemm_phase<EpiOut, pg8::StaticOrder, true, true>(lds + RING_OFF, g, S, E);
        p5_small(args, lds, G);
        if (BOTH(5)) xcd_barrier(bar);
    }
    STAMP(6);
    if (IN(6)) { p6_layernorm(args, G); }
#if PROBE == 2
    if (blockIdx.x == 0 && tid == 0) {
        const unsigned long long tend = __builtin_amdgcn_s_memrealtime();
#if PROBE_SUB
        (void)tend;
        const float dA = (float)(stamps[16 + PROBE_A + 1] - stamps[16 + PROBE_A]) * 0.1f, dB = (float)(stamps[16 + PROBE_B + 1] - stamps[16 + PROBE_B]) * 0.1f;
#else
        const float dA = (float)((PROBE_A == 6 ? tend : stamps[PROBE_A + 1]) - stamps[PROBE_A]) * 0.01f, dB = (float)((PROBE_B == 6 ? tend : stamps[PROBE_B + 1]) - stamps[PROBE_B]) * 0.01f;
#endif
        asm volatile("s_waitcnt vmcnt(0)" ::: "memory");
        args.out[O_YP] += dA * 0.001f;
        for (int i = 0; i < MS * DI; ++i) args.out[O_IKS + i] *= (1.f + dB * (1.f / 3000.f));
    }
#endif
#undef IN
#undef BOTH
}

#if HYBRID
__global__ void __launch_bounds__(256) gemm_nn(const float* __restrict__ A, const float* __restrict__ B, float* __restrict__ C, int M, int N, int K, int lda, int ldb, int ldc) {
    __shared__ float As[16][64 + 4];
    __shared__ float Bs[16][64 + 4];
    const int tid = threadIdx.x, tx = tid & 15, ty = tid >> 4;
    const int m0 = blockIdx.y * 64, n0 = blockIdx.x * 64;
    float acc[4][4] = {};
    for (int k0 = 0; k0 < K; k0 += 16) {
        for (int i = tid; i < 64 * 16; i += 256) { const int r = i >> 4, c = i & 15; As[c][r] = A[(size_t)(m0 + r) * lda + k0 + c]; }
        for (int i = tid; i < 16 * 64; i += 256) { const int r = i >> 6, c = i & 63; Bs[r][c] = (n0 + c < N) ? B[(size_t)(k0 + r) * ldb + n0 + c] : 0.f; }
        __syncthreads();
#pragma unroll
        for (int kk = 0; kk < 16; ++kk) {
            float a[4], b[4];
#pragma unroll
            for (int i = 0; i < 4; ++i) { a[i] = As[kk][ty * 4 + i]; b[i] = Bs[kk][tx * 4 + i]; }
#pragma unroll
            for (int i = 0; i < 4; ++i)
#pragma unroll
                for (int j = 0; j < 4; ++j) acc[i][j] = fmaf(a[i], b[j], acc[i][j]);
        }
        __syncthreads();
    }
#pragma unroll
    for (int i = 0; i < 4; ++i)
#pragma unroll
        for (int j = 0; j < 4; ++j) { const int n = n0 + tx * 4 + j; if (n < N) C[(size_t)(m0 + ty * 4 + i) * ldc + n] = acc[i][j]; }
}
__device__ __forceinline__ int row_pos(int row) { return row < MP ? (row % T) : (PAST + ((row - MP) % ST)); }
__device__ __forceinline__ void rope_pair(float x1, float x2, int pos, int j, int half, float& o1, float& o2) {
    float c, s; rope_cs(pos, j, half, c, s);
    o1 = x1 * c - x2 * s; o2 = x2 * c + x1 * s;
}
__global__ void __launch_bounds__(256) post_rows(const float* __restrict__ Z, float* __restrict__ Qr, float* __restrict__ IQr, float* __restrict__ out, int write_prompt_out, int write_sample_idx) {
    const int row = blockIdx.x, pos = row_pos(row);
    const float* z = Z + (size_t)row * NIN;
    float* kout = row < MP ? out + O_KP + (size_t)row * WA : out + O_KS + (size_t)(row - MP) * WA;
    float* vout = row < MP ? out + O_VP + (size_t)row * WA : out + O_VS + (size_t)(row - MP) * WA;
    float* ikout = row < MP ? out + O_IKP + (size_t)row * DI : out + O_IKS + (size_t)(row - MP) * DI;
    const bool wkv = row < MP ? write_prompt_out != 0 : true;
    const bool wik = row < MP ? write_prompt_out != 0 : write_sample_idx != 0;
    for (int c = threadIdx.x; c < WA; c += 256) {
        const int d = c & 127;
        float q = z[C_AQ + c], k = z[C_AK + c];
        if (d < 32) {
            const int j = d & 15; const bool lo = d < 16; const int c1 = lo ? c : c - 16, c2 = c1 + 16;
            float o1, o2; rope_pair(z[C_AQ + c1], z[C_AQ + c2], pos, j, 16, o1, o2); q = lo ? o1 : o2;
            rope_pair(z[C_AK + c1], z[C_AK + c2], pos, j, 16, o1, o2); k = lo ? o1 : o2;
        }
        Qr[(size_t)row * WA + c] = q; if (wkv) { kout[c] = k; vout[c] = z[C_AV + c]; }
        const int di = c & 63;
        float iq = z[C_IQ + c];
        if (di < 16) { const int j = di & 7; const bool lo = di < 8; const int c1 = lo ? c : c - 8, c2 = c1 + 8; float o1, o2; rope_pair(z[C_IQ + c1], z[C_IQ + c2], pos, j, 8, o1, o2); iq = lo ? o1 : o2; }
        IQr[(size_t)row * WA + c] = iq;
    }
    if (wik) for (int c = threadIdx.x; c < DI; c += 256) {
        float ik = z[C_IK + c];
        if (c < 16) { const int j = c & 7; const bool lo = c < 8; const int c1 = lo ? c : c - 8, c2 = c1 + 8; float o1, o2; rope_pair(z[C_IK + c1], z[C_IK + c2], pos, j, 8, o1, o2); ik = lo ? o1 : o2; }
        ikout[c] = ik;
    }
}
__device__ __forceinline__ const float* idx_key_row(int row, int s, const float* out, const float* cache_idx_k, const int* page_table) {
    if (row < MP) { const int b = row / T; return out + O_IKP + (size_t)(b * T + s) * DI; }
    const int b = (row - MP) / ST;
    if (s >= PAST) return out + O_IKS + (size_t)(b * ST + (s - PAST)) * DI;
    const int pg = page_table[b * NPAGES + s / PAGE];
    return cache_idx_k + ((size_t)pg * PAGE + (s % PAGE)) * DI;
}
__global__ void __launch_bounds__(256) idx_scores(const float* __restrict__ Z, const float* __restrict__ IQr, const float* out, const float* __restrict__ cache_idx_k, const int* __restrict__ page_table,
                                                   float* __restrict__ SC, int row0, int ldsc) {
    __shared__ float q[HI * DI];
    __shared__ float w[HI];
    const int row = row0 + blockIdx.y;
    const int nk = row < MP ? (row % T) + 1 : PAST + ((row - MP) % ST) + 1;
    for (int i = threadIdx.x; i < HI * DI; i += 256) q[i] = IQr[(size_t)row * WA + i];
    if (threadIdx.x < HI) w[threadIdx.x] = Z[(size_t)row * NIN + C_IW + threadIdx.x] * 0.25f;
    __syncthreads();
    const int s = blockIdx.x * 256 + threadIdx.x;
    if (s >= nk) return;
    const float4* kr = (const float4*)idx_key_row(row, s, out, cache_idx_k, page_table);
    float acc = 0.f;
    for (int h = 0; h < HI; ++h) {
        float dot = 0.f;
#pragma unroll
        for (int d4 = 0; d4 < DI / 4; ++d4) { const float4 kv = kr[d4]; const float* qq = q + h * DI + d4 * 4;
            dot = fmaf(qq[0], kv.x, dot); dot = fmaf(qq[1], kv.y, dot); dot = fmaf(qq[2], kv.z, dot); dot = fmaf(qq[3], kv.w, dot); }
        dot *= 0.125f;
        acc += w[h] * fmaxf(dot, 0.f);
    }
    SC[(size_t)blockIdx.y * ldsc + s] = acc;
}
__global__ void __launch_bounds__(256) idx_select(const float* __restrict__ SC, int* __restrict__ sel, int row0, int ldsc) {
    __shared__ float tile[1024];
    const int row = row0 + blockIdx.y;
    const int nk = row < MP ? (row % T) + 1 : PAST + ((row - MP) % ST) + 1;
    const float* sc = SC + (size_t)blockIdx.y * ldsc;
    const int s = blockIdx.x * 256 + threadIdx.x;
    if (blockIdx.x * 256 >= nk) return;
    const float mine = s < nk ? sc[s] : 0.f;
    int rank = 0;
    for (int t0 = 0; t0 < nk; t0 += 1024) {
        __syncthreads();
        for (int i = threadIdx.x; i < 1024; i += 256) tile[i] = (t0 + i < nk) ? sc[t0 + i] : -INFINITY;
        __syncthreads();
        const int lim = min(1024, nk - t0);
        for (int i = 0; i < lim; ++i) { const float o = tile[i]; rank += (o > mine || (o == mine && (t0 + i) < s)) ? 1 : 0; }
    }
    if (s < nk && rank < TOPK) sel[(size_t)row * TOPK + rank] = s;
}
__device__ __forceinline__ const float* kv_row(int row, int s, int h, bool isv, const float* out, const float* cache_k, const float* cache_v, const int* page_table) {
    if (row < MP) { const int b = row / T; return out + (isv ? O_VP : O_KP) + (size_t)(b * T + s) * WA + h * DH; }
    const int b = (row - MP) / ST;
    if (s >= PAST) return out + (isv ? O_VS : O_KS) + (size_t)(b * ST + (s - PAST)) * WA + h * DH;
    const int pg = page_table[b * NPAGES + s / PAGE];
    return (isv ? cache_v : cache_k) + ((size_t)pg * PAGE + (s % PAGE)) * WA + h * DH;
}
__global__ void __launch_bounds__(256) sparse_attn(const float* __restrict__ Qr, const int* __restrict__ sel, const float* out, const float* __restrict__ cache_k, const float* __restrict__ cache_v,
                                                    const int* __restrict__ page_table, float* __restrict__ a_out, int row0) {
    __shared__ float q[WA];
    __shared__ float p[HA][TOPK];
    __shared__ int sl[TOPK];
    const int row = row0 + blockIdx.x, tid = threadIdx.x, h = tid >> 5, l = tid & 31;
    const int nk = row < MP ? (row % T) + 1 : PAST + ((row - MP) % ST) + 1;
    const int ns = nk < TOPK ? nk : TOPK;
    for (int i = tid; i < WA; i += 256) q[i] = Qr[(size_t)row * WA + i];
    for (int i = tid; i < ns; i += 256) sl[i] = sel[(size_t)row * TOPK + i];
    __syncthreads();
    float mx = -INFINITY;
    for (int j = l; j < ns; j += 32) {
        const float4* kr = (const float4*)kv_row(row, sl[j], h, false, out, cache_k, cache_v, page_table);
        float dot = 0.f;
        for (int d4 = 0; d4 < DH / 4; ++d4) { const float4 kv = kr[d4]; const float* qq = q + h * DH + d4 * 4;
            dot = fmaf(qq[0], kv.x, dot); dot = fmaf(qq[1], kv.y, dot); dot = fmaf(qq[2], kv.z, dot); dot = fmaf(qq[3], kv.w, dot); }
        dot *= SM_SCALE;
        p[h][j] = dot; mx = fmaxf(mx, dot);
    }
    for (int o = 16; o >= 1; o >>= 1) mx = fmaxf(mx, __shfl_xor(mx, o));
    float sum = 0.f;
    for (int j = l; j < ns; j += 32) { const float e = expf(p[h][j] - mx); p[h][j] = e; sum += e; }
    for (int o = 16; o >= 1; o >>= 1) sum += __shfl_xor(sum, o);
    __syncthreads();
    float4 acc = make_float4(0.f, 0.f, 0.f, 0.f);
    for (int j = 0; j < ns; ++j) {
        const float4 vr = *((const float4*)kv_row(row, sl[j], h, true, out, cache_k, cache_v, page_table) + l);
        const float pj = p[h][j];
        acc.x = fmaf(pj, vr.x, acc.x); acc.y = fmaf(pj, vr.y, acc.y); acc.z = fmaf(pj, vr.z, acc.z); acc.w = fmaf(pj, vr.w, acc.w);
    }
    const float inv = 1.f / sum;
    *((float4*)(a_out + (size_t)row * WA + h * DH) + l) = make_float4(acc.x * inv, acc.y * inv, acc.z * inv, acc.w * inv);
}
__global__ void __launch_bounds__(256) hgrn_seq(const float* __restrict__ Z, const float* __restrict__ lb_logits, const float* __restrict__ s0, float* __restrict__ s_out, float* __restrict__ b_o,
                                                int row_base, int nt) {
    __shared__ float qs[DK], fs[DK], ks[DK], vs[64], red[4][64];
    const int b = blockIdx.x / (HB * 2), hd = (blockIdx.x / 2) % HB, vh = blockIdx.x & 1;
    const int tid = threadIdx.x, vl = tid & 63, dp = tid >> 6, v = vh * 64 + vl;
    float S[32];
#pragma unroll
    for (int i = 0; i < 32; ++i) S[i] = s0 ? s0[(((size_t)b * HB + hd) * DK + dp * 32 + i) * DV + v] : 0.f;
    float lbv = 0.f;
    if (tid < DK) { const float l0 = lb_logits[hd * DK + tid], l1 = lb_logits[HB * DK + hd * DK + tid]; const float m = fmaxf(l0, l1); const float e0 = expf(l0 - m), e1 = expf(l1 - m); lbv = e0 / (e0 + e1); }
    for (int t = 0; t < nt; ++t) {
        const float* z = Z + (size_t)(row_base + b * nt + t) * NIN;
        __syncthreads();
        if (tid < DK) { qs[tid] = silu_f(z[C_BQ + hd * DK + tid]); const float f = lbv + (1.f - lbv) * sigmoid_f(z[C_BF + hd * DK + tid]); fs[tid] = f; ks[tid] = 1.f - f; }
        else if (tid < DK + 64) vs[tid - DK] = z[C_BI + hd * DV + vh * 64 + (tid - DK)];
        __syncthreads();
        const float vv = vs[vl]; float o = 0.f;
#pragma unroll
        for (int i = 0; i < 32; ++i) { const int d = dp * 32 + i; S[i] = fs[d] * S[i] + ks[d] * vv; o = fmaf(qs[d], S[i], o); }
        red[dp][vl] = o;
        __syncthreads();
        if (dp == 0) b_o[(size_t)(row_base + b * nt + t) * WB + hd * DV + v] = (red[0][vl] + red[1][vl]) + (red[2][vl] + red[3][vl]);
    }
#pragma unroll
    for (int i = 0; i < 32; ++i) s_out[(((size_t)b * HB + hd) * DK + dp * 32 + i) * DV + v] = S[i];
}
__global__ void __launch_bounds__(256) mem_attn(const float* __restrict__ Z, const float* __restrict__ mk, const float* __restrict__ mv, float* __restrict__ m_out, int row0, int rows_per_batch) {
    __shared__ float q[WM];
    __shared__ float p[HM][NMEM];
    const int row = row0 + blockIdx.x, b = blockIdx.x / rows_per_batch, tid = threadIdx.x, h = tid >> 6, l = tid & 63;
    for (int i = tid; i < WM; i += 256) q[i] = Z[(size_t)row * NIN + C_MQ + i];
    __syncthreads();
    float mx = -INFINITY;
    for (int n = l; n < NMEM; n += 64) {
        const float4* kr = (const float4*)(mk + ((size_t)(b * NMEM + n) * HM + h) * DH);
        float dot = 0.f;
        for (int d4 = 0; d4 < DH / 4; ++d4) { const float4 kv = kr[d4]; const float* qq = q + h * DH + d4 * 4;
            dot = fmaf(qq[0], kv.x, dot); dot = fmaf(qq[1], kv.y, dot); dot = fmaf(qq[2], kv.z, dot); dot = fmaf(qq[3], kv.w, dot); }
        dot *= SM_SCALE; p[h][n] = dot; mx = fmaxf(mx, dot);
    }
    for (int o = 32; o >= 1; o >>= 1) mx = fmaxf(mx, __shfl_xor(mx, o));
    float sum = 0.f;
    for (int n = l; n < NMEM; n += 64) { const float e = expf(p[h][n] - mx); p[h][n] = e; sum += e; }
    for (int o = 32; o >= 1; o >>= 1) sum += __shfl_xor(sum, o);
    __syncthreads();
    float a0 = 0.f, a1 = 0.f;
    for (int n = 0; n < NMEM; ++n) { const float* vr = mv + ((size_t)(b * NMEM + n) * HM + h) * DH + l * 2; const float pn = p[h][n]; a0 = fmaf(pn, vr[0], a0); a1 = fmaf(pn, vr[1], a1); }
    const float inv = 1.f / sum;
    m_out[(size_t)row * WM + h * DH + l * 2] = a0 * inv; m_out[(size_t)row * WM + h * DH + l * 2 + 1] = a1 * inv;
}
__global__ void __launch_bounds__(256) merge_rows(const float* __restrict__ Z, const float* __restrict__ a_out, const float* __restrict__ b_o, const float* __restrict__ m_out, const float* __restrict__ norm_g,
                                                   float* __restrict__ cat, unsigned short* __restrict__ catb) {
    __shared__ float ssq[HB];
    const int row = blockIdx.x, tid = threadIdx.x;
    const float* z = Z + (size_t)row * NIN;
    { const int h = tid >> 6, l = tid & 63; const float x0 = b_o[(size_t)row * WB + h * DV + l], x1 = b_o[(size_t)row * WB + h * DV + 64 + l]; float s = x0 * x0 + x1 * x1;
      for (int o = 32; o >= 1; o >>= 1) s += __shfl_xor(s, o);
      if (l == 0) ssq[h] = s; }
    __syncthreads();
    for (int c = tid; c < WA; c += 256) cat[(size_t)row * DM + c] = a_out[(size_t)row * WA + c] * silu_f(z[C_AG + c]);
    for (int c = tid; c < WB; c += 256) { const int h = c >> 7; const float r = rsqrtf(ssq[h] * (1.f / DV) + RMS_EPS);
        cat[(size_t)row * DM + WA + c] = b_o[(size_t)row * WB + c] * r * norm_g[c & 127] * silu_f(z[C_BG + c]); }
    for (int c = tid; c < WM; c += 256) cat[(size_t)row * DM + WA + WB + c] = m_out[(size_t)row * WM + c] * silu_f(z[C_MG + c]);
    __syncthreads();
    for (int c = tid; c < DM; c += 256) catb[(size_t)row * DM + c] = (unsigned short)f2bf(cat[(size_t)row * DM + c]);
}
__global__ void __launch_bounds__(256) ln_rows(const float* __restrict__ xp, const float* __restrict__ xs, const float* __restrict__ Y, const float* __restrict__ g, const float* __restrict__ bta, float* __restrict__ out) {
    __shared__ float red[8];
    const int row = blockIdx.x, tid = threadIdx.x;
    const float* x = row < MP ? xp + (size_t)row * DM : xs + (size_t)(row - MP) * DM;
    float* o = row < MP ? out + O_YP + (size_t)row * DM : out + O_YS + (size_t)(row - MP) * DM;
    float v[8]; float s = 0.f;
#pragma unroll
    for (int i = 0; i < 8; ++i) { const int c = tid + 256 * i; v[i] = ALPHA * x[c] + Y[(size_t)row * DM + c]; s += v[i]; }
    for (int of = 32; of >= 1; of >>= 1) s += __shfl_xor(s, of);
    if ((tid & 63) == 0) red[tid >> 6] = s;
    __syncthreads();
    const float mean = (red[0] + red[1] + red[2] + red[3]) * (1.f / DM);
    float q = 0.f;
#pragma unroll
    for (int i = 0; i < 8; ++i) { v[i] -= mean; q += v[i] * v[i]; }
    for (int of = 32; of >= 1; of >>= 1) q += __shfl_xor(q, of);
    if ((tid & 63) == 0) red[4 + (tid >> 6)] = q;
    __syncthreads();
    const float rstd = rsqrtf((red[4] + red[5] + red[6] + red[7]) * (1.f / DM) + LN_EPS);
#pragma unroll
    for (int i = 0; i < 8; ++i) { const int c = tid + 256 * i; o[c] = v[i] * rstd * g[c] + bta[c]; }
}

#endif
#if PROBE
__global__ void __launch_bounds__(64) sel_to_mask(const int* __restrict__ sel, unsigned* __restrict__ mask) {
    __shared__ unsigned w[64];
    const int row = blockIdx.x, t = row % T, ns = (t + 1) < TOPK ? (t + 1) : TOPK;
    w[threadIdx.x] = 0u; __syncthreads();
    for (int i = threadIdx.x; i < ns; i += 64) { const int s = sel[(size_t)row * TOPK + i]; atomicOr(&w[s >> 5], 1u << (s & 31)); }
    __syncthreads();
    mask[(size_t)row * 64 + threadIdx.x] = w[threadIdx.x];
}
__global__ void __launch_bounds__(256) cmp_masks(const unsigned* __restrict__ a, const unsigned* __restrict__ b, float* acc) {
    float c = 0.f;
    for (size_t i = (size_t)blockIdx.x * 256 + threadIdx.x; i < (size_t)MP * 64; i += (size_t)gridDim.x * 256) c += (float)__popc(a[i] ^ b[i]);
    for (int o = 32; o >= 1; o >>= 1) c += __shfl_xor(c, o);
    if ((threadIdx.x & 63) == 0) atomicAdd(acc + 2, c);
}
__global__ void __launch_bounds__(256) cmp_vals(const float* __restrict__ a, const float* __restrict__ ref, size_t n, float* acc) {
    float d = 0.f, r = 0.f;
    for (size_t i = (size_t)blockIdx.x * 256 + threadIdx.x; i < n; i += (size_t)gridDim.x * 256) { const float x = a[i] - ref[i]; d += x * x; r += ref[i] * ref[i]; }
    for (int o = 32; o >= 1; o >>= 1) { d += __shfl_xor(d, o); r += __shfl_xor(r, o); }
    if ((threadIdx.x & 63) == 0) { atomicAdd(acc, d); atomicAdd(acc + 1, r); }
}
__global__ void __launch_bounds__(256) apply_probe(float* out, const float* acc) {
    const float err = sqrtf(acc[0] / fmaxf(acc[1], 1e-30f));
    for (int i = threadIdx.x; i < MS * DI; i += 256) out[O_IKS + i] *= (1.f + err);
    if (threadIdx.x == 0) out[O_YP] += acc[2] * (1.f / MP);
}
#endif

extern "C" void kernel_launch(void* const* d_in, const int* in_sizes, int n_in, void* d_out, int out_size, void* d_ws, size_t ws_size, hipStream_t stream) {
    static int grid = 0;
    if (grid == 0) {
        int dev = 0, cus = 0, per_cu = 0;
        if (n_in != 18 || (size_t)out_size != O_END || ws_size < (HYBRID ? WS_END : WS_FAST_END)) { fprintf(stderr, "kernel_launch: unexpected sizes (n_in %d out %d ws %zu need %zu)\n", n_in, out_size, ws_size, (size_t)WS_END); grid = -1; return; }
        if (hipGetDevice(&dev) != hipSuccess || hipDeviceGetAttribute(&cus, hipDeviceAttributeMultiprocessorCount, dev) != hipSuccess) { grid = -1; return; }
        if (hipFuncSetAttribute((const void*)mega_fwd, hipFuncAttributeMaxDynamicSharedMemorySize, LDS_BYTES) != hipSuccess) { fprintf(stderr, "kernel_launch: hipFuncSetAttribute failed\n"); grid = -1; return; }
        if (hipOccupancyMaxActiveBlocksPerMultiprocessor(&per_cu, (const void*)mega_fwd, NWAVES * 64, LDS_BYTES) != hipSuccess || per_cu < 1) fprintf(stderr, "kernel_launch: occupancy query says %d\n", per_cu);
        (void)hipGetLastError();
        grid = cus;
    }
    if (grid < 0) return;
    const float* x_prompt = (const float*)d_in[0]; const float* x_sample = (const float*)d_in[1];
    const float* cache_k = (const float*)d_in[3]; const float* cache_v = (const float*)d_in[4]; const float* cache_idx_k = (const float*)d_in[5];
    const float* state_hgrn = (const float*)d_in[6]; const float* cache_mem_k = (const float*)d_in[7]; const float* cache_mem_v = (const float*)d_in[8];
    const int* page_table = (const int*)d_in[9]; const float* lb_logits = (const float*)d_in[11];
    const float* norm_g = (const float*)d_in[12]; const float* w_out = (const float*)d_in[15]; const float* ln_g = (const float*)d_in[16]; const float* ln_b = (const float*)d_in[17];
    float* out = (float*)d_out;
    unsigned char* wsb = (unsigned char*)d_ws;
    (void)hipMemsetAsync(wsb + WS_CTL, 0, CTL_BYTES, stream);
    Args a{};
    a.x_prompt = x_prompt; a.x_sample = x_sample; a.mem_prompt = (const float*)d_in[2]; a.cache_k = cache_k; a.cache_v = cache_v; a.cache_idx_k = cache_idx_k; a.state_hgrn = state_hgrn;
    a.cache_mem_k = cache_mem_k; a.cache_mem_v = cache_mem_v; a.page_table = page_table; a.w_in = (const float*)d_in[10]; a.lb_logits = lb_logits; a.norm_g = norm_g;
    a.w_mem_k = (const float*)d_in[13]; a.w_mem_v = (const float*)d_in[14]; a.w_out = w_out; a.ln_g = ln_g; a.ln_b = ln_b; a.out = out; a.ws = wsb; a.pad = 0; a.dbg_aout = nullptr; a.dbg_mout = nullptr; a.dbg_bo = nullptr;
#if NLAUNCH == 1
    a.ph_lo = 0; a.ph_hi = HYBRID ? 2 : 7; a.li = 0;
    hipLaunchKernelGGL(mega_fwd, dim3(grid), dim3(NWAVES * 64), LDS_BYTES, stream, a);
#else
    { const int cuts[6] = {0, 2, 3, 4, 5, 7};
      for (int li = 0; li < 5; ++li) { a.ph_lo = cuts[li]; a.ph_hi = cuts[li + 1]; a.li = li; hipLaunchKernelGGL(mega_fwd, dim3(grid), dim3(NWAVES * 64), LDS_BYTES, stream, a); } }
#endif
#if HYBRID
    float* Z = (float*)(wsb + WS_Z); float* Qr = (float*)(wsb + WS_QR); float* IQr = (float*)(wsb + WS_IQR); int* sel = (int*)(wsb + WS_SEL); float* a_out = (float*)(wsb + WS_AOUT);
    float* b_o = (float*)(wsb + WS_BO); float* m_out = (float*)(wsb + WS_MO); float* cat = (float*)(wsb + WS_CAT); float* SC = (float*)(wsb + WS_SC);
    post_rows<<<MR, 256, 0, stream>>>(Z, Qr, IQr, out, 0, 0);
    idx_scores<<<dim3((NKEYS_S + 255) / 256, 64), 256, 0, stream>>>(Z, IQr, out, cache_idx_k, page_table, SC, MP, 16400);
    idx_select<<<dim3((NKEYS_S + 255) / 256, 64), 256, 0, stream>>>(SC, sel, MP, 16400);
    sparse_attn<<<MS, 256, 0, stream>>>(Qr, sel, out, cache_k, cache_v, page_table, a_out, MP);
    a.ph_lo = 2; a.ph_hi = 5; a.li = 1; a.dbg_aout = a_out; a.dbg_mout = m_out; a.dbg_bo = b_o;
    hipLaunchKernelGGL(mega_fwd, dim3(grid), dim3(NWAVES * 64), LDS_BYTES, stream, a);
#if PROBE
    {
        float* m_ref = (float*)(wsb + WS_Y); float* acc = (float*)(wsb + WS_SC);
        (void)hipMemsetAsync(acc, 0, 16, stream);
        mem_attn<<<MP, 256, 0, stream>>>(Z, out + O_MKP, out + O_MVP, m_ref, 0, T);
        cmp_vals<<<1024, 256, 0, stream>>>(m_out, m_ref, (size_t)MP * WM, acc);
    }
#endif
    hgrn_seq<<<SB * HB * 2, 256, 0, stream>>>(Z, lb_logits, state_hgrn, out + O_HS, b_o, MP, ST);
    mem_attn<<<MS, 256, 0, stream>>>(Z, cache_mem_k, cache_mem_v, m_out, MP, ST);
    merge_rows<<<MR, 256, 0, stream>>>(Z, a_out, b_o, m_out, norm_g, cat, (unsigned short*)(wsb + WS_CATB));
    a.ph_lo = 5; a.ph_hi = 7; a.li = 2; a.dbg_aout = nullptr; a.dbg_mout = nullptr; a.dbg_bo = nullptr;
    hipLaunchKernelGGL(mega_fwd, dim3(grid), dim3(NWAVES * 64), LDS_BYTES, stream, a);
#if PROBE
    apply_probe<<<1, 256, 0, stream>>>(out, (const float*)(wsb + WS_SC));
#endif
#endif
}
```

```cpp
#include <hip/hip_runtime.h>
#include <cstdio>
#include <cstdint>
#include <math.h>

#ifndef HYBRID
#define HYBRID 0
#endif
#ifndef PROBE
#define PROBE 0
#endif
#ifndef NLAUNCH
#define NLAUNCH 1
#endif
#define CTL_BYTES (PROBE ? (size_t)(1u << 20) : (size_t)(192u << 10))
#ifndef SEL_HIST
#define SEL_HIST 1
#endif
#ifndef PROBE_A
#define PROBE_A 6
#endif
#ifndef PROBE_B
#define PROBE_B 8
#endif
#ifndef PROBE_SUB
#define PROBE_SUB 1
#endif
#ifndef PROBE_BLK
#define PROBE_BLK 0
#endif
#ifndef PROBE_PH
#define PROBE_PH 4
#endif
#ifndef PROBE_ARG
#define PROBE_ARG 0
#endif

constexpr int DM = 2048, NB = 4, T = 2048, SB = 8, ST = 8, PAST = 16384, PAGE = 128, NPAGES = PAST / PAGE;
constexpr int HA = 8, DH = 128, WA = 1024, HI = 16, DI = 64, HB = 4, DK = 128, DV = 128, WB = 512, HM = 4, WM = 512, NMEM = 256;
constexpr int NIN = 8272, NMAIN = 8192, NIKW = 80, TOPK = 256;
constexpr int MP = NB * T, MS = SB * ST, MR = MP + MS;
constexpr int NKEYS_S = PAST + ST;
constexpr int C_AQ = 0, C_AK = 1024, C_AV = 2048, C_AG = 3072, C_IQ = 4096, C_IK = 5120, C_IW = 5184, C_BQ = 5200, C_BF = 5712, C_BI = 6224, C_BG = 6736, C_MQ = 7248, C_MG = 7760;
constexpr float ALPHA = 1.189207115002721f, LN_EPS = 1e-5f, RMS_EPS = 1e-6f;
constexpr float SM_SCALE = 0.08838834764831845f, LOG2E = 1.4426950408889634f;
constexpr int NPOS = T + ST;
constexpr size_t O_YP = 0, O_YS = O_YP + (size_t)MP * DM, O_KP = O_YS + (size_t)MS * DM, O_VP = O_KP + (size_t)MP * WA, O_IKP = O_VP + (size_t)MP * WA,
                 O_HP = O_IKP + (size_t)MP * DI, O_MKP = O_HP + (size_t)NB * HB * DK * DV, O_MVP = O_MKP + (size_t)NB * NMEM * WM, O_KS = O_MVP + (size_t)NB * NMEM * WM,
                 O_VS = O_KS + (size_t)MS * WA, O_IKS = O_VS + (size_t)MS * WA, O_HS = O_IKS + (size_t)MS * DI, O_END = O_HS + (size_t)SB * HB * DK * DV;

constexpr size_t al256(size_t x) { return (x + 255) & ~(size_t)255; }
constexpr size_t WS_CTL = 0, CTL_RESERVED = 1u << 20;
constexpr size_t WS_XB = WS_CTL + CTL_RESERVED;
constexpr size_t WS_WMAIN = WS_XB + al256((size_t)MR * DM * 2);
constexpr size_t WS_WIKW = WS_WMAIN + al256((size_t)NMAIN * DM * 2);
constexpr size_t WS_WOUT = WS_WIKW + al256((size_t)NIKW * DM * 2);
constexpr size_t WS_WMKV = WS_WOUT + al256((size_t)DM * DM * 2);
constexpr size_t WS_MEMB = WS_WMKV + al256((size_t)1024 * DM * 2);
constexpr size_t WS_ROPEA = WS_MEMB + al256((size_t)NB * NMEM * DM * 2);
constexpr size_t WS_ROPEI = WS_ROPEA + al256((size_t)NPOS * 16 * 8);
constexpr size_t WS_LB = WS_ROPEI + al256((size_t)NPOS * 8 * 8);
constexpr size_t WS_QB = WS_LB + al256(512 * 4);
constexpr size_t WS_KB = WS_QB + al256((size_t)MP * WA * 2);
constexpr size_t WS_VB = WS_KB + al256((size_t)MP * WA * 2);
constexpr size_t WS_GA = WS_VB + al256((size_t)MP * WA * 2);
constexpr size_t WS_IQB = WS_GA + al256((size_t)MP * WA * 2);
constexpr size_t WS_HQ = WS_IQB + al256((size_t)MP * WA * 2);
constexpr size_t WS_HG = WS_HQ + al256((size_t)MP * WB * 4);
constexpr size_t WS_HV = WS_HG + al256((size_t)MP * WB * 4);
constexpr size_t WS_GB = WS_HV + al256((size_t)MP * WB * 2);
constexpr size_t WS_MQB = WS_GB + al256((size_t)MP * WB * 2);
constexpr size_t WS_GM = WS_MQB + al256((size_t)MP * WM * 2);
constexpr size_t WS_IKB = WS_GM + al256((size_t)MP * WM * 2);
constexpr size_t WS_IW = WS_IKB + al256((size_t)MR * DI * 2);
constexpr size_t WS_MKB = WS_IW + al256((size_t)MR * HI * 4);
constexpr size_t WS_MVB = WS_MKB + al256((size_t)NB * NMEM * WM * 2);
constexpr size_t WS_ZS = WS_MVB + al256((size_t)NB * NMEM * WM * 2);
constexpr size_t WS_CATB = WS_ZS + al256((size_t)MS * NIN * 4);
constexpr size_t WS_MASK = WS_CATB + al256((size_t)MR * DM * 2);
constexpr int NCH = T / 64, NHU = NB * HB * NCH;
constexpr size_t WS_QABS = WS_MASK + al256((size_t)MP * 64 * 4);
constexpr size_t WS_OT = WS_QABS + al256((size_t)MP * WB * 2);
constexpr size_t WS_KVT = WS_OT + al256((size_t)NHU * 128 * 64 * 4);
constexpr size_t WS_EG = WS_KVT + al256((size_t)NHU * 128 * 128 * 4);
constexpr size_t WS_SCT = WS_EG + al256((size_t)NHU * 128 * 4);
constexpr int LDSC = 16400;
constexpr size_t WS_SCS = WS_SCT + al256((size_t)NHU * 128 * 128 * 2);
constexpr size_t WS_SELS = WS_SCS + al256((size_t)MS * LDSC * 4);
constexpr size_t WS_YMIX = WS_SELS + al256((size_t)MS * TOPK * 4);
constexpr size_t WS_FAST_END = WS_YMIX + al256((size_t)MR * DM * 2);
constexpr size_t WS_Z = WS_FAST_END;
constexpr size_t WS_QR = WS_Z + al256((size_t)MR * NIN * 4);
constexpr size_t WS_IQR = WS_QR + al256((size_t)MR * WA * 4);
constexpr size_t WS_SEL = WS_IQR + al256((size_t)MR * WA * 4);
constexpr size_t WS_AOUT = WS_SEL + al256((size_t)MR * TOPK * 4);
constexpr size_t WS_BO = WS_AOUT + al256((size_t)MR * WA * 4);
constexpr size_t WS_MO = WS_BO + al256((size_t)MR * WB * 4);
constexpr size_t WS_CAT = WS_MO + al256((size_t)MR * WM * 4);
constexpr size_t WS_Y = WS_CAT + al256((size_t)MR * DM * 4);
constexpr size_t WS_SC = WS_Y + al256((size_t)MR * DM * 4);
constexpr size_t WS_END = WS_SC + al256((size_t)64 * 16400 * 4);

__device__ __forceinline__ float silu_f(float x) { return x / (1.f + expf(-x)); }
__device__ __forceinline__ float fexp(float x) { return __builtin_amdgcn_exp2f(x * 1.4426950408889634f); }
__device__ __forceinline__ float fsilu(float x) { return x * __builtin_amdgcn_rcpf(1.f + fexp(-x)); }
__device__ __forceinline__ float fsigmoid(float x) { return __builtin_amdgcn_rcpf(1.f + fexp(-x)); }
__device__ __forceinline__ float flog(float x) { return __builtin_amdgcn_logf(x) * 0.6931471805599453f; }
__device__ __forceinline__ float sigmoid_f(float x) { return 1.f / (1.f + expf(-x)); }

namespace pg8 {
#define PG8_LAS __attribute__((address_space(3)))
typedef unsigned short bf16_t;
typedef short bf16x8 __attribute__((ext_vector_type(8)));
typedef float f32x4 __attribute__((ext_vector_type(4)));
typedef unsigned u32x4 __attribute__((ext_vector_type(4)));
constexpr int BM = 256, BK = 64, HALF = 128, HTB = HALF * BK * 2  , STAGE_BYTES = 8 * HTB, NXCD = 8, WGM = 8;

__host__ __device__ __forceinline__ int lds_byte(int r, int c) { const int st = (r >> 4) * 2 + (c >> 5), rr = r & 15, cc = c & 31, ob = rr * 64 + cc * 2; return st * 1024 + (ob ^ (((ob >> 9) & 1) << 5)); }
__host__ __device__ __forceinline__ void stage_rc(int b, int& R, int& C) { const int st = b / 1024, sb = b % 1024, swz = sb ^ (((sb >> 9) & 1) << 5); R = (st >> 1) * 16 + swz / 64; C = (st & 1) * 32 + (swz % 64) / 2; }
__host__ __device__ __forceinline__ int perm32(int rho) { const int n = rho >> 4, i = rho & 15; return 8 * (i >> 2) + 4 * n + (i & 3); }

struct Unit { int pm, pn; };
struct Gemm { const bf16_t* A; const bf16_t* Bt; int M, N, K; };

struct StaticOrder {
    int nM, nN, nwg, G, c;
    __host__ __device__ void init(int M, int N, int G_, int c_) { nM = M / BM; nN = N / BM; nwg = nM * nN; G = G_; c = c_; }
    __host__ __device__ bool next(int i, Unit& u) const {
        const long L = (long)i * G + c; if (L >= nwg) return false;
        int wgid = (int)L; { const int q = nwg / NXCD, r = nwg % NXCD, xcd = wgid % NXCD, off = wgid / NXCD; wgid = (xcd < r ? xcd * (q + 1) : r * (q + 1) + (xcd - r) * q) + off; }
        const int nig = WGM * nN, gid = wgid / nig, fm = gid * WGM, gsz = (nM - fm) < WGM ? (nM - fm) : WGM;
        u.pm = fm + ((wgid % nig) % gsz); u.pn = (wgid % nig) / gsz; return true;
    }
    __device__ __forceinline__ void a_ready(const Unit&) const {}
    __device__ __forceinline__ void done(const Unit&) const {}
};

__device__ __forceinline__ unsigned cvt_pk_bf16(float lo, float hi) { unsigned r; asm volatile("v_cvt_pk_bf16_f32 %0, %1, %2" : "=v"(r) : "v"(lo), "v"(hi)); return r; }
template <class Epi, class Sched, bool ALIGN_EPI = false, bool SP2 = false>
__device__ __forceinline__ void gemm_phase(PG8_LAS unsigned char* lds, const Gemm g, const Sched& S, const Epi& E) {
    const int tid = threadIdx.x, wid = __builtin_amdgcn_readfirstlane(tid >> 6), lane = tid & 63, wr = wid >> 2, wc = wid & 3, fr = lane & 15, fq = lane >> 4;
    const int K = g.K, nt = K / BK;
    unsigned voffA[2], voffB[2];
#pragma unroll
    for (int i = 0; i < 2; ++i) { int R, C; stage_rc(tid * 16 + i * 8192, R, C); const int Rb = Epi::PERM ? ((R & ~31) + perm32(R & 31)) : R;
        voffA[i] = (unsigned)(R * K + C) * 2u; voffB[i] = (unsigned)(Rb * K + C) * 2u; }
    const size_t kstep = (size_t)(BK * 2);
    const size_t hstep = (size_t)HALF * K * 2;
    const size_t tstep = 2 * hstep;
    const unsigned ldsw = (unsigned)wid * 1024u;
    const int aoff = lds_byte(wr * 64 + fr, fq * 8), boff = lds_byte(wc * 32 + fr, fq * 8);
#define PG8_SA(b, h) (((b) * 2 + (h)) * HTB)
#define PG8_SB(b, h) ((4 + (b) * 2 + (h)) * HTB)
#define PG8_STAGE(bufoff, gbase, voff) do { _Pragma("unroll") for (int _i = 0; _i < 2; ++_i) \
        __builtin_amdgcn_global_load_lds((const unsigned*)((const char*)(gbase) + (voff)[_i]), (PG8_LAS unsigned*)(lds + (bufoff) + ldsw + _i * 8192), 16, 0, 0); } while (0)
#define PG8_LDA(dst, b, h) do { _Pragma("unroll") for (int m = 0; m < 4; ++m) _Pragma("unroll") for (int k = 0; k < 2; ++k) dst[m][k] = *(const PG8_LAS bf16x8*)(lds + PG8_SA(b, h) + aoff + m * 2048 + k * 1024); } while (0)
#define PG8_LDB(dst, b, h) do { _Pragma("unroll") for (int n = 0; n < 2; ++n) _Pragma("unroll") for (int k = 0; k < 2; ++k) dst[n][k] = *(const PG8_LAS bf16x8*)(lds + PG8_SB(b, h) + boff + n * 2048 + k * 1024); } while (0)
#define PG8_MMA(ai, bj, At, Bt) do { __builtin_amdgcn_s_setprio(1); _Pragma("unroll") for (int m = 0; m < 4; ++m) _Pragma("unroll") for (int n = 0; n < 2; ++n) _Pragma("unroll") for (int k = 0; k < 2; ++k) \
        acc[ai][bj][m][n] = __builtin_amdgcn_mfma_f32_16x16x32_bf16(Bt[n][k], At[m][k], acc[ai][bj][m][n], 0, 0, 0); __builtin_amdgcn_s_setprio(0); } while (0)
#define PG8_WAIT_V(n) asm volatile("s_waitcnt vmcnt(" #n ")" ::: "memory")
#define PG8_WAIT_L(n) asm volatile("s_waitcnt lgkmcnt(" #n ")" ::: "memory")
#define PG8_BAR __builtin_amdgcn_s_barrier()
#define PG8_SCHED __builtin_amdgcn_sched_barrier(0)
    Unit cur, nxt; int ui = 0;
    if (!S.next(0, cur)) return;
    f32x4 acc[2][2][4][2];
#pragma unroll
    for (int a = 0; a < 2; ++a)
#pragma unroll
        for (int b = 0; b < 2; ++b)
#pragma unroll
            for (int m = 0; m < 4; ++m)
#pragma unroll
                for (int n = 0; n < 2; ++n) acc[a][b][m][n] = (f32x4){0.f, 0.f, 0.f, 0.f};
    bf16x8 At[4][2], B0[2][2], B1[2][2];
    const char* cA = (const char*)g.A + (size_t)cur.pm * tstep; const char* cB = (const char*)g.Bt + (size_t)cur.pn * tstep;
    S.a_ready(cur);
    if constexpr (SP2) {
        PG8_STAGE(PG8_SB(0, 0), cB, voffB); PG8_STAGE(PG8_SB(0, 1), cB + hstep, voffB); PG8_STAGE(PG8_SA(0, 0), cA, voffA); PG8_STAGE(PG8_SA(0, 1), cA + hstep, voffA);
        if (wr == 1) PG8_BAR;
        PG8_WAIT_V(2); PG8_BAR;
        PG8_STAGE(PG8_SB(1, 0), cB + kstep, voffB); PG8_STAGE(PG8_SA(1, 0), cA + kstep, voffA); PG8_STAGE(PG8_SB(1, 1), cB + hstep + kstep, voffB);
        PG8_WAIT_V(6); PG8_BAR;
    } else {
        PG8_STAGE(PG8_SB(0, 0), cB, voffB); PG8_STAGE(PG8_SA(0, 0), cA, voffA); PG8_STAGE(PG8_SB(0, 1), cB + hstep, voffB); PG8_STAGE(PG8_SA(0, 1), cA + hstep, voffA);
        if (wr == 1) PG8_BAR;
        PG8_WAIT_V(4); PG8_BAR;
        PG8_STAGE(PG8_SB(1, 0), cB + kstep, voffB); PG8_STAGE(PG8_SA(1, 0), cA + kstep, voffA); PG8_STAGE(PG8_SB(1, 1), cB + hstep + kstep, voffB);
        PG8_WAIT_V(6); PG8_BAR;
    }
    for (;;) {
        const bool has_next = S.next(ui + 1, nxt);
        const char* nA = has_next ? (const char*)g.A + (size_t)nxt.pm * tstep : cA; const char* nB = has_next ? (const char*)g.Bt + (size_t)nxt.pn * tstep : cB;
        for (int t = 0; t < nt; t += 2) {
            const bool last = (t == nt - 2);
            const char* a1 = cA + (size_t)(t + 1) * kstep;
            const char* a2 = last ? nA : cA + (size_t)(t + 2) * kstep; const char* b2 = last ? nB : cB + (size_t)(t + 2) * kstep;
            const char* a3 = a2 + kstep; const char* b3 = b2 + kstep;
            if (last && has_next) S.a_ready(nxt);
            if constexpr (SP2) {
            PG8_LDB(B0, 0, 0); PG8_LDB(B1, 0, 1); PG8_SCHED; PG8_LDA(At, 0, 0); PG8_STAGE(PG8_SA(1, 1), a1 + hstep, voffA);
            PG8_WAIT_V(8); PG8_WAIT_L(0); PG8_BAR; PG8_MMA(0, 0, At, B0); PG8_MMA(0, 1, At, B1); PG8_BAR; PG8_SCHED;
            PG8_LDA(At, 0, 1); PG8_STAGE(PG8_SB(0, 0), b2, voffB); PG8_STAGE(PG8_SB(0, 1), b2 + hstep, voffB); PG8_STAGE(PG8_SA(0, 0), a2, voffA);
            PG8_WAIT_V(8); PG8_WAIT_L(0); PG8_BAR; PG8_MMA(1, 0, At, B0); PG8_MMA(1, 1, At, B1); PG8_BAR; PG8_SCHED;
            PG8_LDB(B0, 1, 0); PG8_LDB(B1, 1, 1); PG8_SCHED; PG8_LDA(At, 1, 0); PG8_STAGE(PG8_SA(0, 1), a2 + hstep, voffA);
            PG8_WAIT_V(8); PG8_WAIT_L(0); PG8_BAR; PG8_MMA(0, 0, At, B0); PG8_MMA(0, 1, At, B1); PG8_BAR; PG8_SCHED;
            PG8_LDA(At, 1, 1); PG8_STAGE(PG8_SB(1, 0), b3, voffB); PG8_STAGE(PG8_SB(1, 1), b3 + hstep, voffB); PG8_STAGE(PG8_SA(1, 0), a3, voffA);
            PG8_WAIT_V(8); PG8_WAIT_L(0); PG8_BAR; PG8_MMA(1, 0, At, B0); PG8_MMA(1, 1, At, B1); PG8_BAR; PG8_SCHED;
            } else {
            PG8_LDB(B0, 0, 0); PG8_SCHED; PG8_LDA(At, 0, 0); PG8_STAGE(PG8_SA(1, 1), a1 + hstep, voffA);
            PG8_WAIT_L(8); PG8_BAR; PG8_WAIT_L(0); PG8_MMA(0, 0, At, B0); PG8_BAR; PG8_SCHED;
            PG8_LDB(B1, 0, 1); PG8_STAGE(PG8_SB(0, 0), b2, voffB);
            PG8_BAR; PG8_WAIT_L(0); PG8_MMA(0, 1, At, B1); PG8_BAR;
            PG8_LDA(At, 0, 1); PG8_STAGE(PG8_SA(0, 0), a2, voffA);
            PG8_BAR; PG8_WAIT_L(0); PG8_MMA(1, 0, At, B0); PG8_BAR; PG8_SCHED;
            PG8_STAGE(PG8_SB(0, 1), b2 + hstep, voffB);
            PG8_WAIT_V(6); PG8_BAR; PG8_MMA(1, 1, At, B1); PG8_BAR;
            PG8_LDB(B0, 1, 0); PG8_SCHED; PG8_LDA(At, 1, 0); PG8_STAGE(PG8_SA(0, 1), a2 + hstep, voffA);
            PG8_WAIT_L(8); PG8_BAR; PG8_WAIT_L(0); PG8_MMA(0, 0, At, B0); PG8_BAR; PG8_SCHED;
            PG8_LDB(B1, 1, 1); PG8_STAGE(PG8_SB(1, 0), b3, voffB);
            PG8_BAR; PG8_WAIT_L(0); PG8_MMA(0, 1, At, B1); PG8_BAR;
            PG8_LDA(At, 1, 1); PG8_STAGE(PG8_SA(1, 0), a3, voffA);
            PG8_BAR; PG8_WAIT_L(0); PG8_MMA(1, 0, At, B0); PG8_BAR; PG8_SCHED;
            PG8_STAGE(PG8_SB(1, 1), b3 + hstep, voffB);
            PG8_WAIT_V(6); PG8_BAR; PG8_MMA(1, 1, At, B1); PG8_BAR;
            }
        }
        if constexpr (ALIGN_EPI) { if (wr == 0) PG8_BAR; }
        if constexpr (!Epi::AFTER_DRAIN) { E(acc, cur, wr, wc, fr, fq); S.done(cur); }
        if (!has_next) break;
#pragma unroll
        for (int a = 0; a < 2; ++a)
#pragma unroll
            for (int b = 0; b < 2; ++b)
#pragma unroll
                for (int m = 0; m < 4; ++m)
#pragma unroll
                    for (int n = 0; n < 2; ++n) acc[a][b][m][n] = (f32x4){0.f, 0.f, 0.f, 0.f};
        cur = nxt; cA = nA; cB = nB; ++ui;
        if constexpr (ALIGN_EPI) { if (wr == 1) PG8_BAR; }
    }
    PG8_WAIT_V(0);
    if constexpr (!ALIGN_EPI) { if (wr == 0) PG8_BAR; }
    PG8_BAR;
    if constexpr (Epi::AFTER_DRAIN) { E.fused(acc, cur, wr, wc, fr, fq, lds, wid, lane); S.done(cur); }
#undef PG8_SA
#undef PG8_SB
#undef PG8_STAGE
#undef PG8_LDA
#undef PG8_LDB
#undef PG8_MMA
#undef PG8_WAIT_V
#undef PG8_WAIT_L
#undef PG8_BAR
#undef PG8_SCHED
}
}


#define GAS __attribute__((address_space(1)))
#define LAS __attribute__((address_space(3)))
typedef unsigned short bf16;
typedef unsigned v4u __attribute__((ext_vector_type(4)));
typedef unsigned u32x2 __attribute__((ext_vector_type(2)));
typedef float f32x4 __attribute__((ext_vector_type(4)));
typedef short bf16x8 __attribute__((ext_vector_type(8)));
typedef GAS unsigned gu32;
#define RLX_AGENT __ATOMIC_RELAXED, __HIP_MEMORY_SCOPE_AGENT
#define LDS_WAIT() asm volatile("s_waitcnt lgkmcnt(0)" ::: "memory")
#define VM_WAIT() asm volatile("s_waitcnt vmcnt(0)" ::: "memory")
__device__ __forceinline__ unsigned f2bf(float f) { unsigned u = __builtin_bit_cast(unsigned, f); return (u + 0x7fffu + ((u >> 16) & 1u)) >> 16; }
__device__ __forceinline__ unsigned pk2(float lo, float hi) { return f2bf(lo) | (f2bf(hi) << 16); }
__device__ __forceinline__ v4u pack8(const f32x4 a, const f32x4 b) { v4u w; w.x = pg8::cvt_pk_bf16(a[0], a[1]); w.y = pg8::cvt_pk_bf16(a[2], a[3]); w.z = pg8::cvt_pk_bf16(b[0], b[1]); w.w = pg8::cvt_pk_bf16(b[2], b[3]); return w; }

#define XB_TMO      128
#define XB_XCNT(j)  (256  + 64 * (j))
#define XB_XSUB(j)  (1280 + 64 * (j))
#define XB_XGEN(j)  (2304 + 64 * (j))
#define XB_TOP      3328
#define XB_TOPGEN   3392
#define XCD_BAR_WORDS 3456
#define XB_SPIN_CAP (1u << 18)

__device__ __forceinline__ unsigned xb_ld(unsigned* p)              { return __hip_atomic_load(p, __ATOMIC_RELAXED, __HIP_MEMORY_SCOPE_AGENT); }
__device__ __forceinline__ unsigned xb_add(unsigned* p, unsigned v) { return __hip_atomic_fetch_add(p, v, __ATOMIC_RELAXED, __HIP_MEMORY_SCOPE_AGENT); }
__device__ __forceinline__ unsigned xb_xcc_id() { return (unsigned)__builtin_amdgcn_s_getreg((3 << 11) | 20) & 0xFu; }
#define XB_SPIN(cond, bar) do { unsigned _sp = 0; while (cond) { __builtin_amdgcn_s_sleep(1); \
    if ((++_sp & 255u) == 0u) { if (xb_ld(&(bar)[XB_TMO])) break; if (_sp > XB_SPIN_CAP) { atomicAdd(&(bar)[XB_TMO], 1u); break; } } } } while (0)

struct XcdBarrier {
    unsigned* bar; unsigned x;
    volatile LAS unsigned* st;
};

__device__ __forceinline__ XcdBarrier xcd_barrier_post(unsigned* bar, volatile LAS unsigned* st) {
    XcdBarrier b; b.bar = bar; b.x = xb_xcc_id(); b.st = st;
    if (threadIdx.x == 0) (void)xb_add(&bar[XB_XCNT(b.x)], 1u);
    return b;
}
__device__ __forceinline__ void xcd_barrier_complete(unsigned* bar, unsigned x, unsigned& nloc, unsigned& nx) {
    const unsigned G = gridDim.x * gridDim.y * gridDim.z;
    unsigned sum, cnt, mine, sp = 0u;
    for (;;) {
        sum = 0u; cnt = 0u; mine = 0u;
#pragma unroll
        for (unsigned j = 0; j < 16; ++j) { const unsigned c = xb_ld(&bar[XB_XCNT(j)]); sum += c; cnt += (c > 0u) ? 1u : 0u; mine = (j == x) ? c : mine; }
        if (sum == G) break;
        __builtin_amdgcn_s_sleep(1);
        if ((++sp & 255u) == 0u) { if (xb_ld(&bar[XB_TMO])) break; if (sp > XB_SPIN_CAP) { atomicAdd(&bar[XB_TMO], 1u); break; } }
    }
    nloc = mine > 0u ? mine : 1u; nx = cnt > 0u ? cnt : 1u;
}

__device__ __forceinline__ void xcd_barrier(const XcdBarrier& b) {
    asm volatile("s_waitcnt vmcnt(0)" ::: "memory");
    __syncthreads();
    if (threadIdx.x == 0) {
        unsigned* bar = b.bar;
        __builtin_amdgcn_s_waitcnt(0);
        unsigned nloc = b.st[0], nx = b.st[1];
        if (nloc == 0u) { xcd_barrier_complete(bar, b.x, nloc, nx); b.st[0] = nloc; b.st[1] = nx; }
        const unsigned old = xb_add(&bar[XB_XSUB(b.x)], 1u);
        const unsigned gen = old / nloc;
        if (old + 1u == (gen + 1u) * nloc) {
            __builtin_amdgcn_fence(__ATOMIC_RELEASE, "agent");
            asm volatile("s_waitcnt vmcnt(0)" ::: "memory");
            const unsigned og = xb_add(&bar[XB_TOP], 1u);
            const unsigned tg = og / nx;
            if (og + 1u == (tg + 1u) * nx) xb_add(&bar[XB_TOPGEN], 1u);
            else XB_SPIN(xb_ld(&bar[XB_TOPGEN]) == tg, bar);
            __builtin_amdgcn_fence(__ATOMIC_ACQUIRE, "agent");
            xb_add(&bar[XB_XGEN(b.x)], 1u);
            asm volatile("s_waitcnt vmcnt(0)" ::: "memory");
        } else {
            XB_SPIN(xb_ld(&bar[XB_XGEN(b.x)]) == gen, bar);
            __builtin_amdgcn_fence(__ATOMIC_ACQUIRE, "agent");
            asm volatile("s_waitcnt vmcnt(0)" ::: "memory");
        }
    }
    __syncthreads();
}


constexpr int RING_OFF = 0, RING_BYTES = 131072;
constexpr int AUX_OFF = RING_BYTES, AUX_BYTES = 24576;
constexpr int LDSCTL_OFF = AUX_OFF + AUX_BYTES, MISC_OFF = LDSCTL_OFF + 320;
constexpr int LDS_BYTES = LDSCTL_OFF + 1024;
constexpr int NWAVES = 8;
constexpr int CW_BAR = 4096;

struct Args {
    const float *x_prompt, *x_sample, *mem_prompt, *cache_k, *cache_v, *cache_idx_k, *state_hgrn, *cache_mem_k, *cache_mem_v;
    const int* page_table;
    const float *w_in, *lb_logits, *norm_g, *w_mem_k, *w_mem_v, *w_out, *ln_g, *ln_b;
    float* out; unsigned char* ws; float* dbg_aout; float* dbg_mout; float* dbg_bo; int ph_lo, ph_hi, li, pad;
};

__device__ __forceinline__ void rope_cs(int pos, int j, int half, float& c, float& s) {
    const float inv = exp2f(-(float)j / (float)half * 18.931568569324174f);
    const float ang = (float)pos * inv;
    const float k = rintf(ang * 0.15915494309189535f);
    float r = fmaf(-k, 6.2831854820251465f, ang);
    r = fmaf(-k, -1.7484555e-7f, r);
    c = cosf(r); s = sinf(r);
}
struct TrItem { const float* src; bf16* dst; int ldw, nc; };
__device__ __forceinline__ TrItem p0_decode(const Args& A, unsigned char* ws, int it) {
    bf16* Wmain = (bf16*)(ws + WS_WMAIN); bf16* Wikw = (bf16*)(ws + WS_WIKW); bf16* Wout = (bf16*)(ws + WS_WOUT); bf16* Wmkv = (bf16*)(ws + WS_WMKV);
    constexpr int NBLK = 80 + 48 + 2 + 32 + 8 + 8;
    const int kb = it / NBLK; int nb = it % NBLK; const int k0 = kb * 64;
    TrItem t; t.nc = 64;
    if (nb < 80) { t.src = A.w_in + (size_t)k0 * NIN + nb * 64; t.ldw = NIN; t.dst = Wmain + (size_t)(nb * 64) * DM + k0; return t; } nb -= 80;
    if (nb < 48) { t.src = A.w_in + (size_t)k0 * NIN + 5200 + nb * 64; t.ldw = NIN; t.dst = Wmain + (size_t)(5120 + nb * 64) * DM + k0; return t; } nb -= 48;
    if (nb < 2) { t.src = A.w_in + (size_t)k0 * NIN + 5120 + nb * 64; t.ldw = NIN; t.dst = Wikw + (size_t)(nb * 64) * DM + k0; t.nc = nb < 1 ? 64 : 16; return t; } nb -= 2;
    if (nb < 32) { t.src = A.w_out + (size_t)k0 * DM + nb * 64; t.ldw = DM; t.dst = Wout + (size_t)(nb * 64) * DM + k0; return t; } nb -= 32;
    if (nb < 8) { t.src = A.w_mem_k + (size_t)k0 * WM + nb * 64; t.ldw = WM; t.dst = Wmkv + (size_t)(nb * 64) * DM + k0; return t; } nb -= 8;
    t.src = A.w_mem_v + (size_t)k0 * WM + nb * 64; t.ldw = WM; t.dst = Wmkv + (size_t)(512 + nb * 64) * DM + k0; return t;
}
__device__ __forceinline__ void p0_tr_load(const TrItem& t, f32x4 (&v)[16], int lane) {
    const int c4 = (lane & 15) * 4, kr = lane >> 4;
#pragma unroll
    for (int i = 0; i < 16; ++i) v[i] = (c4 < t.nc) ? *(const GAS f32x4*)(t.src + (size_t)(kr + 4 * i) * t.ldw + c4) : (f32x4){0.f, 0.f, 0.f, 0.f};
}
__device__ __forceinline__ void p0_tr_finish(const TrItem& t, const f32x4 (&v)[16], LAS float* scr, int lane) {
    const int c4 = (lane & 15) * 4, kr = lane >> 4;
#pragma unroll
    for (int i = 0; i < 16; ++i) { LAS float* d = scr + (kr + 4 * i) * 65 + c4; d[0] = v[i][0]; d[1] = v[i][1]; d[2] = v[i][2]; d[3] = v[i][3]; }
    LDS_WAIT(); asm volatile("" ::: "memory");
    const int c8 = lane & 7;
#pragma unroll
    for (int j = 0; j < 8; ++j) { const int n = (lane >> 3) + 8 * j; const LAS float* sp = scr + (8 * c8) * 65 + n;
        v4u o; o.x = pk2(sp[0 * 65], sp[1 * 65]); o.y = pk2(sp[2 * 65], sp[3 * 65]); o.z = pk2(sp[4 * 65], sp[5 * 65]); o.w = pk2(sp[6 * 65], sp[7 * 65]);
        if (n < t.nc) *(GAS v4u*)(t.dst + (size_t)n * DM + 8 * c8) = o; }
    LDS_WAIT(); asm volatile("" ::: "memory");
}
__device__ __forceinline__ void cvt_rows(const float* src, bf16* dst, size_t nchunk8, size_t gtid, size_t gthreads) {
    for (size_t c0 = (gtid >> 6) * 512 + (gtid & 63); c0 < nchunk8; c0 += (gthreads >> 6) * 512) {
        f32x4 a[8], b[8];
#pragma unroll
        for (int u = 0; u < 8; ++u) { a[u] = *(const GAS f32x4*)(src + (c0 + 64 * u) * 8); b[u] = *(const GAS f32x4*)(src + (c0 + 64 * u) * 8 + 4); }
#pragma unroll
        for (int u = 0; u < 8; ++u) { v4u o; o.x = pk2(a[u][0], a[u][1]); o.y = pk2(a[u][2], a[u][3]); o.z = pk2(b[u][0], b[u][1]); o.w = pk2(b[u][2], b[u][3]); *(GAS v4u*)(dst + (c0 + 64 * u) * 8) = o; }
    }
}
__device__ __forceinline__ void p0_prologue(const Args& A, LAS unsigned char* lds, int G) {
    const int tid = threadIdx.x, lane = tid & 63, wave = tid >> 6;
    unsigned char* ws = A.ws;
    bf16* Xb = (bf16*)(ws + WS_XB); bf16* Wmain = (bf16*)(ws + WS_WMAIN); bf16* Wikw = (bf16*)(ws + WS_WIKW); bf16* Wout = (bf16*)(ws + WS_WOUT);
    bf16* Wmkv = (bf16*)(ws + WS_WMKV); bf16* MEMb = (bf16*)(ws + WS_MEMB);
    const size_t gtid = (size_t)blockIdx.x * 512 + tid, gthreads = (size_t)G * 512;
    {
        LAS float* scr = (LAS float*)(lds + RING_OFF + wave * 16640);
        const int gw = blockIdx.x * NWAVES + wave, NGW = G * NWAVES;
        constexpr int NITEMS = 32 * (80 + 48 + 2 + 32 + 8 + 8);
        if (gw < NITEMS) {
            TrItem cur = p0_decode(A, ws, gw); f32x4 vc[16];
            p0_tr_load(cur, vc, lane);
            for (int it = gw + NGW; it < NITEMS; it += NGW) {
                const TrItem nxt = p0_decode(A, ws, it); f32x4 vn[16];
                p0_tr_load(nxt, vn, lane);
                p0_tr_finish(cur, vc, scr, lane);
                cur = nxt;
#pragma unroll
                for (int i = 0; i < 16; ++i) vc[i] = vn[i];
            }
            p0_tr_finish(cur, vc, scr, lane);
        }
    }
    cvt_rows(A.x_prompt, Xb, (size_t)MP * DM / 8, gtid, gthreads);
    cvt_rows(A.x_sample, Xb + (size_t)MP * DM, (size_t)MS * DM / 8, gtid, gthreads);
    cvt_rows(A.mem_prompt, MEMb, (size_t)NB * NMEM * DM / 8, gtid, gthreads);
    float2* ropeA = (float2*)(ws + WS_ROPEA); float2* ropeI = (float2*)(ws + WS_ROPEI); float* lbv = (float*)(ws + WS_LB);
    for (size_t i = gtid; i < (size_t)NPOS * 16; i += gthreads) { const int p = (int)(i >> 4), j = (int)(i & 15); const int pos = p < T ? p : PAST + (p - T); float c, s; rope_cs(pos, j, 16, c, s); ropeA[i] = make_float2(c, s); }
    for (size_t i = gtid; i < (size_t)NPOS * 8; i += gthreads) { const int p = (int)(i >> 3), j = (int)(i & 7); const int pos = p < T ? p : PAST + (p - T); float c, s; rope_cs(pos, j, 8, c, s); ropeI[i] = make_float2(c, s); }
    for (size_t i = gtid; i < 512; i += gthreads) { const float l0 = A.lb_logits[i], l1 = A.lb_logits[512 + i]; const float m = fmaxf(l0, l1); const float e0 = expf(l0 - m), e1 = expf(l1 - m); lbv[i] = e0 / (e0 + e1); }
}

__device__ __forceinline__ int orig_col(int n) { return n < 5120 ? n : n + NIKW; }
struct EpiIn {
    static constexpr bool PERM = true, AFTER_DRAIN = false;
    float* out; float* Z; bf16 *Qb, *Kb, *Vb, *GA, *IQb, *HV, *GB, *MQb, *GM; float *HQ, *HG; const float2* ropeA; const float2* ropeI; const float* lbv;
    template <int GRP> __device__ __forceinline__ void run(const pg8::f32x4 (&acc)[2][2][4][2], const pg8::Unit& u, int wr, int wc, int fr, int fq) const {
        constexpr int gstart = GRP <= 4 ? GRP * 1024 : 5120 + (GRP - 5) * 512;
        const int ncol0 = u.pn * 256 + wc * 32 + 8 * fq;
        const int row0 = u.pm * 256 + wr * 64 + fr;
        const bool ropeA_on = (GRP == 0 || GRP == 1) && (wc == 0);
        const bool ropeI_on = (GRP == 4) && ((wc & 1) == 0);
#pragma unroll
        for (int ai = 0; ai < 2; ++ai)
#pragma unroll
            for (int m = 0; m < 4; ++m) {
                const int row = row0 + ai * 128 + m * 16;
                f32x4 cs[4];
                if (GRP == 0 || GRP == 1) { if (ropeA_on) { const GAS f32x4* tp = (const GAS f32x4*)(ropeA + (size_t)(row & (T - 1)) * 16 + 8 * (fq & 1));
#pragma unroll
                    for (int q = 0; q < 4; ++q) cs[q] = tp[q]; } }
                if (GRP == 4) { if (ropeI_on) { const GAS f32x4* tp = (const GAS f32x4*)(ropeI + (size_t)(row & (T - 1)) * 8);
#pragma unroll
                    for (int q = 0; q < 4; ++q) cs[q] = tp[q]; } }
#pragma unroll
                for (int bj = 0; bj < 2; ++bj) {
                    f32x4 v0 = acc[ai][bj][m][0], v1 = acc[ai][bj][m][1];
                    const int ncol = ncol0 + bj * 128, gcol = ncol - gstart;
#if HYBRID
                    { float* zp = Z + (size_t)row * NIN + orig_col(ncol); *(GAS f32x4*)zp = v0; *(GAS f32x4*)(zp + 4) = v1; }
#endif
                    if (GRP == 0 || GRP == 1) {
                        if (ropeA_on) {
                            f32x4 p0, p1;
#pragma unroll
                            for (int e = 0; e < 4; ++e) { p0[e] = __shfl_xor(v0[e], 32); p1[e] = __shfl_xor(v1[e], 32); }
                            const float sg = fq < 2 ? -1.f : 1.f;
                            v0[0] = v0[0] * cs[0][0] + sg * p0[0] * cs[0][1]; v0[1] = v0[1] * cs[0][2] + sg * p0[1] * cs[0][3];
                            v0[2] = v0[2] * cs[1][0] + sg * p0[2] * cs[1][1]; v0[3] = v0[3] * cs[1][2] + sg * p0[3] * cs[1][3];
                            v1[0] = v1[0] * cs[2][0] + sg * p1[0] * cs[2][1]; v1[1] = v1[1] * cs[2][2] + sg * p1[1] * cs[2][3];
                            v1[2] = v1[2] * cs[3][0] + sg * p1[2] * cs[3][1]; v1[3] = v1[3] * cs[3][2] + sg * p1[3] * cs[3][3];
                        }
                    }
                    if (GRP == 4) {
                        if (ropeI_on) {
                            f32x4 p0, p1;
#pragma unroll
                            for (int e = 0; e < 4; ++e) { p0[e] = __shfl_xor(v0[e], 16); p1[e] = __shfl_xor(v1[e], 16); }
                            if (fq < 2) { const float sg = fq == 0 ? -1.f : 1.f;
                                v0[0] = v0[0] * cs[0][0] + sg * p0[0] * cs[0][1]; v0[1] = v0[1] * cs[0][2] + sg * p0[1] * cs[0][3];
                                v0[2] = v0[2] * cs[1][0] + sg * p0[2] * cs[1][1]; v0[3] = v0[3] * cs[1][2] + sg * p0[3] * cs[1][3];
                                v1[0] = v1[0] * cs[2][0] + sg * p1[0] * cs[2][1]; v1[1] = v1[1] * cs[2][2] + sg * p1[1] * cs[2][3];
                                v1[2] = v1[2] * cs[3][0] + sg * p1[2] * cs[3][1]; v1[3] = v1[3] * cs[3][2] + sg * p1[3] * cs[3][3]; }
                        }
                    }
                    if (GRP == 0) { *(GAS v4u*)(Qb + (size_t)row * WA + gcol) = pack8(v0 * (SM_SCALE * LOG2E), v1 * (SM_SCALE * LOG2E)); }
                    if (GRP == 1) { float* op = out + O_KP + (size_t)row * WA + gcol; *(GAS f32x4*)op = v0; *(GAS f32x4*)(op + 4) = v1; *(GAS v4u*)(Kb + (size_t)row * WA + gcol) = pack8(v0, v1); }
                    if (GRP == 2) { float* op = out + O_VP + (size_t)row * WA + gcol; *(GAS f32x4*)op = v0; *(GAS f32x4*)(op + 4) = v1; *(GAS v4u*)(Vb + (size_t)row * WA + gcol) = pack8(v0, v1); }
                    if (GRP == 4) { *(GAS v4u*)(IQb + (size_t)row * WA + gcol) = pack8(v0 * 0.125f, v1 * 0.125f); }
                    if (GRP == 3 || GRP == 8 || GRP == 10 || GRP == 5) {
#pragma unroll
                        for (int e = 0; e < 4; ++e) { v0[e] = fsilu(v0[e]); v1[e] = fsilu(v1[e]); }
                        if (GRP == 3) *(GAS v4u*)(GA + (size_t)row * WA + gcol) = pack8(v0, v1);
                        if (GRP == 8) *(GAS v4u*)(GB + (size_t)row * WB + gcol) = pack8(v0, v1);
                        if (GRP == 10) *(GAS v4u*)(GM + (size_t)row * WM + gcol) = pack8(v0, v1);
                        if (GRP == 5) { float* op = HQ + (size_t)row * WB + gcol; *(GAS f32x4*)op = v0; *(GAS f32x4*)(op + 4) = v1; }
                    }
                    if (GRP == 6) { const f32x4 l0 = *(const GAS f32x4*)(lbv + gcol), l1 = *(const GAS f32x4*)(lbv + gcol + 4);
#pragma unroll
                        for (int e = 0; e < 4; ++e) { v0[e] = flog(l0[e] + (1.f - l0[e]) * fsigmoid(v0[e])); v1[e] = flog(l1[e] + (1.f - l1[e]) * fsigmoid(v1[e])); }
                        float* op = HG + (size_t)row * WB + gcol; *(GAS f32x4*)op = v0; *(GAS f32x4*)(op + 4) = v1; }
                    if (GRP == 7) *(GAS v4u*)(HV + (size_t)row * WB + gcol) = pack8(v0, v1);
                    if (GRP == 9) *(GAS v4u*)(MQb + (size_t)row * WM + gcol) = pack8(v0 * (SM_SCALE * LOG2E), v1 * (SM_SCALE * LOG2E));
                }
            }
    }
    __device__ __forceinline__ void operator()(const pg8::f32x4 (&acc)[2][2][4][2], const pg8::Unit& u, int wr, int wc, int fr, int fq) const {
        const int pn = u.pn;
        if (pn < 4) run<0>(acc, u, wr, wc, fr, fq);
        else if (pn < 8) run<1>(acc, u, wr, wc, fr, fq);
        else if (pn < 12) run<2>(acc, u, wr, wc, fr, fq);
        else if (pn < 16) run<3>(acc, u, wr, wc, fr, fq);
        else if (pn < 20) run<4>(acc, u, wr, wc, fr, fq);
        else if (pn < 22) run<5>(acc, u, wr, wc, fr, fq);
        else if (pn < 24) run<6>(acc, u, wr, wc, fr, fq);
        else if (pn < 26) run<7>(acc, u, wr, wc, fr, fq);
        else if (pn < 28) run<8>(acc, u, wr, wc, fr, fq);
        else if (pn < 30) run<9>(acc, u, wr, wc, fr, fq);
        else run<10>(acc, u, wr, wc, fr, fq);
    }
};

template <int MT, int NT, int PF = 1>
__device__ __forceinline__ void small_gemm(const bf16* A, const bf16* Bt, int K, int ld, int m0, int n0, int lane, f32x4 (&acc)[MT][NT]) {
    const int fr = lane & 15, fq = lane >> 4;
    const GAS bf16x8* ap[MT]; const GAS bf16x8* bp[NT];
#pragma unroll
    for (int i = 0; i < MT; ++i) ap[i] = (const GAS bf16x8*)(A + (size_t)(m0 + 16 * i + fr) * ld + 8 * fq);
#pragma unroll
    for (int j = 0; j < NT; ++j) bp[j] = (const GAS bf16x8*)(Bt + (size_t)(n0 + 16 * j + fr) * ld + 8 * fq);
#pragma unroll
    for (int i = 0; i < MT; ++i)
#pragma unroll
        for (int j = 0; j < NT; ++j) acc[i][j] = (f32x4){0.f, 0.f, 0.f, 0.f};
    bf16x8 a[PF][MT], b[PF][NT];
#pragma unroll
    for (int p = 0; p < PF; ++p) {
#pragma unroll
        for (int i = 0; i < MT; ++i) a[p][i] = ap[i][4 * p];
#pragma unroll
        for (int j = 0; j < NT; ++j) b[p][j] = bp[j][4 * p];
    }
    const int nb = K / (32 * PF);
    for (int kb = 0; kb < nb; ++kb) {
        bf16x8 an[PF][MT], bn[PF][NT];
        const int kn = (kb + 1 < nb) ? (kb + 1) * 4 * PF : 0;
#pragma unroll
        for (int p = 0; p < PF; ++p) {
#pragma unroll
            for (int i = 0; i < MT; ++i) an[p][i] = ap[i][kn + 4 * p];
#pragma unroll
            for (int j = 0; j < NT; ++j) bn[p][j] = bp[j][kn + 4 * p];
        }
#pragma unroll
        for (int p = 0; p < PF; ++p)
#pragma unroll
            for (int i = 0; i < MT; ++i)
#pragma unroll
                for (int j = 0; j < NT; ++j) acc[i][j] = __builtin_amdgcn_mfma_f32_16x16x32_bf16(a[p][i], b[p][j], acc[i][j], 0, 0, 0);
#pragma unroll
        for (int p = 0; p < PF; ++p) {
#pragma unroll
            for (int i = 0; i < MT; ++i) a[p][i] = an[p][i];
#pragma unroll
            for (int j = 0; j < NT; ++j) b[p][j] = bn[p][j];
        }
    }
}

__device__ __forceinline__ void p1_small(const Args& A, int G) {
    const int tid = threadIdx.x, lane = tid & 63, wave = tid >> 6, fr = lane & 15, fq = lane >> 4;
    unsigned char* ws = A.ws;
    const bf16* Xb = (const bf16*)(ws + WS_XB); const bf16* Wmain = (const bf16*)(ws + WS_WMAIN); const bf16* Wikw = (const bf16*)(ws + WS_WIKW);
    const bf16* Wmkv = (const bf16*)(ws + WS_WMKV); const bf16* MEMb = (const bf16*)(ws + WS_MEMB);
    const float2* ropeI = (const float2*)(ws + WS_ROPEI);
    bf16* IKb = (bf16*)(ws + WS_IKB); float* IW = (float*)(ws + WS_IW); bf16* MKb = (bf16*)(ws + WS_MKB); bf16* MVb = (bf16*)(ws + WS_MVB); float* Zs = (float*)(ws + WS_ZS);
#if HYBRID
    float* Z = (float*)(ws + WS_Z);
#endif
    const int gw = wave * G + blockIdx.x, NGW = G * NWAVES;
    constexpr int U_IKW = MR / 32, U_SMP = NMAIN / 32, U_MKV = 32 * 32;
    for (int u = gw; u < U_IKW + U_SMP + U_MKV; u += NGW) {
        if (u < U_IKW) {
            f32x4 acc[2][5];
            small_gemm<2, 5, 2>(Xb, Wikw, DM, DM, u * 32, 0, lane, acc);
#pragma unroll
            for (int i = 0; i < 2; ++i)
#pragma unroll
                for (int e = 0; e < 4; ++e) {
                    const int row = u * 32 + 16 * i + 4 * fq + e;
                    const int pidx = row < MP ? (row & (T - 1)) : T + ((row - MP) & (ST - 1));
                    float* ikout = row < MP ? A.out + O_IKP + (size_t)row * DI : A.out + O_IKS + (size_t)(row - MP) * DI;
#pragma unroll
                    for (int j = 0; j < 4; ++j) {
                        float v = acc[i][j][e];
#if HYBRID
                        Z[(size_t)row * NIN + C_IK + 16 * j + fr] = v;
#endif
                        if (row >= MP) Zs[(size_t)(row - MP) * NIN + C_IK + 16 * j + fr] = v;
                        if (j == 0) { const float p = __shfl_xor(v, 8); const float2 cs = ropeI[(size_t)pidx * 8 + (fr & 7)]; v = v * cs.x + (fr < 8 ? -p : p) * cs.y; }
                        ikout[16 * j + fr] = v;
                        IKb[(size_t)row * DI + 16 * j + fr] = (bf16)f2bf(v);
                    }
                    { const float v = acc[i][4][e];
#if HYBRID
                      Z[(size_t)row * NIN + C_IW + fr] = v;
#endif
                      if (row >= MP) Zs[(size_t)(row - MP) * NIN + C_IW + fr] = v;
                      IW[(size_t)row * HI + fr] = v * 0.25f; }
                }
        } else if (u < U_IKW + U_SMP) {
            const int n0 = (u - U_IKW) * 32;
            f32x4 acc[4][2];
            small_gemm<4, 2, 2>(Xb, Wmain, DM, DM, MP, n0, lane, acc);
#pragma unroll
            for (int i = 0; i < 4; ++i)
#pragma unroll
                for (int j = 0; j < 2; ++j)
#pragma unroll
                    for (int e = 0; e < 4; ++e) { const int r = 16 * i + 4 * fq + e, oc = orig_col(n0 + 16 * j + fr);
                        Zs[(size_t)r * NIN + oc] = acc[i][j][e];
#if HYBRID
                        Z[(size_t)(MP + r) * NIN + oc] = acc[i][j][e];
#endif
                    }
        } else {
            const int t = u - U_IKW - U_SMP, m0 = (t >> 5) * 32, n0 = (t & 31) * 32;
            f32x4 acc[2][2];
            small_gemm<2, 2, 4>(MEMb, Wmkv, DM, DM, m0, n0, lane, acc);
#pragma unroll
            for (int i = 0; i < 2; ++i)
#pragma unroll
                for (int j = 0; j < 2; ++j)
#pragma unroll
                    for (int e = 0; e < 4; ++e) { const int r = m0 + 16 * i + 4 * fq + e, c = n0 + 16 * j + fr; const float v = acc[i][j][e];
                        if (c < WM) { A.out[O_MKP + (size_t)r * WM + c] = v; MKb[(size_t)r * WM + c] = (bf16)f2bf(v); }
                        else { A.out[O_MVP + (size_t)r * WM + (c - WM)] = v; MVb[(size_t)r * WM + (c - WM)] = (bf16)f2bf(v); } }
        }
    }
}

struct EpiOut {
    static constexpr bool PERM = true, AFTER_DRAIN = false;
    bf16* y;
    __device__ __forceinline__ void operator()(const pg8::f32x4 (&acc)[2][2][4][2], const pg8::Unit& u, int wr, int wc, int fr, int fq) const {
        const int col0 = u.pn * 256 + wc * 32 + 8 * fq, row0 = u.pm * 256 + wr * 64 + fr;
#pragma unroll
        for (int ai = 0; ai < 2; ++ai)
#pragma unroll
            for (int m = 0; m < 4; ++m) {
                const size_t ro = (size_t)(row0 + ai * 128 + m * 16) * DM;
#pragma unroll
                for (int bj = 0; bj < 2; ++bj) *(GAS v4u*)(y + ro + col0 + bj * 128) = pack8(acc[ai][bj][m][0], acc[ai][bj][m][1]);
            }
    }
};
__device__ __forceinline__ void p5_small(const Args& A, LAS unsigned char* lds, int G) {
    const int tid = threadIdx.x, lane = tid & 63, wave = tid >> 6;
    const bf16* CATb = (const bf16*)(A.ws + WS_CATB); const bf16* Wout = (const bf16*)(A.ws + WS_WOUT);
    LAS float* part = (LAS float*)(lds + RING_OFF);
    for (int u = (G >= 128 ? (int)blockIdx.x - 64 : (int)blockIdx.x); u < DM / 32; u += G) { if (u < 0) continue;
        f32x4 acc[4][2];
        small_gemm<4, 2, 2>(CATb + wave * 256, Wout + wave * 256, 256, DM, MP, u * 32, lane, acc);
#pragma unroll
        for (int i = 0; i < 4; ++i)
#pragma unroll
            for (int j = 0; j < 2; ++j) *(LAS f32x4*)(part + ((wave * 8 + i * 2 + j) * 64 + lane) * 4) = acc[i][j];
        LDS_WAIT(); __syncthreads();
        { const int tl = tid >> 6, ln = tid & 63, i = tl >> 1, j = tl & 1, fr = ln & 15, fq = ln >> 4;
          f32x4 sum = (f32x4){0.f, 0.f, 0.f, 0.f};
#pragma unroll
          for (int w = 0; w < 8; ++w) sum = sum + *(const LAS f32x4*)(part + ((w * 8 + tl) * 64 + ln) * 4);
#pragma unroll
          for (int e = 0; e < 4; ++e) ((bf16*)(A.ws + WS_YMIX))[(size_t)(MP + 16 * i + 4 * fq + e) * DM + u * 32 + 16 * j + fr] = (bf16)f2bf(sum[e]); }
        __syncthreads();
    }
}
__device__ __forceinline__ float wave_sum(float v) {
    v += __builtin_bit_cast(float, __builtin_amdgcn_update_dpp(0, __builtin_bit_cast(int, v), 0xB1, 0xf, 0xf, false));
    v += __builtin_bit_cast(float, __builtin_amdgcn_update_dpp(0, __builtin_bit_cast(int, v), 0x4E, 0xf, 0xf, false));
    v += __builtin_bit_cast(float, __builtin_amdgcn_update_dpp(0, __builtin_bit_cast(int, v), 0x141, 0xf, 0xf, false));
    v += __builtin_bit_cast(float, __builtin_amdgcn_update_dpp(0, __builtin_bit_cast(int, v), 0x140, 0xf, 0xf, false));
    const int vi = __builtin_bit_cast(int, v);
    const float r0 = __builtin_bit_cast(float, __builtin_amdgcn_readlane(vi, 0)), r1 = __builtin_bit_cast(float, __builtin_amdgcn_readlane(vi, 16)), r2 = __builtin_bit_cast(float, __builtin_amdgcn_readlane(vi, 32)), r3 = __builtin_bit_cast(float, __builtin_amdgcn_readlane(vi, 48));
    return (r0 + r1) + (r2 + r3);
}
__device__ __forceinline__ void p6_layernorm(const Args& A, int G) {
    const int tid = threadIdx.x, lane = tid & 63, wave = tid >> 6;
    const int gw = blockIdx.x * NWAVES + wave, NGW = G * NWAVES;
    const bf16* YM = (const bf16*)(A.ws + WS_YMIX);
    for (int rp = gw; rp < MR / 2; rp += NGW) {
        f32x4 v[2][8]; float s[2];
#pragma unroll
        for (int h = 0; h < 2; ++h) {
            const int row = 2 * rp + h;
            const GAS f32x4* xp = (const GAS f32x4*)(row < MP ? A.x_prompt + (size_t)row * DM : A.x_sample + (size_t)(row - MP) * DM) + lane;
            const GAS u32x2* yp = (const GAS u32x2*)(YM + (size_t)row * DM) + lane;
            s[h] = 0.f;
#pragma unroll
            for (int j = 0; j < 8; ++j) { const u32x2 yy = yp[64 * j]; const f32x4 yv = (f32x4){__uint_as_float(yy.x << 16), __uint_as_float(yy.x & 0xffff0000u), __uint_as_float(yy.y << 16), __uint_as_float(yy.y & 0xffff0000u)};
                v[h][j] = xp[64 * j] * ALPHA + yv; s[h] += (v[h][j][0] + v[h][j][1]) + (v[h][j][2] + v[h][j][3]); }
        }
#pragma unroll
        for (int h = 0; h < 2; ++h) {
            const int row = 2 * rp + h;
            const float mean = wave_sum(s[h]) * (1.f / DM); float q = 0.f;
#pragma unroll
            for (int j = 0; j < 8; ++j) { v[h][j] = v[h][j] - mean; q += (v[h][j][0] * v[h][j][0] + v[h][j][1] * v[h][j][1]) + (v[h][j][2] * v[h][j][2] + v[h][j][3] * v[h][j][3]); }
            const float rstd = rsqrtf(wave_sum(q) * (1.f / DM) + LN_EPS);
            GAS f32x4* p = (GAS f32x4*)(A.out + O_YP + (size_t)row * DM) + lane;
#pragma unroll
            for (int j = 0; j < 8; ++j) { const f32x4 g = *(const GAS f32x4*)(A.ln_g + 4 * lane + 256 * j), bb = *(const GAS f32x4*)(A.ln_b + 4 * lane + 256 * j); p[64 * j] = v[h][j] * rstd * g + bb; }
        }
    }
}

typedef float f32x16 __attribute__((ext_vector_type(16)));
__device__ __forceinline__ unsigned off_b(unsigned row, unsigned ch) { return 256u * row + 16u * (ch ^ (((row & 3u) << 2) | ((row >> 2) & 3u))); }
#if !SEL_HIST
__device__ __forceinline__ void select_row(const float (&x)[32], int n, int lane, LAS float* scr, float& thr_v, int& thr_s) {
    const int NI = (n + 63) >> 6;
    float mn = INFINITY, mx = -INFINITY;
#pragma unroll
    for (int i = 0; i < 32; ++i) if (i < NI) { const bool ok = i * 64 + lane < n; mn = fminf(mn, ok ? x[i] : INFINITY); mx = fmaxf(mx, x[i]); }
#pragma unroll
    for (int o = 1; o < 64; o <<= 1) { mn = fminf(mn, __shfl_xor(mn, o)); mx = fmaxf(mx, __shfl_xor(mx, o)); }
    float lo = mn, hi = INFINITY; int c_lo = n, c_hi = 0;
    for (int it = 0; it < 96 && c_lo - c_hi > 64; ++it) {
        const float hf = (hi == INFINITY) ? mx : hi;
        const float mid = lo + 0.5f * (hf - lo);
        if (!(mid > lo) || (hi != INFINITY && !(mid < hi))) break;
        int c = 0;
#pragma unroll
        for (int i = 0; i < 32; ++i) if (i < NI) c += __popcll(__ballot(x[i] >= mid));
        if (c >= TOPK) { lo = mid; c_lo = c; } else { hi = mid; c_hi = c; }
    }
    const int m = c_lo - c_hi, r = TOPK - c_hi;
    int base = 0;
#pragma unroll
    for (int i = 0; i < 32; ++i) if (i < NI) {
        const bool cand = x[i] >= lo && x[i] < hi;
        const unsigned long long bal = __ballot(cand);
        if (cand) { const int pos = base + __popcll(bal & ((1ull << lane) - 1ull)); if (pos < 128) { scr[2 * pos] = x[i]; scr[2 * pos + 1] = __int_as_float(i * 64 + lane); } }
        base += __popcll(bal);
    }
    LDS_WAIT(); asm volatile("" ::: "memory");
    thr_v = lo; thr_s = 0x7fffffff;
    if (m <= 128) {
        float fv = 0.f; int fs = -1;
        for (int c0 = 0; c0 < m; c0 += 64) {
            const int cme = c0 + lane; const bool have = cme < m;
            const float v = have ? scr[2 * cme] : 0.f; const int sidx = have ? __float_as_int(scr[2 * cme + 1]) : 0;
            int rank = 0;
            for (int j = 0; j < m; ++j) { const float ov = scr[2 * j]; const int os = __float_as_int(scr[2 * j + 1]); rank += (ov > v || (ov == v && os < sidx)) ? 1 : 0; }
            const unsigned long long hit = __ballot(have && rank == r - 1);
            if (hit) { const int src = __ffsll((long long)hit) - 1; fv = __shfl(v, src); fs = __shfl(sidx, src); }
        }
        if (fs >= 0) { thr_v = fv; thr_s = fs; }
    }
    LDS_WAIT(); asm volatile("" ::: "memory");
}
#else
#define DPP_F(v, ctrl) __builtin_bit_cast(float, __builtin_amdgcn_update_dpp(0, __builtin_bit_cast(int, (v)), (ctrl), 0xf, 0xf, false))
__device__ __forceinline__ float wave_min_all(float v) {
    v = fminf(v, DPP_F(v, 0xB1)); v = fminf(v, DPP_F(v, 0x4E)); v = fminf(v, DPP_F(v, 0x141)); v = fminf(v, DPP_F(v, 0x140));
    const int vi = __builtin_bit_cast(int, v);
    const float r0 = __builtin_bit_cast(float, __builtin_amdgcn_readlane(vi, 0)), r1 = __builtin_bit_cast(float, __builtin_amdgcn_readlane(vi, 16)), r2 = __builtin_bit_cast(float, __builtin_amdgcn_readlane(vi, 32)), r3 = __builtin_bit_cast(float, __builtin_amdgcn_readlane(vi, 48));
    return fminf(fminf(r0, r1), fminf(r2, r3));
}
__device__ __forceinline__ float wave_max_all(float v) {
    v = fmaxf(v, DPP_F(v, 0xB1)); v = fmaxf(v, DPP_F(v, 0x4E)); v = fmaxf(v, DPP_F(v, 0x141)); v = fmaxf(v, DPP_F(v, 0x140));
    const int vi = __builtin_bit_cast(int, v);
    const float r0 = __builtin_bit_cast(float, __builtin_amdgcn_readlane(vi, 0)), r1 = __builtin_bit_cast(float, __builtin_amdgcn_readlane(vi, 16)), r2 = __builtin_bit_cast(float, __builtin_amdgcn_readlane(vi, 32)), r3 = __builtin_bit_cast(float, __builtin_amdgcn_readlane(vi, 48));
    return fmaxf(fmaxf(r0, r1), fmaxf(r2, r3));
}
__device__ __forceinline__ unsigned wave_prefix_incl(unsigned v, int lane) {
    v += (unsigned)__builtin_amdgcn_update_dpp(0, (int)v, 0x111, 0xf, 0xf, true);
    v += (unsigned)__builtin_amdgcn_update_dpp(0, (int)v, 0x112, 0xf, 0xf, true);
    v += (unsigned)__builtin_amdgcn_update_dpp(0, (int)v, 0x114, 0xf, 0xf, true);
    v += (unsigned)__builtin_amdgcn_update_dpp(0, (int)v, 0x118, 0xf, 0xf, true);
    const unsigned r0 = (unsigned)__builtin_amdgcn_readlane((int)v, 15), r1 = (unsigned)__builtin_amdgcn_readlane((int)v, 31), r2 = (unsigned)__builtin_amdgcn_readlane((int)v, 47);
    return v + (lane >= 16 ? r0 : 0u) + (lane >= 32 ? r1 : 0u) + (lane >= 48 ? r2 : 0u);
}
__device__ __forceinline__ void select_row(const float (&x)[32], int n, int lane, LAS float* scr, float& thr_v, int& thr_s) {
    LAS unsigned* hist = (LAS unsigned*)scr;
    unsigned act = 0u;
#pragma unroll
    for (int i = 0; i < 32; ++i) act |= (i * 64 + lane < n) ? (1u << i) : 0u;
    int need = TOPK;
    int m = n;
    for (int pass = 0; pass < 8 && m > 64; ++pass) {
        float mn = INFINITY, mx = -INFINITY;
#pragma unroll
        for (int i = 0; i < 32; ++i) { const bool on = (act >> i) & 1u; mn = fminf(mn, on ? x[i] : INFINITY); mx = fmaxf(mx, on ? x[i] : -INFINITY); }
        mn = wave_min_all(mn); mx = wave_max_all(mx);
        if (!(mx > mn)) break;
        const float scale = 255.f / (mx - mn);
        *(LAS v4u*)(hist + lane * 4) = (v4u){0u, 0u, 0u, 0u};
        LDS_WAIT(); asm volatile("" ::: "memory");
#pragma unroll
        for (int i = 0; i < 32; ++i) { if ((act >> i) & 1u) { int bn = (int)((x[i] - mn) * scale); bn = bn > 255 ? 255 : bn; __hip_atomic_fetch_add(hist + bn, 1u, __ATOMIC_RELAXED, __HIP_MEMORY_SCOPE_WAVEFRONT); } }
        LDS_WAIT(); asm volatile("" ::: "memory");
        const v4u hc = *(const LAS v4u*)(hist + (63 - lane) * 4);
        const unsigned tot4 = (hc.x + hc.y) + (hc.z + hc.w);
        const unsigned above_lane = wave_prefix_incl(tot4, lane) - tot4;
        const unsigned a3 = above_lane, a2 = a3 + hc.w, a1 = a2 + hc.z, a0 = a1 + hc.y;
        int jb = -1; unsigned ab = 0u, cb = 0u;
        if (a3 < (unsigned)need && (unsigned)need <= a3 + hc.w) { jb = 3; ab = a3; cb = hc.w; }
        else if (a2 < (unsigned)need && (unsigned)need <= a2 + hc.z) { jb = 2; ab = a2; cb = hc.z; }
        else if (a1 < (unsigned)need && (unsigned)need <= a1 + hc.y) { jb = 1; ab = a1; cb = hc.y; }
        else if (a0 < (unsigned)need && (unsigned)need <= a0 + hc.x) { jb = 0; ab = a0; cb = hc.x; }
        const unsigned long long who = __ballot(jb >= 0);
        const int src = __ffsll((long long)who) - 1;
        const int bstar = __builtin_amdgcn_readlane((63 - lane) * 4 + jb, src); const unsigned above = (unsigned)__builtin_amdgcn_readlane((int)ab, src);
        const unsigned cnt = (unsigned)__builtin_amdgcn_readlane((int)cb, src);
#pragma unroll
        for (int i = 0; i < 32; ++i) { const float xv = ((act >> i) & 1u) ? x[i] : mn; int bn = (int)((xv - mn) * scale); bn = bn > 255 ? 255 : bn; act &= (bn == bstar) ? 0xffffffffu : ~(1u << i); }
        need -= (int)above; m = (int)cnt;
    }
    int base = 0;
#pragma unroll
    for (int i = 0; i < 32; ++i) {
        const bool cand = (act >> i) & 1u;
        const unsigned long long bal = __ballot(cand);
        if (cand) { const int pos = base + __popcll(bal & ((1ull << lane) - 1ull)); if (pos < 128) { scr[2 * pos] = x[i]; scr[2 * pos + 1] = __int_as_float(i * 64 + lane); } }
        base += __popcll(bal);
    }
    LDS_WAIT(); asm volatile("" ::: "memory");
    thr_v = scr[0]; thr_s = 0x7fffffff;
    if (m <= 128) {
        float fv = 0.f; int fs = -1;
        for (int c0 = 0; c0 < m; c0 += 64) {
            const int cme = c0 + lane; const bool have = cme < m;
            const float v = have ? scr[2 * cme] : 0.f; const int sidx = have ? __float_as_int(scr[2 * cme + 1]) : 0;
            int rank = 0;
            for (int j = 0; j < m; ++j) { const float ov = scr[2 * j]; const int os = __float_as_int(scr[2 * j + 1]); rank += (ov > v || (ov == v && os < sidx)) ? 1 : 0; }
            const unsigned long long hit = __ballot(have && rank == need - 1);
            if (hit) { const int src = __ffsll((long long)hit) - 1; fv = __builtin_bit_cast(float, __builtin_amdgcn_readlane(__builtin_bit_cast(int, v), src)); fs = __builtin_amdgcn_readlane(sidx, src); }
        }
        if (fs >= 0) { thr_v = fv; thr_s = fs; }
    }
    LDS_WAIT(); asm volatile("" ::: "memory");
}
#endif
#if PROBE == 2
#define ISUB(k) do { if (blockIdx.x == PROBE_BLK && threadIdx.x == 0) ((unsigned long long*)(A.ws + WS_CTL + 800000))[16 + (k)] = __builtin_amdgcn_s_memrealtime(); } while (0)
#else
#define ISUB(k) do { } while (0)
#endif
__device__ __forceinline__ void p2_indexer(const Args& A, LAS unsigned char* lds, int unit) {
    const int tid = threadIdx.x, lane = tid & 63, wave = tid >> 6, r32 = lane & 31, hlf = lane >> 5;
    const bf16* IQb = (const bf16*)(A.ws + WS_IQB); const bf16* IKb = (const bf16*)(A.ws + WS_IKB); const float* IW = (const float*)(A.ws + WS_IW);
    unsigned* MASK = (unsigned*)(A.ws + WS_MASK);
    const int b = unit >> 6, p = unit & 63;
    LAS float* S = (LAS float*)(lds + RING_OFF);
    LAS unsigned char* kst = lds + AUX_OFF;
    LAS float* scr = (LAS float*)(lds + AUX_OFF + 16384 + wave * 1024);
    for (int half = 0; half < 2; ++half) {
        const int ti = half == 0 ? p : 127 - p, t0 = 16 * ti, nk = t0 + 16, n64 = (nk + 63) >> 6;
        const int qa = (r32 >> 2) & 1, ha = (r32 & 3) + 4 * (r32 >> 3);
        bf16x8 aq[4];
#pragma unroll
        for (int ks = 0; ks < 4; ++ks) aq[ks] = *(const GAS bf16x8*)(IQb + (size_t)(b * T + t0 + 2 * wave + qa) * WA + ha * DI + 16 * ks + 8 * hlf);
        float wv[16];
        { const GAS f32x4* wp = (const GAS f32x4*)(IW + (size_t)(b * T + t0 + 2 * wave + hlf) * HI);
#pragma unroll
          for (int q = 0; q < 4; ++q) { const f32x4 w4 = wp[q]; wv[4 * q] = w4[0]; wv[4 * q + 1] = w4[1]; wv[4 * q + 2] = w4[2]; wv[4 * q + 3] = w4[3]; } }
        const int tq = t0 + 2 * wave + hlf;
        const int srow = tid >> 3, sch = tid & 7;
        const GAS v4u* ksrc = (const GAS v4u*)(IKb + (size_t)(b * T) * DI) + (size_t)srow * 8 + (sch ^ ((srow >> 1) & 7));
        v4u stg = ksrc[0];
        *(LAS v4u*)(kst + tid * 16) = stg;
        v4u s1 = ksrc[(size_t)(1 < n64 ? 1 : 0) * 512], s2 = ksrc[(size_t)(2 < n64 ? 2 : 0) * 512], s3 = ksrc[(size_t)(3 < n64 ? 3 : 0) * 512];
        LDS_WAIT(); __syncthreads();
        for (int kt = 0; kt < n64; ++kt) {
            const LAS unsigned char* kb = kst + (kt & 1) * 8192;
            bf16x8 kf[2][4];
#pragma unroll
            for (int g = 0; g < 2; ++g)
#pragma unroll
                for (int ks = 0; ks < 4; ++ks) { const int krow = 32 * g + r32; kf[g][ks] = *(const LAS bf16x8*)(kb + krow * 128 + (((2 * ks + hlf) ^ ((krow >> 1) & 7)) << 4)); }
            __builtin_amdgcn_sched_barrier(0);
#pragma unroll
            for (int g = 0; g < 2; ++g) {
                f32x16 C;
#pragma unroll
                for (int i = 0; i < 16; ++i) C[i] = 0.f;
#pragma unroll
                for (int ks = 0; ks < 4; ++ks) C = __builtin_amdgcn_mfma_f32_32x32x16_bf16(aq[ks], kf[g][ks], C, 0, 0, 0);
                float sc = 0.f;
#pragma unroll
                for (int i = 0; i < 16; ++i) sc = fmaf(wv[i], fmaxf(C[i], 0.f), sc);
                const int key = 64 * kt + 32 * g + r32;
                S[(2 * wave + hlf) * 2048 + key] = key <= tq ? sc : -INFINITY;
            }
            if (kt + 1 < n64) *(LAS v4u*)(kst + ((kt + 1) & 1) * 8192 + tid * 16) = s1;
            s1 = s2; s2 = s3;
            if (kt + 4 < n64) s3 = ksrc[(size_t)(kt + 4) * 512];
            LDS_WAIT(); __syncthreads();
        }
        ISUB(20 + 2 * half);
        for (int qi = 0; qi < 2; ++qi) {
            const int t = t0 + 2 * wave + qi, n = t + 1, NI = (n + 63) >> 6;
            unsigned long long mk = 0ull;
            if (n <= TOPK) {
#pragma unroll
                for (int i = 0; i < 32; ++i) { const unsigned long long bal = __ballot(i * 64 + lane <= t); if (lane == i) mk = bal; }
            } else {
                float x[32];
#pragma unroll
                for (int i = 0; i < 32; ++i) x[i] = (i * 64 + lane < n) ? S[(2 * wave + qi) * 2048 + i * 64 + lane] : -INFINITY;
                float thr_v; int thr_s;
                select_row(x, n, lane, scr, thr_v, thr_s);
#pragma unroll
                for (int i = 0; i < 32; ++i) { const int sidx = i * 64 + lane; const unsigned long long bal = __ballot(x[i] > thr_v || (x[i] == thr_v && sidx <= thr_s)); if (lane == i) mk = bal; }
            }
            if (lane < 32) *(GAS unsigned long long*)(MASK + (size_t)(b * T + t) * 64 + 2 * lane) = mk;
        }
        ISUB(21 + 2 * half);
    }
    __syncthreads();
}

struct AttnUnit {
    const bf16* Q; int ldq;
    const bf16* K; const bf16* V; int ldkv;
    const unsigned* mask;
    int qrow0, qrow1;
    int ntile0, ntile1;
    int pos0, pos1;
    bf16* cat; int ldc;
    const bf16* gate; int ldg;
    float* of32; int ldo;
};
__device__ __forceinline__ void attn_unit(const AttnUnit& U, LAS unsigned char* lds) {
    int tid_l = threadIdx.x; asm volatile("" : "+v"(tid_l));
    const int tid = tid_l, lane = tid & 63, wave = __builtin_amdgcn_readfirstlane(tid >> 6), r32 = lane & 31, hlf = lane >> 5, wg = wave >> 2, ww = wave & 3;
    const int myrow = (wg ? U.qrow1 : U.qrow0) + 32 * ww + r32;
    int ntw = wg ? U.ntile1 : U.ntile0; { const int lastpos = (wg ? U.pos1 : U.pos0) + 32 * ww + 31; const int lim = (lastpos >> 7) + 1; ntw = lim < ntw ? lim : ntw; }
    const int maxt = U.ntile0 > U.ntile1 ? U.ntile0 : U.ntile1;
    bf16x8 qf[8];
#pragma unroll
    for (int ks = 0; ks < 8; ++ks) qf[ks] = *(const GAS bf16x8*)(U.Q + (size_t)myrow * U.ldq + 16 * ks + 8 * hlf);
    f32x16 O[4];
#pragma unroll
    for (int c = 0; c < 4; ++c)
#pragma unroll
        for (int i = 0; i < 16; ++i) O[c][i] = 0.f;
    float m_run = -1e30f, l_run = 0.f;
    unsigned gofs[4];
#pragma unroll
    for (int i = 0; i < 4; ++i) { const unsigned row = 16u * wave + 4u * i + (lane >> 4), chs = lane & 15u, f = ((row & 3u) << 2) | ((row >> 2) & 3u); gofs[i] = row * (unsigned)U.ldkv + ((chs ^ f) << 3); }
    const size_t tstep = (size_t)128 * U.ldkv;
#define ATT_STAGE(kt_, st_) do { _Pragma("unroll") for (int _i = 0; _i < 4; ++_i) { \
        __builtin_amdgcn_global_load_lds((const unsigned*)(U.K + (size_t)(kt_) * tstep + gofs[_i]), (LAS unsigned*)(lds + RING_OFF + (st_) * 65536 + (wave * 4 + _i) * 1024), 16, 0, 0); \
        __builtin_amdgcn_global_load_lds((const unsigned*)(U.V + (size_t)(kt_) * tstep + gofs[_i]), (LAS unsigned*)(lds + RING_OFF + (st_) * 65536 + 32768 + (wave * 4 + _i) * 1024), 16, 0, 0); } } while (0)
    unsigned kofs[8];
#pragma unroll
    for (int ks = 0; ks < 8; ++ks) kofs[ks] = off_b(r32, 2 * ks + hlf);
    const unsigned blk = (lane >> 4) & 1, q4 = (lane & 15) >> 2, p4 = lane & 3;
    unsigned vb2[2], vx[4];
#pragma unroll
    for (int t = 0; t < 2; ++t) vb2[t] = 256u * (8 * t + 4 * hlf + q4) + 16u * ((2 * blk + (p4 >> 1)) ^ ((2 * t + hlf) & 3)) + 8u * (p4 & 1);
#pragma unroll
    for (int c = 0; c < 4; ++c) vx[c] = 64u * (c ^ q4);
    v4u mnext = (v4u){0xffffffffu, 0xffffffffu, 0xffffffffu, 0xffffffffu};
    if (U.mask) mnext = *(const GAS v4u*)(U.mask + (size_t)myrow * 64);
    ATT_STAGE(0, 0);
    asm volatile("s_waitcnt vmcnt(0) lgkmcnt(0)" ::: "memory"); __builtin_amdgcn_s_barrier(); asm volatile("" ::: "memory");
    typedef short s16x4 __attribute__((ext_vector_type(4)));
    for (int kt = 0; kt < maxt; ++kt) {
        const bool more = kt + 1 < maxt;
        v4u mcur = mnext;
        asm volatile("" : "+v"(mcur));
        if (more) {
            ATT_STAGE(kt + 1, (kt + 1) & 1);
            if (U.mask) mnext = *(const GAS v4u*)(U.mask + (size_t)myrow * 64 + 4 * (kt + 1));
        }
        if (kt < ntw) {
            const LAS unsigned char* kb = lds + RING_OFF + (kt & 1) * 65536; const unsigned vbase = (unsigned)(RING_OFF + (kt & 1) * 65536 + 32768);
#pragma unroll
            for (int g = 0; g < 4; ++g) {
                bf16x8 kf[8];
#pragma unroll
                for (int ks = 0; ks < 8; ++ks) kf[ks] = *(const LAS bf16x8*)(kb + 8192 * g + kofs[ks]);
                __builtin_amdgcn_sched_barrier(0);
                f32x16 C;
#pragma unroll
                for (int i = 0; i < 16; ++i) C[i] = 0.f;
#pragma unroll
                for (int ks = 0; ks < 8; ++ks) C = __builtin_amdgcn_mfma_f32_32x32x16_bf16(kf[ks], qf[ks], C, 0, 0, 0);
                __builtin_amdgcn_sched_barrier(0);
                s16x4 vlo[8], vhi[8];
#pragma unroll
                for (int c = 0; c < 4; ++c)
#pragma unroll
                    for (int s2 = 0; s2 < 2; ++s2) {
                        const unsigned a0 = vbase + vb2[0] + vx[c], a1 = vbase + vb2[1] + vx[c];
                        asm volatile("ds_read_b64_tr_b16 %0, %1 offset:%c2" : "=&v"(vlo[c * 2 + s2]) : "v"(a0), "i"(256 * (32 * g + 16 * s2)) : "memory");
                        asm volatile("ds_read_b64_tr_b16 %0, %1 offset:%c2" : "=&v"(vhi[c * 2 + s2]) : "v"(a1), "i"(256 * (32 * g + 16 * s2)) : "memory");
                    }
                __builtin_amdgcn_sched_barrier(0);
                const unsigned mw = (g == 0 ? mcur.x : g == 1 ? mcur.y : g == 2 ? mcur.z : mcur.w) >> (4 * hlf);
                float smax = -INFINITY;
#pragma unroll
                for (int i = 0; i < 16; ++i) { const int bit = (i & 3) + 8 * (i >> 2); C[i] = ((mw >> bit) & 1u) ? C[i] : -INFINITY; smax = fmaxf(smax, C[i]); }
                { auto rr = __builtin_amdgcn_permlane32_swap(__float_as_uint(smax), __float_as_uint(smax), false, false); smax = fmaxf(__uint_as_float(rr[0]), __uint_as_float(rr[1])); }
                const float m_new = fmaxf(m_run, smax);
                if (!__all(m_new == m_run)) {
                    const float alpha = __builtin_amdgcn_exp2f(m_run - m_new);
                    l_run *= alpha;
#pragma unroll
                    for (int c = 0; c < 4; ++c)
#pragma unroll
                        for (int i = 0; i < 16; ++i) O[c][i] *= alpha;
                    m_run = m_new;
                }
                float psum = 0.f;
#pragma unroll
                for (int i = 0; i < 16; ++i) { C[i] = __builtin_amdgcn_exp2f(C[i] - m_run); psum += C[i]; }
                l_run += psum;
                bf16x8 pf[2];
#pragma unroll
                for (int s2 = 0; s2 < 2; ++s2) { v4u w; w.x = pg8::cvt_pk_bf16(C[8 * s2 + 0], C[8 * s2 + 1]); w.y = pg8::cvt_pk_bf16(C[8 * s2 + 2], C[8 * s2 + 3]); w.z = pg8::cvt_pk_bf16(C[8 * s2 + 4], C[8 * s2 + 5]); w.w = pg8::cvt_pk_bf16(C[8 * s2 + 6], C[8 * s2 + 7]); pf[s2] = __builtin_bit_cast(bf16x8, w); }
                __builtin_amdgcn_sched_barrier(0);
                asm volatile("s_waitcnt lgkmcnt(0)" : "+v"(vlo[0]), "+v"(vlo[1]), "+v"(vlo[2]), "+v"(vlo[3]), "+v"(vlo[4]), "+v"(vlo[5]), "+v"(vlo[6]), "+v"(vlo[7]),
                                                       "+v"(vhi[0]), "+v"(vhi[1]), "+v"(vhi[2]), "+v"(vhi[3]), "+v"(vhi[4]), "+v"(vhi[5]), "+v"(vhi[6]), "+v"(vhi[7]) :: "memory");
                __builtin_amdgcn_sched_barrier(0);
#pragma unroll
                for (int c = 0; c < 4; ++c)
#pragma unroll
                    for (int s2 = 0; s2 < 2; ++s2) {
                        const s16x4 lo4 = vlo[c * 2 + s2], hi4 = vhi[c * 2 + s2];
                        const bf16x8 vf = (bf16x8){lo4[0], lo4[1], lo4[2], lo4[3], hi4[0], hi4[1], hi4[2], hi4[3]};
                        O[c] = __builtin_amdgcn_mfma_f32_32x32x16_bf16(vf, pf[s2], O[c], 0, 0, 0);
                    }
                __builtin_amdgcn_sched_barrier(0);
            }
        }
        asm volatile("s_waitcnt vmcnt(0) lgkmcnt(0)" ::: "memory"); __builtin_amdgcn_s_barrier(); asm volatile("" ::: "memory");
    }
#undef ATT_STAGE
    const float l_tot = l_run + __shfl_xor(l_run, 32);
    const float inv = 1.f / l_tot;
#pragma unroll
    for (int c = 0; c < 4; ++c)
#pragma unroll
        for (int g4 = 0; g4 < 4; ++g4) {
            const int d = 32 * c + 8 * g4 + 4 * hlf;
            f32x4 o; o[0] = O[c][4 * g4] * inv; o[1] = O[c][4 * g4 + 1] * inv; o[2] = O[c][4 * g4 + 2] * inv; o[3] = O[c][4 * g4 + 3] * inv;
            if (U.of32) *(GAS f32x4*)(U.of32 + (size_t)myrow * U.ldo + d) = o;
            const u32x2 gg = *(const GAS u32x2*)(U.gate + (size_t)myrow * U.ldg + d);
            const float g0 = __uint_as_float(gg.x << 16), g1 = __uint_as_float(gg.x & 0xffff0000u), g2 = __uint_as_float(gg.y << 16), g3 = __uint_as_float(gg.y & 0xffff0000u);
            u32x2 w; w.x = pg8::cvt_pk_bf16(o[0] * g0, o[1] * g1); w.y = pg8::cvt_pk_bf16(o[2] * g2, o[3] * g3);
            *(GAS u32x2*)(U.cat + (size_t)myrow * U.ldc + d) = w;
        }
    __syncthreads();
}
__device__ __forceinline__ void p3_dsa_attn(const Args& A, LAS unsigned char* lds, int unit, float* a_f32) {
    const int b = unit >> 6, h = (unit >> 3) & 7, j = unit & 7;
    AttnUnit U;
    U.Q = (const bf16*)(A.ws + WS_QB) + h * DH; U.ldq = WA;
    U.K = (const bf16*)(A.ws + WS_KB) + (size_t)(b * T) * WA + h * DH; U.V = (const bf16*)(A.ws + WS_VB) + (size_t)(b * T) * WA + h * DH; U.ldkv = WA;
    U.mask = (const unsigned*)(A.ws + WS_MASK);
    U.qrow0 = b * T + 128 * j; U.qrow1 = b * T + 128 * (15 - j);
    U.ntile0 = j + 1; U.ntile1 = 16 - j;
    U.pos0 = 128 * j; U.pos1 = 128 * (15 - j);
    U.cat = (bf16*)(A.ws + WS_CATB) + h * DH; U.ldc = DM;
    U.gate = (const bf16*)(A.ws + WS_GA) + h * DH; U.ldg = WA;
    U.of32 = a_f32 ? a_f32 + h * DH : nullptr; U.ldo = WA;
    attn_unit(U, lds);
}

__device__ __forceinline__ void p2_memattn(const Args& A, LAS unsigned char* lds, int unit, float* m_f32) {
    const int b = unit >> 5, hm = (unit >> 3) & 3, jq = unit & 7;
    AttnUnit U;
    U.Q = (const bf16*)(A.ws + WS_MQB) + hm * DH; U.ldq = WM;
    U.K = (const bf16*)(A.ws + WS_MKB) + (size_t)(b * NMEM) * WM + hm * DH; U.V = (const bf16*)(A.ws + WS_MVB) + (size_t)(b * NMEM) * WM + hm * DH; U.ldkv = WM;
    U.mask = nullptr;
    U.qrow0 = b * T + 128 * jq; U.qrow1 = b * T + 128 * (jq + 8);
    U.ntile0 = NMEM / 128; U.ntile1 = NMEM / 128; U.pos0 = 1 << 28; U.pos1 = 1 << 28;
    U.cat = (bf16*)(A.ws + WS_CATB) + WA + WB + hm * DH; U.ldc = DM;
    U.gate = (const bf16*)(A.ws + WS_GM) + hm * DH; U.ldg = WM;
    U.of32 = m_f32 ? m_f32 + hm * DH : nullptr; U.ldo = WM;
    attn_unit(U, lds);
}

typedef short s16x4 __attribute__((ext_vector_type(4)));
__device__ __forceinline__ bf16x8 tr_frag(const LAS unsigned char* img, unsigned row0, unsigned rstep, unsigned ch, unsigned hlf, unsigned q4, unsigned p4) {
    const unsigned a0 = off_b(row0 + q4, ch) + 8 * (p4 & 1), a1 = off_b(row0 + rstep + q4, ch) + 8 * (p4 & 1);
    const s16x4 lo4 = __builtin_bit_cast(s16x4, __builtin_amdgcn_ds_read_tr16_b64_v4i16((LAS s16x4*)(img + a0)));
    const s16x4 hi4 = __builtin_bit_cast(s16x4, __builtin_amdgcn_ds_read_tr16_b64_v4i16((LAS s16x4*)(img + a1)));
    return (bf16x8){lo4[0], lo4[1], lo4[2], lo4[3], hi4[0], hi4[1], hi4[2], hi4[3]};
}
__device__ __forceinline__ void hgrn1_unit(const Args& A, LAS unsigned char* lds, int unit) {
    int tid_l = threadIdx.x; asm volatile("" : "+v"(tid_l));
    const int tid = tid_l, lane = tid & 63, wave = tid >> 6, r32 = lane & 31, hlf = lane >> 5;
    const unsigned blk = (lane >> 4) & 1, q4 = (lane & 15) >> 2, p4 = lane & 3;
    const int b = unit / (HB * NCH), hd = (unit / NCH) % HB, c = unit % NCH, r0 = b * T + 64 * c, col0 = hd * DK;
    const float* HQ = (const float*)(A.ws + WS_HQ); const float* HG = (const float*)(A.ws + WS_HG); const bf16* HV = (const bf16*)(A.ws + WS_HV);
    bf16* QABS = (bf16*)(A.ws + WS_QABS); float* OT = (float*)(A.ws + WS_OT) + (size_t)unit * 128 * 64; float* KVT = (float*)(A.ws + WS_KVT) + (size_t)unit * 128 * 128; float* EG = (float*)(A.ws + WS_EG) + (size_t)unit * 128;
    LAS float* Gs = (LAS float*)(lds + RING_OFF);
    LAS unsigned char* QT = lds + RING_OFF + 32768;
    LAS unsigned char* KT = QT + 16384;
    LAS unsigned char* KD = KT + 16384;
    LAS unsigned char* VI = KD + 16384;
    LAS unsigned char* KH = VI + 16384;
    LAS float* tot = (LAS float*)(KH + 8192);
    { const int d = tid & 127, tq = tid >> 7; float gl[16]; float run = 0.f;
#pragma unroll
      for (int i = 0; i < 16; ++i) { run += HG[(size_t)(r0 + 16 * tq + i) * WB + col0 + d]; gl[i] = run; }
      tot[tq * 128 + d] = run; LDS_WAIT(); __syncthreads();
      float offs = 0.f;
#pragma unroll
      for (int j = 0; j < 3; ++j) offs += (j < tq) ? tot[j * 128 + d] : 0.f;
#pragma unroll
      for (int i = 0; i < 16; ++i) Gs[(16 * tq + i) * 128 + d] = gl[i] + offs;
      LDS_WAIT(); __syncthreads(); }
#pragma unroll
    for (int it = 0; it < 2; ++it) {
        const int item = tid + 512 * it, t = item >> 4, d8 = item & 15, d0 = 8 * d8;
        const size_t go = (size_t)(r0 + t) * WB + col0 + d0;
        f32x4 q0 = *(const GAS f32x4*)(HQ + go), q1 = *(const GAS f32x4*)(HQ + go + 4), g0 = *(const GAS f32x4*)(HG + go), g1 = *(const GAS f32x4*)(HG + go + 4);
        const f32x4 G0 = *(const LAS f32x4*)(Gs + t * 128 + d0), G1 = *(const LAS f32x4*)(Gs + t * 128 + d0 + 4);
        const f32x4 M0 = *(const LAS f32x4*)(Gs + 31 * 128 + d0), M1 = *(const LAS f32x4*)(Gs + 31 * 128 + d0 + 4);
        const f32x4 E0 = *(const LAS f32x4*)(Gs + 63 * 128 + d0), E1 = *(const LAS f32x4*)(Gs + 63 * 128 + d0 + 4);
        f32x4 qt0, qt1, kt0, kt1, kd0, kd1, kh0, kh1, qa0, qa1;
#pragma unroll
        for (int e = 0; e < 4; ++e) {
            { const float G = G0[e], gs = t < 32 ? 0.f : M0[e], k = 1.f - fexp(g0[e]);
              qt0[e] = q0[e] * fexp(G - gs); kt0[e] = k * fexp(gs - G); kd0[e] = k * fexp(E0[e] - G); kh0[e] = k * fexp(M0[e] - G); qa0[e] = q0[e] * fexp(G); }
            { const float G = G1[e], gs = t < 32 ? 0.f : M1[e], k = 1.f - fexp(g1[e]);
              qt1[e] = q1[e] * fexp(G - gs); kt1[e] = k * fexp(gs - G); kd1[e] = k * fexp(E1[e] - G); kh1[e] = k * fexp(M1[e] - G); qa1[e] = q1[e] * fexp(G); }
        }
        const unsigned o = off_b(t, d8);
        *(LAS v4u*)(QT + o) = pack8(qt0, qt1); *(LAS v4u*)(KT + o) = pack8(kt0, kt1); *(LAS v4u*)(KD + o) = pack8(kd0, kd1);
        if (t < 32) *(LAS v4u*)(KH + o) = pack8(kh0, kh1);
        *(LAS v4u*)(VI + o) = *(const GAS v4u*)(HV + go);
        *(GAS v4u*)(QABS + go) = pack8(qa0, qa1);
        if (t == 63) { f32x4 x0, x1;
#pragma unroll
            for (int e = 0; e < 4; ++e) { x0[e] = fexp(E0[e]); x1[e] = fexp(E1[e]); }
            *(GAS f32x4*)(EG + d0) = x0; *(GAS f32x4*)(EG + d0 + 4) = x1; }
    }
    LDS_WAIT(); __syncthreads();
    if (wave < 4) {
        f32x16 acc[4];
#pragma unroll
        for (int db = 0; db < 4; ++db)
#pragma unroll
            for (int i = 0; i < 16; ++i) acc[db][i] = 0.f;
#pragma unroll
        for (int ks = 0; ks < 4; ++ks) {
            const bf16x8 vf = tr_frag(VI, 16 * ks + 8 * hlf, 4, 4 * wave + 2 * blk + (p4 >> 1), 0, q4, p4);
#pragma unroll
            for (int db = 0; db < 4; ++db) { const bf16x8 kf = tr_frag(KD, 16 * ks + 8 * hlf, 4, 4 * db + 2 * blk + (p4 >> 1), 0, q4, p4); acc[db] = __builtin_amdgcn_mfma_f32_32x32x16_bf16(vf, kf, acc[db], 0, 0, 0); }
        }
#pragma unroll
        for (int db = 0; db < 4; ++db)
#pragma unroll
            for (int i = 0; i < 16; ++i) KVT[(size_t)(32 * wave + (i & 3) + 8 * (i >> 2) + 4 * hlf) * 128 + 32 * db + r32] = acc[db][i];
    } else {
        const int x = wave - 4, tb = x & 1, vh = x >> 1;
        f32x16 oacc[2];
#pragma unroll
        for (int j = 0; j < 2; ++j)
#pragma unroll
            for (int i = 0; i < 16; ++i) oacc[j][i] = 0.f;
#pragma unroll
        for (int sb = 0; sb < 2; ++sb) {
            if (sb <= tb) {
                f32x16 X;
#pragma unroll
                for (int i = 0; i < 16; ++i) X[i] = 0.f;
                const LAS unsigned char* kimg = (sb == tb) ? KT : KH;
                const unsigned krow = (sb == tb) ? 32 * sb + r32 : r32;
#pragma unroll
                for (int ks = 0; ks < 8; ++ks) { const bf16x8 kf = *(const LAS bf16x8*)(kimg + off_b(krow, 2 * ks + hlf)); const bf16x8 qf = *(const LAS bf16x8*)(QT + off_b(32 * tb + r32, 2 * ks + hlf)); X = __builtin_amdgcn_mfma_f32_32x32x16_bf16(kf, qf, X, 0, 0, 0); }
                if (sb == tb) {
#pragma unroll
                    for (int i = 0; i < 16; ++i) { const int sl = (i & 3) + 8 * (i >> 2) + 4 * hlf; X[i] = sl <= r32 ? X[i] : 0.f; }
                }
                bf16x8 pf[2];
#pragma unroll
                for (int s2 = 0; s2 < 2; ++s2) { v4u w; w.x = pg8::cvt_pk_bf16(X[8 * s2 + 0], X[8 * s2 + 1]); w.y = pg8::cvt_pk_bf16(X[8 * s2 + 2], X[8 * s2 + 3]); w.z = pg8::cvt_pk_bf16(X[8 * s2 + 4], X[8 * s2 + 5]); w.w = pg8::cvt_pk_bf16(X[8 * s2 + 6], X[8 * s2 + 7]); pf[s2] = __builtin_bit_cast(bf16x8, w); }
#pragma unroll
                for (int j = 0; j < 2; ++j)
#pragma unroll
                    for (int s2 = 0; s2 < 2; ++s2) { const bf16x8 vf = tr_frag(VI, 32 * sb + 16 * s2 + 4 * hlf, 8, 4 * (2 * vh + j) + 2 * blk + (p4 >> 1), 0, q4, p4); oacc[j] = __builtin_amdgcn_mfma_f32_32x32x16_bf16(vf, pf[s2], oacc[j], 0, 0, 0); }
            }
        }
#pragma unroll
        for (int j = 0; j < 2; ++j)
#pragma unroll
            for (int i = 0; i < 16; ++i) OT[(size_t)(32 * (2 * vh + j) + (i & 3) + 8 * (i >> 2) + 4 * hlf) * 64 + 32 * tb + r32] = oacc[j][i];
    }
    LDS_WAIT(); __syncthreads();
}
__device__ __forceinline__ void hgrn2_scan(const Args& A, int G) {
    const float* KVT = (const float*)(A.ws + WS_KVT); const float* EG = (const float*)(A.ws + WS_EG); bf16* SCT = (bf16*)(A.ws + WS_SCT);
    const size_t gtid = (size_t)blockIdx.x * 512 + threadIdx.x, gthreads = (size_t)G * 512;
    for (size_t e = gtid; e < (size_t)NB * HB * 128 * 128; e += gthreads) {
        const int bh = (int)(e >> 14), vd = (int)(e & 16383), d = vd & 127, v = vd >> 7;
        float kv[NCH], eg[NCH];
#pragma unroll
        for (int c = 0; c < NCH; ++c) { kv[c] = KVT[((size_t)(bh * NCH + c) << 14) + vd]; eg[c] = EG[(size_t)(bh * NCH + c) * 128 + d]; }
        float S = 0.f;
#pragma unroll
        for (int c = 0; c < NCH; ++c) { SCT[((size_t)(bh * NCH + c) << 14) + vd] = (bf16)f2bf(S); S = fmaf(eg[c], S, kv[c]); }
        A.out[O_HP + ((size_t)bh * DK + d) * DV + v] = S;
    }
}
__device__ __forceinline__ void hgrn3_unit(const Args& A, LAS unsigned char* lds, int unit, float* bo_f32) {
    int tid_l = threadIdx.x; asm volatile("" : "+v"(tid_l));
    const int tid = tid_l, lane = tid & 63, wave = tid >> 6, r32 = lane & 31, hlf = lane >> 5, vb = wave & 3, tb = wave >> 2;
    const int b = unit / (HB * NCH), hd = (unit / NCH) % HB, c = unit % NCH, r0 = b * T + 64 * c, col0 = hd * DK;
    const float* OT = (const float*)(A.ws + WS_OT) + (size_t)unit * 128 * 64; const bf16* SCT = (const bf16*)(A.ws + WS_SCT) + (size_t)unit * 128 * 128; const bf16* QABS = (const bf16*)(A.ws + WS_QABS);
    LAS float* ssq = (LAS float*)(lds + RING_OFF);
    f32x16 acc;
#pragma unroll
    for (int i = 0; i < 16; ++i) acc[i] = OT[(size_t)(32 * vb + (i & 3) + 8 * (i >> 2) + 4 * hlf) * 64 + 32 * tb + r32];
    if (c > 0) {
#pragma unroll
        for (int ks = 0; ks < 8; ++ks) {
            const bf16x8 sf = *(const GAS bf16x8*)(SCT + (size_t)(32 * vb + r32) * 128 + 16 * ks + 8 * hlf);
            const bf16x8 qf = *(const GAS bf16x8*)(QABS + (size_t)(r0 + 32 * tb + r32) * WB + col0 + 16 * ks + 8 * hlf);
            acc = __builtin_amdgcn_mfma_f32_32x32x16_bf16(sf, qf, acc, 0, 0, 0);
        }
    }
    float sq = 0.f;
#pragma unroll
    for (int i = 0; i < 16; ++i) sq = fmaf(acc[i], acc[i], sq);
    sq += __shfl_xor(sq, 32);
    if (hlf == 0) ssq[(tb * 4 + vb) * 32 + r32] = sq;
    const int row = r0 + 32 * tb + r32;
    const bf16* GB = (const bf16*)(A.ws + WS_GB); bf16* CATb = (bf16*)(A.ws + WS_CATB);
    f32x4 ngv[4]; u32x2 ggv[4];
#pragma unroll
    for (int g4 = 0; g4 < 4; ++g4) { const int v = 32 * vb + 8 * g4 + 4 * hlf; ngv[g4] = *(const GAS f32x4*)(A.norm_g + v); ggv[g4] = *(const GAS u32x2*)(GB + (size_t)row * WB + col0 + v); }
    LDS_WAIT(); __syncthreads();
    const float tot = (ssq[(tb * 4 + 0) * 32 + r32] + ssq[(tb * 4 + 1) * 32 + r32]) + (ssq[(tb * 4 + 2) * 32 + r32] + ssq[(tb * 4 + 3) * 32 + r32]);
    const float rs = rsqrtf(tot * (1.f / DV) + RMS_EPS);
#pragma unroll
    for (int g4 = 0; g4 < 4; ++g4) {
        const int v = 32 * vb + 8 * g4 + 4 * hlf;
        f32x4 o; o[0] = acc[4 * g4]; o[1] = acc[4 * g4 + 1]; o[2] = acc[4 * g4 + 2]; o[3] = acc[4 * g4 + 3];
        if (bo_f32) *(GAS f32x4*)(bo_f32 + (size_t)row * WB + col0 + v) = o;
        const f32x4 ng = ngv[g4]; const u32x2 gg = ggv[g4];
        const float g0 = __uint_as_float(gg.x << 16), g1 = __uint_as_float(gg.x & 0xffff0000u), g2 = __uint_as_float(gg.y << 16), g3 = __uint_as_float(gg.y & 0xffff0000u);
        u32x2 w; w.x = pg8::cvt_pk_bf16(o[0] * rs * ng[0] * g0, o[1] * rs * ng[1] * g1); w.y = pg8::cvt_pk_bf16(o[2] * rs * ng[2] * g2, o[3] * rs * ng[3] * g3);
        *(GAS u32x2*)(CATb + (size_t)row * DM + WA + col0 + v) = w;
    }
    LDS_WAIT(); __syncthreads();
}

__device__ __forceinline__ float bf2f(unsigned short h) { return __uint_as_float((unsigned)h << 16); }
__device__ __forceinline__ void s1_unit(const Args& A, int r) {
    const float* z = (const float*)(A.ws + WS_ZS) + (size_t)r * NIN; const float2* ropeA = (const float2*)(A.ws + WS_ROPEA) + (size_t)(T + (r & (ST - 1))) * 16;
    for (int c = threadIdx.x; c < WA; c += 512) {
        const int d = c & 127; float k = z[C_AK + c];
        if (d < 32) { const int j = d & 15; const bool lo = d < 16; const float x1 = z[C_AK + (lo ? c : c - 16)], x2 = z[C_AK + (lo ? c + 16 : c)]; const float2 cs = ropeA[j]; k = lo ? x1 * cs.x - x2 * cs.y : x2 * cs.x + x1 * cs.y; }
        A.out[O_KS + (size_t)r * WA + c] = k; A.out[O_VS + (size_t)r * WA + c] = z[C_AV + c];
    }
}
__device__ __forceinline__ void s2_unit(const Args& A, int unit) {
    int tid_l = threadIdx.x; asm volatile("" : "+v"(tid_l));
    const int tid = tid_l, lane = tid & 63, wave = tid >> 6, r32 = lane & 31, hlf = lane >> 5, qp = wave & 3, kh = wave >> 2;
    const int b = unit >> 5, pg0 = (unit & 31) * 4;
    const float* Zs = (const float*)(A.ws + WS_ZS); const float* IW = (const float*)(A.ws + WS_IW); const float2* ropeI = (const float2*)(A.ws + WS_ROPEI); float* SCs = (float*)(A.ws + WS_SCS);
    const int qa = (r32 >> 2) & 1, ha = (r32 & 3) + 4 * (r32 >> 3), qrow = b * ST + 2 * qp + qa;
    const float* src = Zs + (size_t)qrow * NIN + C_IQ + ha * DI;
    bf16x8 aq[4];
    { f32x4 x1a = *(const GAS f32x4*)(src), x1b = *(const GAS f32x4*)(src + 4), x2a = *(const GAS f32x4*)(src + 8), x2b = *(const GAS f32x4*)(src + 12);
      const GAS f32x4* cp = (const GAS f32x4*)(ropeI + (size_t)(T + 2 * qp + qa) * 8);
      f32x4 o0, o1;
#pragma unroll
      for (int q = 0; q < 2; ++q) { const f32x4 c01 = cp[q], c23 = cp[2 + q];
          const float a0 = x1a[2 * q], a1 = x1a[2 * q + 1], b0 = x2a[2 * q], b1 = x2a[2 * q + 1], a2 = x1b[2 * q], a3 = x1b[2 * q + 1], b2 = x2b[2 * q], b3 = x2b[2 * q + 1];
          o0[2 * q] = hlf == 0 ? a0 * c01[0] - b0 * c01[1] : b0 * c01[0] + a0 * c01[1]; o0[2 * q + 1] = hlf == 0 ? a1 * c01[2] - b1 * c01[3] : b1 * c01[2] + a1 * c01[3];
          o1[2 * q] = hlf == 0 ? a2 * c23[0] - b2 * c23[1] : b2 * c23[0] + a2 * c23[1]; o1[2 * q + 1] = hlf == 0 ? a3 * c23[2] - b3 * c23[3] : b3 * c23[2] + a3 * c23[3]; }
      aq[0] = __builtin_bit_cast(bf16x8, pack8(o0 * 0.125f, o1 * 0.125f)); }
#pragma unroll
    for (int ks = 1; ks < 4; ++ks) { const f32x4 v0 = *(const GAS f32x4*)(src + 16 * ks + 8 * hlf), v1 = *(const GAS f32x4*)(src + 16 * ks + 8 * hlf + 4); aq[ks] = __builtin_bit_cast(bf16x8, pack8(v0 * 0.125f, v1 * 0.125f)); }
    float wv[16];
    { const GAS f32x4* wp = (const GAS f32x4*)(IW + (size_t)(MP + b * ST + 2 * qp + hlf) * HI);
#pragma unroll
      for (int q = 0; q < 4; ++q) { const f32x4 w4 = wp[q]; wv[4 * q] = w4[0]; wv[4 * q + 1] = w4[1]; wv[4 * q + 2] = w4[2]; wv[4 * q + 3] = w4[3]; } }
    const int ph0 = A.page_table[b * NPAGES + pg0], ph1 = A.page_table[b * NPAGES + pg0 + 1], ph2 = A.page_table[b * NPAGES + pg0 + 2], ph3 = A.page_table[b * NPAGES + pg0 + 3];
    f32x4 ka[2][8], kb[2][8];
#define S2_LOAD(dst, phys_) do { _Pragma("unroll") for (int g = 0; g < 2; ++g) { const float* kr = A.cache_idx_k + ((size_t)(phys_) * PAGE + 64 * kh + 32 * g + r32) * DI; \
        _Pragma("unroll") for (int ks = 0; ks < 4; ++ks) { dst[g][2 * ks] = *(const GAS f32x4*)(kr + 16 * ks + 8 * hlf); dst[g][2 * ks + 1] = *(const GAS f32x4*)(kr + 16 * ks + 8 * hlf + 4); } } } while (0)
#define S2_SCORE(src, pg_) do { _Pragma("unroll") for (int g = 0; g < 2; ++g) { const int key = 64 * kh + 32 * g + r32; f32x16 C; \
        _Pragma("unroll") for (int i = 0; i < 16; ++i) C[i] = 0.f; \
        _Pragma("unroll") for (int ks = 0; ks < 4; ++ks) { const bf16x8 kf = __builtin_bit_cast(bf16x8, pack8(src[g][2 * ks], src[g][2 * ks + 1])); C = __builtin_amdgcn_mfma_f32_32x32x16_bf16(aq[ks], kf, C, 0, 0, 0); } \
        float sc = 0.f; _Pragma("unroll") for (int i = 0; i < 16; ++i) sc = fmaf(wv[i], fmaxf(C[i], 0.f), sc); \
        SCs[(size_t)(b * ST + 2 * qp + hlf) * LDSC + (pg_) * PAGE + key] = sc; } } while (0)
    S2_LOAD(ka, ph0);
    __builtin_amdgcn_sched_barrier(0);
    S2_LOAD(kb, ph1);
    __builtin_amdgcn_sched_barrier(0);
    S2_SCORE(ka, pg0);
    __builtin_amdgcn_sched_barrier(0);
    S2_LOAD(ka, ph2);
    __builtin_amdgcn_sched_barrier(0);
    S2_SCORE(kb, pg0 + 1);
    __builtin_amdgcn_sched_barrier(0);
    S2_LOAD(kb, ph3);
    __builtin_amdgcn_sched_barrier(0);
    S2_SCORE(ka, pg0 + 2);
    __builtin_amdgcn_sched_barrier(0);
    S2_SCORE(kb, pg0 + 3);
#undef S2_LOAD
#undef S2_SCORE
}
__device__ __forceinline__ void s2n_unit(const Args& A, int b) {
    int tid_l = threadIdx.x; asm volatile("" : "+v"(tid_l));
    const int tid = tid_l, lane = tid & 63, t = tid >> 6, key = lane >> 3, hp = lane & 7;
    const float* Zs = (const float*)(A.ws + WS_ZS); const float* IW = (const float*)(A.ws + WS_IW); const float2* ropeI = (const float2*)(A.ws + WS_ROPEI) + (size_t)(T + t) * 8; float* SCs = (float*)(A.ws + WS_SCS);
    const float* kr = A.out + O_IKS + (size_t)(b * ST + key) * DI;
    float part = 0.f;
#pragma unroll
    for (int hh = 0; hh < 2; ++hh) {
        const int h = 2 * hp + hh; const float* q = Zs + (size_t)(b * ST + t) * NIN + C_IQ + h * DI;
        float dot = 0.f;
        for (int d = 0; d < DI; ++d) { float qv = q[d]; if (d < 16) { const int j = d & 7; const float x1 = q[j], x2 = q[j + 8]; const float2 cs = ropeI[j]; qv = d < 8 ? x1 * cs.x - x2 * cs.y : x2 * cs.x + x1 * cs.y; } dot = fmaf(qv, kr[d], dot); }
        part += IW[(size_t)(MP + b * ST + t) * HI + h] * fmaxf(dot * 0.125f, 0.f);
    }
    part += __shfl_xor(part, 1); part += __shfl_xor(part, 2); part += __shfl_xor(part, 4);
    if (hp == 0 && key <= t) SCs[(size_t)(b * ST + t) * LDSC + PAST + key] = part;
}
__device__ __forceinline__ void s3_unit(const Args& A, LAS unsigned char* lds, int unit, float* bo_f32) {
    int tid_l = threadIdx.x; asm volatile("" : "+v"(tid_l));
    const int tid = tid_l, v = tid & 127, dq = tid >> 7, b = unit >> 2, hd = unit & 3;
    const float* Zs = (const float*)(A.ws + WS_ZS); const float* lbv = (const float*)(A.ws + WS_LB); bf16* CATb = (bf16*)(A.ws + WS_CATB);
    LAS float* qs = (LAS float*)(lds + RING_OFF); LAS float* fs = qs + 128; LAS float* ks = fs + 128; LAS float* vs = ks + 128; LAS float* red = vs + 128; LAS float* ssq = red + 512;
    float S[32];
#pragma unroll
    for (int i = 0; i < 32; ++i) S[i] = A.state_hgrn[(((size_t)b * HB + hd) * DK + dq * 32 + i) * DV + v];
    for (int t = 0; t < ST; ++t) {
        const int r = b * ST + t; const float* z = Zs + (size_t)r * NIN;
        __syncthreads();
        if (tid < 128) { qs[tid] = silu_f(z[C_BQ + hd * DK + tid]); const float lb = lbv[hd * DK + tid]; const float f = lb + (1.f - lb) * sigmoid_f(z[C_BF + hd * DK + tid]); fs[tid] = f; ks[tid] = 1.f - f; }
        else if (tid < 256) vs[tid - 128] = z[C_BI + hd * DV + (tid - 128)];
        LDS_WAIT(); __syncthreads();
        const float vv = vs[v]; float o = 0.f;
#pragma unroll
        for (int i = 0; i < 32; ++i) { const int d = dq * 32 + i; S[i] = fs[d] * S[i] + ks[d] * vv; o = fmaf(qs[d], S[i], o); }
        red[dq * 128 + v] = o;
        LDS_WAIT(); __syncthreads();
        float oo = 0.f;
        if (tid < 128) { oo = (red[v] + red[128 + v]) + (red[256 + v] + red[384 + v]); const float sq = wave_sum(oo * oo); if ((tid & 63) == 0) ssq[tid >> 6] = sq; }
        LDS_WAIT(); __syncthreads();
        if (tid < 128) { const float rs = rsqrtf((ssq[0] + ssq[1]) * (1.f / DV) + RMS_EPS);
            if (bo_f32) bo_f32[(size_t)(MP + r) * WB + hd * DV + v] = oo;
            CATb[(size_t)(MP + r) * DM + WA + hd * DV + v] = (bf16)f2bf(oo * rs * A.norm_g[v] * silu_f(z[C_BG + hd * DV + v])); }
    }
#pragma unroll
    for (int i = 0; i < 32; ++i) A.out[O_HS + (((size_t)b * HB + hd) * DK + dq * 32 + i) * DV + v] = S[i];
    __syncthreads();
}
__device__ __forceinline__ void s4_unit(const Args& A, LAS unsigned char* lds, int unit, float* m_f32) {
    int tid_l = threadIdx.x; asm volatile("" : "+v"(tid_l));
    const int tid = tid_l, sub = tid >> 8, t8 = tid & 255, h = t8 >> 6, l = t8 & 63, r = unit * 2 + sub, b = r >> 3;
    const float* z = (const float*)(A.ws + WS_ZS) + (size_t)r * NIN; bf16* CATb = (bf16*)(A.ws + WS_CATB);
    LAS float* q = (LAS float*)(lds + RING_OFF) + sub * 512; LAS float* p = (LAS float*)(lds + RING_OFF) + 1024 + sub * 1024 + h * 256;
    for (int i = t8; i < WM; i += 256) q[i] = z[C_MQ + i];
    LDS_WAIT(); __syncthreads();
    float mx = -INFINITY;
    for (int n = l; n < NMEM; n += 64) {
        const GAS f32x4* kr = (const GAS f32x4*)(A.cache_mem_k + ((size_t)(b * NMEM + n) * HM + h) * DH);
        float dot = 0.f;
#pragma unroll 8
        for (int d4 = 0; d4 < DH / 4; ++d4) { const f32x4 kv = kr[d4]; const LAS float* qq = q + h * DH + d4 * 4; dot = fmaf(qq[0], kv[0], dot); dot = fmaf(qq[1], kv[1], dot); dot = fmaf(qq[2], kv[2], dot); dot = fmaf(qq[3], kv[3], dot); }
        dot *= SM_SCALE; p[n] = dot; mx = fmaxf(mx, dot);
    }
#pragma unroll
    for (int o = 32; o >= 1; o >>= 1) mx = fmaxf(mx, __shfl_xor(mx, o));
    float sum = 0.f;
    for (int n = l; n < NMEM; n += 64) { const float e = expf(p[n] - mx); p[n] = e; sum += e; }
    sum = wave_sum(sum);
    LDS_WAIT(); __syncthreads();
    float a0 = 0.f, a1 = 0.f;
    for (int n = 0; n < NMEM; ++n) { const float* vr = A.cache_mem_v + ((size_t)(b * NMEM + n) * HM + h) * DH + l * 2; const float pn = p[n]; a0 = fmaf(pn, vr[0], a0); a1 = fmaf(pn, vr[1], a1); }
    const float inv = 1.f / sum; a0 *= inv; a1 *= inv;
    if (m_f32) { m_f32[(size_t)(MP + r) * WM + h * DH + l * 2] = a0; m_f32[(size_t)(MP + r) * WM + h * DH + l * 2 + 1] = a1; }
    *(GAS unsigned*)(CATb + (size_t)(MP + r) * DM + WA + WB + h * DH + l * 2) = pk2(a0 * silu_f(z[C_MG + h * DH + l * 2]), a1 * silu_f(z[C_MG + h * DH + l * 2 + 1]));
    __syncthreads();
}
__device__ __forceinline__ void s5_unit(const Args& A, LAS unsigned char* lds, int r) {
    int tid_l = threadIdx.x; asm volatile("" : "+v"(tid_l));
    const int tid = tid_l, lane = tid & 63, wave = tid >> 6, n = PAST + (r & (ST - 1)) + 1;
    const float* sc = (const float*)(A.ws + WS_SCS) + (size_t)r * LDSC; int* sel = (int*)(A.ws + WS_SELS) + (size_t)r * TOPK;
    LAS float* red = (LAS float*)(lds + RING_OFF);
    LAS int* cnts = (LAS int*)(lds + RING_OFF + 64);
    LAS int* ctr = (LAS int*)(lds + RING_OFF + 128);
    LAS float* cand = (LAS float*)(lds + RING_OFF + 256);
    constexpr int NV = (NKEYS_S + 511) / 512;
    float x[NV];
#pragma unroll
    for (int i = 0; i < NV; ++i) { const int s = i * 512 + tid; x[i] = s < n ? sc[s] : -INFINITY; }
    float mn = INFINITY, mx = -INFINITY;
#pragma unroll
    for (int i = 0; i < NV; ++i) { const int s = i * 512 + tid; mn = fminf(mn, s < n ? x[i] : INFINITY); mx = fmaxf(mx, x[i]); }
#pragma unroll
    for (int o = 1; o < 64; o <<= 1) { mn = fminf(mn, __shfl_xor(mn, o)); mx = fmaxf(mx, __shfl_xor(mx, o)); }
    if (lane == 0) { red[wave] = mn; red[8 + wave] = mx; }
    if (tid < 4) ctr[tid] = 0;
    LDS_WAIT(); __syncthreads();
    mn = red[0]; mx = red[8];
#pragma unroll
    for (int w = 1; w < 8; ++w) { mn = fminf(mn, red[w]); mx = fmaxf(mx, red[8 + w]); }
    float lo = mn, hi = INFINITY; int c_lo = n, c_hi = 0;
    for (int it = 0; it < 96 && c_lo - c_hi > 512; ++it) {
        const float hf = (hi == INFINITY) ? mx : hi;
        const float mid = lo + 0.5f * (hf - lo);
        if (!(mid > lo) || (hi != INFINITY && !(mid < hi))) break;
        int c = 0;
#pragma unroll
        for (int i = 0; i < NV; ++i) c += __popcll(__ballot(x[i] >= mid));
        __syncthreads();
        if (lane == 0) cnts[wave] = c;
        LDS_WAIT(); __syncthreads();
        c = 0;
#pragma unroll
        for (int w = 0; w < 8; ++w) c += cnts[w];
        if (c >= TOPK) { lo = mid; c_lo = c; } else { hi = mid; c_hi = c; }
    }
    const int m = c_lo - c_hi, rr = TOPK - c_hi;
#pragma unroll
    for (int i = 0; i < NV; ++i) { if (x[i] >= lo && x[i] < hi) { const int pos = __hip_atomic_fetch_add(ctr, 1, __ATOMIC_RELAXED, __HIP_MEMORY_SCOPE_WORKGROUP); if (pos < 1024) { cand[2 * pos] = x[i]; cand[2 * pos + 1] = __int_as_float(i * 512 + tid); } } }
    LDS_WAIT(); __syncthreads();
    float thr_v = lo; int thr_s = 0x7fffffff;
    if (m <= 1024) {
        LAS float* res = red;
        for (int c0 = 0; c0 < m; c0 += 512) {
            const int cme = c0 + tid; const bool have = cme < m;
            const float v = have ? cand[2 * cme] : 0.f; const int sidx = have ? __float_as_int(cand[2 * cme + 1]) : 0;
            int rank = 0;
            for (int j = 0; j < m; ++j) { const float ov = cand[2 * j]; const int os = __float_as_int(cand[2 * j + 1]); rank += (ov > v || (ov == v && os < sidx)) ? 1 : 0; }
            if (have && rank == rr - 1) { res[0] = v; res[1] = __int_as_float(sidx); }
        }
        LDS_WAIT(); __syncthreads();
        thr_v = red[0]; thr_s = __float_as_int(red[1]);
    }
    int tot = 0;
#pragma unroll
    for (int i = 0; i < NV; ++i) { const int s = i * 512 + tid; tot += __popcll(__ballot(x[i] > thr_v || (x[i] == thr_v && s <= thr_s))); }
    __syncthreads();
    if (lane == 0) cnts[wave] = tot;
    LDS_WAIT(); __syncthreads();
    int run = 0;
#pragma unroll
    for (int w = 0; w < 8; ++w) run += (w < wave) ? cnts[w] : 0;
#pragma unroll
    for (int i = 0; i < NV; ++i) { const int s = i * 512 + tid; const bool on = x[i] > thr_v || (x[i] == thr_v && s <= thr_s); const unsigned long long bal = __ballot(on);
        if (on) { const int pos = run + __popcll(bal & ((1ull << lane) - 1ull)); if (pos < TOPK) sel[pos] = s; }
        run += __popcll(bal); }
    __syncthreads();
}
__device__ __forceinline__ void s6_unit(const Args& A, LAS unsigned char* lds, int unit, float* a_f32) {
    int tid_l = threadIdx.x; asm volatile("" : "+v"(tid_l));
    const int tid = tid_l, r = unit >> 3, h = unit & 7, b = r >> 3, t = r & 7;
    const float* z = (const float*)(A.ws + WS_ZS) + (size_t)r * NIN; const int* sel = (const int*)(A.ws + WS_SELS) + (size_t)r * TOPK; bf16* CATb = (bf16*)(A.ws + WS_CATB);
    const float2* ropeA = (const float2*)(A.ws + WS_ROPEA) + (size_t)(T + t) * 16;
    LAS float* q = (LAS float*)(lds + RING_OFF); LAS float* p = q + 128; LAS float* red = p + 256; LAS float* part = red + 32;
    LAS long long* ko = (LAS long long*)(part + 2048);
    if (tid < 128) { const int d = tid; float qv = z[C_AQ + h * DH + d];
        if (d < 32) { const int j = d & 15; const bool lo = d < 16; const float x1 = z[C_AQ + h * DH + j], x2 = z[C_AQ + h * DH + j + 16]; const float2 cs = ropeA[j]; qv = lo ? x1 * cs.x - x2 * cs.y : x2 * cs.x + x1 * cs.y; }
        q[d] = qv * SM_SCALE; }
    else if (tid < 384) { const int i = tid - 128, sp = sel[i];
        ko[i] = sp >= PAST ? -(long long)(1 + b * ST + (sp - PAST)) : ((long long)A.page_table[b * NPAGES + (sp >> 7)] * PAGE + (sp & 127)) * WA + h * DH; }
    LDS_WAIT(); __syncthreads();
    { const int kidx = tid >> 1, half = tid & 1; const long long o = ko[kidx];
      const float* kr = o < 0 ? A.out + O_KS + (size_t)(-o - 1) * WA + h * DH : A.cache_k + o;
      const GAS f32x4* k4 = (const GAS f32x4*)(kr + 64 * half); float dot = 0.f;
      f32x4 kv[16];
#pragma unroll
      for (int d4 = 0; d4 < 16; ++d4) kv[d4] = k4[d4];
#pragma unroll
      for (int d4 = 0; d4 < 16; ++d4) { const LAS float* qq = q + 64 * half + 4 * d4; dot = fmaf(qq[0], kv[d4][0], dot); dot = fmaf(qq[1], kv[d4][1], dot); dot = fmaf(qq[2], kv[d4][2], dot); dot = fmaf(qq[3], kv[d4][3], dot); }
      dot += __shfl_xor(dot, 1);
      if (half == 0) p[kidx] = dot; }
    const int d4v = tid & 31, kp = tid >> 5;
    f32x4 vv[16];
#pragma unroll
    for (int i = 0; i < 16; ++i) { const long long o = ko[kp * 16 + i]; const float* vr = o < 0 ? A.out + O_VS + (size_t)(-o - 1) * WA + h * DH : A.cache_v + o; vv[i] = *((const GAS f32x4*)vr + d4v); }
    LDS_WAIT(); __syncthreads();
    float mx = -INFINITY;
    if (tid < 256) mx = p[tid];
#pragma unroll
    for (int o = 1; o < 64; o <<= 1) mx = fmaxf(mx, __shfl_xor(mx, o));
    if ((tid & 63) == 0) red[tid >> 6] = mx;
    LDS_WAIT(); __syncthreads();
    mx = fmaxf(fmaxf(red[0], red[1]), fmaxf(red[2], red[3]));
    float e = 0.f;
    if (tid < 256) { e = expf(p[tid] - mx); }
    const float esum = wave_sum(e);
    __syncthreads();
    if (tid < 256) p[tid] = e;
    if ((tid & 63) == 0) red[8 + (tid >> 6)] = esum;
    LDS_WAIT(); __syncthreads();
    const float inv = 1.f / ((red[8] + red[9]) + (red[10] + red[11]));
    { f32x4 acc = (f32x4){0.f, 0.f, 0.f, 0.f};
#pragma unroll
      for (int i = 0; i < 16; ++i) acc = acc + vv[i] * p[kp * 16 + i];
      *(LAS f32x4*)(part + kp * 128 + 4 * d4v) = acc; }
    LDS_WAIT(); __syncthreads();
    if (tid < 128) { float o = 0.f;
#pragma unroll
        for (int kq = 0; kq < 16; ++kq) o += part[kq * 128 + tid];
        o *= inv;
        if (a_f32) a_f32[(size_t)(MP + r) * WA + h * DH + tid] = o;
        CATb[(size_t)(MP + r) * DM + h * DH + tid] = (bf16)f2bf(o * silu_f(z[C_AG + h * DH + tid])); }
    __syncthreads();
}

constexpr int CW_QUEUE = 32768;
__device__ __forceinline__ unsigned q_issue(gu32* ctl, int q) {
    unsigned v = 0u;
    if (threadIdx.x == 0) v = __hip_atomic_fetch_add(ctl + CW_QUEUE + 64 * q, 1u, __ATOMIC_RELAXED, __HIP_MEMORY_SCOPE_AGENT);
    return v;
}
__device__ __forceinline__ int q_next(gu32* ctl, int q, volatile LAS unsigned* slot, int& par, unsigned& pend) {
    if (threadIdx.x == 0) slot[par] = pend;
    __syncthreads();
    const int v = (int)slot[par]; par ^= 1;
    pend = q_issue(ctl, q);
    return v;
}
__device__ __forceinline__ int q_grab(gu32* ctl, int q, volatile LAS unsigned* slot, int& par) {
    if (threadIdx.x == 0) slot[par] = __hip_atomic_fetch_add(ctl + CW_QUEUE + 64 * q, 1u, __ATOMIC_RELAXED, __HIP_MEMORY_SCOPE_AGENT);
    __syncthreads();
    const int v = (int)slot[par]; par ^= 1;
    return v;
}
#define QLOOP_PLAIN(q_, n_, i_) for (int i_ = q_grab(ctl, q_, QS, qpar); i_ < (n_); i_ = q_grab(ctl, q_, QS, qpar))
#define QLOOP(q_, n_, i_) unsigned pend_##q_ = q_issue(ctl, q_); for (int i_ = q_next(ctl, q_, QS, qpar, pend_##q_); i_ < (n_); i_ = q_next(ctl, q_, QS, qpar, pend_##q_))

__global__ void __launch_bounds__(NWAVES * 64, 2) mega_fwd(Args args) {
    extern __shared__ __attribute__((aligned(16))) unsigned char lds_raw[];
    LAS unsigned char* lds = (LAS unsigned char*)lds_raw;
    volatile LAS unsigned* MISC = (volatile LAS unsigned*)(lds + MISC_OFF);
    const int tid = threadIdx.x, G = gridDim.x;
    unsigned char* ws = args.ws;
    gu32* ctl = (gu32*)(ws + WS_CTL);
    for (int u = tid; u < (LDS_BYTES - LDSCTL_OFF) / 4; u += NWAVES * 64) ((LAS unsigned*)(lds + LDSCTL_OFF))[u] = 0u;
    __syncthreads();
    volatile LAS unsigned* QS = MISC + 16; int qpar = 0;
    XcdBarrier bar = xcd_barrier_post((unsigned*)(ctl + CW_BAR) + args.li * XCD_BAR_WORDS, MISC + 8);
    const int lo = args.ph_lo, hi = args.ph_hi;
#if PROBE == 3
    unsigned long long* stamps = (unsigned long long*)(ws + WS_CTL + 800000);
#define STAMP(k) do { if (blockIdx.x == 0 && tid == 0) stamps[k] = __builtin_amdgcn_s_memrealtime(); } while (0)
#define SUB(k) do { } while (0)
#define WEND(ph) do { if (tid == 0) __hip_atomic_store(stamps + 64 + (ph) * 256 + blockIdx.x, (unsigned long long)__builtin_amdgcn_s_memrealtime(), __ATOMIC_RELAXED, __HIP_MEMORY_SCOPE_AGENT); } while (0)
#elif PROBE == 2
#define WEND(ph) do { } while (0)
    unsigned long long* stamps = (unsigned long long*)(ws + WS_CTL + 800000);
#define STAMP(k) do { if (blockIdx.x == 0 && tid == 0) stamps[k] = __builtin_amdgcn_s_memrealtime(); } while (0)
#define SUB(k) do { if (blockIdx.x == PROBE_BLK && tid == 0) stamps[16 + (k)] = __builtin_amdgcn_s_memrealtime(); } while (0)
#else
#define STAMP(k) do { } while (0)
#define SUB(k) do { } while (0)
#define WEND(ph) do { } while (0)
#endif
    STAMP(0);
#define IN(k) (lo <= (k) && (k) < hi)
#define BOTH(k) (IN(k) && IN((k) + 1))
    if (IN(0)) { p0_prologue(args, lds, G); WEND(0); if (BOTH(0)) xcd_barrier(bar); }
    STAMP(1);
    if (IN(1)) {
        pg8::Gemm g{(const pg8::bf16_t*)(ws + WS_XB), (const pg8::bf16_t*)(ws + WS_WMAIN), MP, NMAIN, DM};
        pg8::StaticOrder S; S.init(MP, NMAIN, G, (int)blockIdx.x);
        EpiIn E{args.out, (float*)(ws + WS_Z), (bf16*)(ws + WS_QB), (bf16*)(ws + WS_KB), (bf16*)(ws + WS_VB), (bf16*)(ws + WS_GA), (bf16*)(ws + WS_IQB), (bf16*)(ws + WS_HV), (bf16*)(ws + WS_GB),
                (bf16*)(ws + WS_MQB), (bf16*)(ws + WS_GM), (float*)(ws + WS_HQ), (float*)(ws + WS_HG), (const float2*)(ws + WS_ROPEA), (const float2*)(ws + WS_ROPEI), (const float*)(ws + WS_LB)};
        pg8::gemm_phase<EpiIn, pg8::StaticOrder, true, true>(lds + RING_OFF, g, S, E);
        p1_small(args, G);
        WEND(1);
        if (BOTH(1)) xcd_barrier(bar);
    }
    STAMP(2);
    if (IN(2)) {
        SUB(0);
        {
            QLOOP_PLAIN(0, 256, i) { const int pq = i >> 2, b = i & 3, p = pq < 48 ? 16 + pq : pq - 48; p2_indexer(args, lds, (b << 6) | p); }
            SUB(1);
            QLOOP_PLAIN(1, SB * HB, i) s3_unit(args, lds, i, args.dbg_bo);
            QLOOP_PLAIN(2, MS / 2, i) s4_unit(args, lds, i, args.dbg_mout);
            QLOOP(3, NHU, i) hgrn1_unit(args, lds, i);
            SUB(2);
            SUB(3);
            QLOOP_PLAIN(4, SB * NPAGES / 4, i) s2_unit(args, i);
            SUB(4);
            QLOOP(5, MS + SB, i) { if (i < MS) s1_unit(args, i); else s2n_unit(args, i - MS); }
        }
        SUB(5);
        WEND(2);
        if (BOTH(2)) xcd_barrier(bar);
        SUB(6);
    }
    STAMP(3);
    if (IN(3)) {
        QLOOP_PLAIN(6, 256, i) { const int j = i >> 5, bh = i & 31; p3_dsa_attn(args, lds, (bh << 3) | j, args.dbg_aout); }
        SUB(7);
        QLOOP_PLAIN(7, MS, i) s5_unit(args, lds, i);
        QLOOP_PLAIN(8, 128, i) p2_memattn(args, lds, i, args.dbg_mout);
        SUB(8);
        hgrn2_scan(args, G);
        SUB(9);
        WEND(3);
        if (BOTH(3)) xcd_barrier(bar);
        SUB(10);
    }
    STAMP(4);
    if (IN(4)) {
        QLOOP_PLAIN(9, MS * HA, i) s6_unit(args, lds, i, args.dbg_aout);
        SUB(11);
        QLOOP(10, NHU, i) hgrn3_unit(args, lds, i, args.dbg_bo);
        SUB(12);
        WEND(4);
        if (BOTH(4)) xcd_barrier(bar);
        SUB(13);
    }
    STAMP(5);
    if (IN(5)) {
        pg8::Gemm g{(const pg8::bf16_t*)(ws + WS_CATB), (const pg8::bf16_t*)(ws + WS_WOUT), MP, DM, DM};
        pg8::StaticOrder S; S.init(MP, DM, G, (int)blockIdx.x);
        EpiOut E{(bf16*)(ws + WS_YMIX)};
        pg8::gemm_phase<EpiOut, pg8::StaticOrder, true, true>(lds + RING_OFF, g, S, E);
        p5_small(args, lds, G);
        WEND(5);
        if (BOTH(5)) xcd_barrier(bar);
    }
    STAMP(6);
    if (IN(6)) { p6_layernorm(args, G); }
#if PROBE == 3
    if (blockIdx.x == 0 && tid == 0) {
        asm volatile("s_waitcnt vmcnt(0)" ::: "memory");
        const unsigned long long t0 = stamps[PROBE_PH];
        float mx = 0.f, sum = 0.f, mnv = 1e30f; int am = 0;
        for (int bq = 0; bq < (int)gridDim.x; ++bq) { const float d = (float)(__hip_atomic_load(stamps + 64 + PROBE_PH * 256 + bq, __ATOMIC_RELAXED, __HIP_MEMORY_SCOPE_AGENT) - t0) * 0.01f; if (d > mx) { mx = d; am = bq; } sum += d; mnv = fminf(mnv, d); }
        const float dA = PROBE_ARG ? (float)am * 1.0f : mx, dB = PROBE_ARG ? mnv : sum / (float)gridDim.x;
        args.out[O_YP] += dA * 0.01f;
        for (int i = 0; i < MS * DI; ++i) args.out[O_IKS + i] *= (1.f + dB * (1.f / 3000.f));
    }
#endif
#if PROBE == 2
    if (blockIdx.x == 0 && tid == 0) {
        const unsigned long long tend = __builtin_amdgcn_s_memrealtime();
#if PROBE_SUB
        (void)tend;
        const float dA = (float)(stamps[16 + PROBE_A + 1] - stamps[16 + PROBE_A]) * 0.1f, dB = (float)(stamps[16 + PROBE_B + 1] - stamps[16 + PROBE_B]) * 0.1f;
#else
        const float dA = (float)((PROBE_A == 6 ? tend : stamps[PROBE_A + 1]) - stamps[PROBE_A]) * 0.01f, dB = (float)((PROBE_B == 6 ? tend : stamps[PROBE_B + 1]) - stamps[PROBE_B]) * 0.01f;
#endif
        asm volatile("s_waitcnt vmcnt(0)" ::: "memory");
        args.out[O_YP] += dA * (PROBE_SUB ? 0.001f : 0.01f);
        for (int i = 0; i < MS * DI; ++i) args.out[O_IKS + i] *= (1.f + dB * (1.f / 3000.f));
    }
#endif
#undef IN
#undef BOTH
}

#if HYBRID
__global__ void __launch_bounds__(256) gemm_nn(const float* __restrict__ A, const float* __restrict__ B, float* __restrict__ C, int M, int N, int K, int lda, int ldb, int ldc) {
    __shared__ float As[16][64 + 4];
    __shared__ float Bs[16][64 + 4];
    const int tid = threadIdx.x, tx = tid & 15, ty = tid >> 4;
    const int m0 = blockIdx.y * 64, n0 = blockIdx.x * 64;
    float acc[4][4] = {};
    for (int k0 = 0; k0 < K; k0 += 16) {
        for (int i = tid; i < 64 * 16; i += 256) { const int r = i >> 4, c = i & 15; As[c][r] = A[(size_t)(m0 + r) * lda + k0 + c]; }
        for (int i = tid; i < 16 * 64; i += 256) { const int r = i >> 6, c = i & 63; Bs[r][c] = (n0 + c < N) ? B[(size_t)(k0 + r) * ldb + n0 + c] : 0.f; }
        __syncthreads();
#pragma unroll
        for (int kk = 0; kk < 16; ++kk) {
            float a[4], b[4];
#pragma unroll
            for (int i = 0; i < 4; ++i) { a[i] = As[kk][ty * 4 + i]; b[i] = Bs[kk][tx * 4 + i]; }
#pragma unroll
            for (int i = 0; i < 4; ++i)
#pragma unroll
                for (int j = 0; j < 4; ++j) acc[i][j] = fmaf(a[i], b[j], acc[i][j]);
        }
        __syncthreads();
    }
#pragma unroll
    for (int i = 0; i < 4; ++i)
#pragma unroll
        for (int j = 0; j < 4; ++j) { const int n = n0 + tx * 4 + j; if (n < N) C[(size_t)(m0 + ty * 4 + i) * ldc + n] = acc[i][j]; }
}
__device__ __forceinline__ int row_pos(int row) { return row < MP ? (row % T) : (PAST + ((row - MP) % ST)); }
__device__ __forceinline__ void rope_pair(float x1, float x2, int pos, int j, int half, float& o1, float& o2) {
    float c, s; rope_cs(pos, j, half, c, s);
    o1 = x1 * c - x2 * s; o2 = x2 * c + x1 * s;
}
__global__ void __launch_bounds__(256) post_rows(const float* __restrict__ Z, float* __restrict__ Qr, float* __restrict__ IQr, float* __restrict__ out, int write_prompt_out, int write_sample_idx) {
    const int row = blockIdx.x, pos = row_pos(row);
    const float* z = Z + (size_t)row * NIN;
    float* kout = row < MP ? out + O_KP + (size_t)row * WA : out + O_KS + (size_t)(row - MP) * WA;
    float* vout = row < MP ? out + O_VP + (size_t)row * WA : out + O_VS + (size_t)(row - MP) * WA;
    float* ikout = row < MP ? out + O_IKP + (size_t)row * DI : out + O_IKS + (size_t)(row - MP) * DI;
    const bool wkv = row < MP ? write_prompt_out != 0 : true;
    const bool wik = row < MP ? write_prompt_out != 0 : write_sample_idx != 0;
    for (int c = threadIdx.x; c < WA; c += 256) {
        const int d = c & 127;
        float q = z[C_AQ + c], k = z[C_AK + c];
        if (d < 32) {
            const int j = d & 15; const bool lo = d < 16; const int c1 = lo ? c : c - 16, c2 = c1 + 16;
            float o1, o2; rope_pair(z[C_AQ + c1], z[C_AQ + c2], pos, j, 16, o1, o2); q = lo ? o1 : o2;
            rope_pair(z[C_AK + c1], z[C_AK + c2], pos, j, 16, o1, o2); k = lo ? o1 : o2;
        }
        Qr[(size_t)row * WA + c] = q; if (wkv) { kout[c] = k; vout[c] = z[C_AV + c]; }
        const int di = c & 63;
        float iq = z[C_IQ + c];
        if (di < 16) { const int j = di & 7; const bool lo = di < 8; const int c1 = lo ? c : c - 8, c2 = c1 + 8; float o1, o2; rope_pair(z[C_IQ + c1], z[C_IQ + c2], pos, j, 8, o1, o2); iq = lo ? o1 : o2; }
        IQr[(size_t)row * WA + c] = iq;
    }
    if (wik) for (int c = threadIdx.x; c < DI; c += 256) {
        float ik = z[C_IK + c];
        if (c < 16) { const int j = c & 7; const bool lo = c < 8; const int c1 = lo ? c : c - 8, c2 = c1 + 8; float o1, o2; rope_pair(z[C_IK + c1], z[C_IK + c2], pos, j, 8, o1, o2); ik = lo ? o1 : o2; }
        ikout[c] = ik;
    }
}
__device__ __forceinline__ const float* idx_key_row(int row, int s, const float* out, const float* cache_idx_k, const int* page_table) {
    if (row < MP) { const int b = row / T; return out + O_IKP + (size_t)(b * T + s) * DI; }
    const int b = (row - MP) / ST;
    if (s >= PAST) return out + O_IKS + (size_t)(b * ST + (s - PAST)) * DI;
    const int pg = page_table[b * NPAGES + s / PAGE];
    return cache_idx_k + ((size_t)pg * PAGE + (s % PAGE)) * DI;
}
__global__ void __launch_bounds__(256) idx_scores(const float* __restrict__ Z, const float* __restrict__ IQr, const float* out, const float* __restrict__ cache_idx_k, const int* __restrict__ page_table,
                                                   float* __restrict__ SC, int row0, int ldsc) {
    __shared__ float q[HI * DI];
    __shared__ float w[HI];
    const int row = row0 + blockIdx.y;
    const int nk = row < MP ? (row % T) + 1 : PAST + ((row - MP) % ST) + 1;
    for (int i = threadIdx.x; i < HI * DI; i += 256) q[i] = IQr[(size_t)row * WA + i];
    if (threadIdx.x < HI) w[threadIdx.x] = Z[(size_t)row * NIN + C_IW + threadIdx.x] * 0.25f;
    __syncthreads();
    const int s = blockIdx.x * 256 + threadIdx.x;
    if (s >= nk) return;
    const float4* kr = (const float4*)idx_key_row(row, s, out, cache_idx_k, page_table);
    float acc = 0.f;
    for (int h = 0; h < HI; ++h) {
        float dot = 0.f;
#pragma unroll
        for (int d4 = 0; d4 < DI / 4; ++d4) { const float4 kv = kr[d4]; const float* qq = q + h * DI + d4 * 4;
            dot = fmaf(qq[0], kv.x, dot); dot = fmaf(qq[1], kv.y, dot); dot = fmaf(qq[2], kv.z, dot); dot = fmaf(qq[3], kv.w, dot); }
        dot *= 0.125f;
        acc += w[h] * fmaxf(dot, 0.f);
    }
    SC[(size_t)blockIdx.y * ldsc + s] = acc;
}
__global__ void __launch_bounds__(256) idx_select(const float* __restrict__ SC, int* __restrict__ sel, int row0, int ldsc) {
    __shared__ float tile[1024];
    const int row = row0 + blockIdx.y;
    const int nk = row < MP ? (row % T) + 1 : PAST + ((row - MP) % ST) + 1;
    const float* sc = SC + (size_t)blockIdx.y * ldsc;
    const int s = blockIdx.x * 256 + threadIdx.x;
    if (blockIdx.x * 256 >= nk) return;
    const float mine = s < nk ? sc[s] : 0.f;
    int rank = 0;
    for (int t0 = 0; t0 < nk; t0 += 1024) {
        __syncthreads();
        for (int i = threadIdx.x; i < 1024; i += 256) tile[i] = (t0 + i < nk) ? sc[t0 + i] : -INFINITY;
        __syncthreads();
        const int lim = min(1024, nk - t0);
        for (int i = 0; i < lim; ++i) { const float o = tile[i]; rank += (o > mine || (o == mine && (t0 + i) < s)) ? 1 : 0; }
    }
    if (s < nk && rank < TOPK) sel[(size_t)row * TOPK + rank] = s;
}
__device__ __forceinline__ const float* kv_row(int row, int s, int h, bool isv, const float* out, const float* cache_k, const float* cache_v, const int* page_table) {
    if (row < MP) { const int b = row / T; return out + (isv ? O_VP : O_KP) + (size_t)(b * T + s) * WA + h * DH; }
    const int b = (row - MP) / ST;
    if (s >= PAST) return out + (isv ? O_VS : O_KS) + (size_t)(b * ST + (s - PAST)) * WA + h * DH;
    const int pg = page_table[b * NPAGES + s / PAGE];
    return (isv ? cache_v : cache_k) + ((size_t)pg * PAGE + (s % PAGE)) * WA + h * DH;
}
__global__ void __launch_bounds__(256) sparse_attn(const float* __restrict__ Qr, const int* __restrict__ sel, const float* out, const float* __restrict__ cache_k, const float* __restrict__ cache_v,
                                                    const int* __restrict__ page_table, float* __restrict__ a_out, int row0) {
    __shared__ float q[WA];
    __shared__ float p[HA][TOPK];
    __shared__ int sl[TOPK];
    const int row = row0 + blockIdx.x, tid = threadIdx.x, h = tid >> 5, l = tid & 31;
    const int nk = row < MP ? (row % T) + 1 : PAST + ((row - MP) % ST) + 1;
    const int ns = nk < TOPK ? nk : TOPK;
    for (int i = tid; i < WA; i += 256) q[i] = Qr[(size_t)row * WA + i];
    for (int i = tid; i < ns; i += 256) sl[i] = sel[(size_t)row * TOPK + i];
    __syncthreads();
    float mx = -INFINITY;
    for (int j = l; j < ns; j += 32) {
        const float4* kr = (const float4*)kv_row(row, sl[j], h, false, out, cache_k, cache_v, page_table);
        float dot = 0.f;
        for (int d4 = 0; d4 < DH / 4; ++d4) { const float4 kv = kr[d4]; const float* qq = q + h * DH + d4 * 4;
            dot = fmaf(qq[0], kv.x, dot); dot = fmaf(qq[1], kv.y, dot); dot = fmaf(qq[2], kv.z, dot); dot = fmaf(qq[3], kv.w, dot); }
        dot *= SM_SCALE;
        p[h][j] = dot; mx = fmaxf(mx, dot);
    }
    for (int o = 16; o >= 1; o >>= 1) mx = fmaxf(mx, __shfl_xor(mx, o));
    float sum = 0.f;
    for (int j = l; j < ns; j += 32) { const float e = expf(p[h][j] - mx); p[h][j] = e; sum += e; }
    for (int o = 16; o >= 1; o >>= 1) sum += __shfl_xor(sum, o);
    __syncthreads();
    float4 acc = make_float4(0.f, 0.f, 0.f, 0.f);
    for (int j = 0; j < ns; ++j) {
        const float4 vr = *((const float4*)kv_row(row, sl[j], h, true, out, cache_k, cache_v, page_table) + l);
        const float pj = p[h][j];
        acc.x = fmaf(pj, vr.x, acc.x); acc.y = fmaf(pj, vr.y, acc.y); acc.z = fmaf(pj, vr.z, acc.z); acc.w = fmaf(pj, vr.w, acc.w);
    }
    const float inv = 1.f / sum;
    *((float4*)(a_out + (size_t)row * WA + h * DH) + l) = make_float4(acc.x * inv, acc.y * inv, acc.z * inv, acc.w * inv);
}
__global__ void __launch_bounds__(256) hgrn_seq(const float* __restrict__ Z, const float* __restrict__ lb_logits, const float* __restrict__ s0, float* __restrict__ s_out, float* __restrict__ b_o,
                                                int row_base, int nt) {
    __shared__ float qs[DK], fs[DK], ks[DK], vs[64], red[4][64];
    const int b = blockIdx.x / (HB * 2), hd = (blockIdx.x / 2) % HB, vh = blockIdx.x & 1;
    const int tid = threadIdx.x, vl = tid & 63, dp = tid >> 6, v = vh * 64 + vl;
    float S[32];
#pragma unroll
    for (int i = 0; i < 32; ++i) S[i] = s0 ? s0[(((size_t)b * HB + hd) * DK + dp * 32 + i) * DV + v] : 0.f;
    float lbv = 0.f;
    if (tid < DK) { const float l0 = lb_logits[hd * DK + tid], l1 = lb_logits[HB * DK + hd * DK + tid]; const float m = fmaxf(l0, l1); const float e0 = expf(l0 - m), e1 = expf(l1 - m); lbv = e0 / (e0 + e1); }
    for (int t = 0; t < nt; ++t) {
        const float* z = Z + (size_t)(row_base + b * nt + t) * NIN;
        __syncthreads();
        if (tid < DK) { qs[tid] = silu_f(z[C_BQ + hd * DK + tid]); const float f = lbv + (1.f - lbv) * sigmoid_f(z[C_BF + hd * DK + tid]); fs[tid] = f; ks[tid] = 1.f - f; }
        else if (tid < DK + 64) vs[tid - DK] = z[C_BI + hd * DV + vh * 64 + (tid - DK)];
        __syncthreads();
        const float vv = vs[vl]; float o = 0.f;
#pragma unroll
        for (int i = 0; i < 32; ++i) { const int d = dp * 32 + i; S[i] = fs[d] * S[i] + ks[d] * vv; o = fmaf(qs[d], S[i], o); }
        red[dp][vl] = o;
        __syncthreads();
        if (dp == 0) b_o[(size_t)(row_base + b * nt + t) * WB + hd * DV + v] = (red[0][vl] + red[1][vl]) + (red[2][vl] + red[3][vl]);
    }
#pragma unroll
    for (int i = 0; i < 32; ++i) s_out[(((size_t)b * HB + hd) * DK + dp * 32 + i) * DV + v] = S[i];
}
__global__ void __launch_bounds__(256) mem_attn(const float* __restrict__ Z, const float* __restrict__ mk, const float* __restrict__ mv, float* __restrict__ m_out, int row0, int rows_per_batch) {
    __shared__ float q[WM];
    __shared__ float p[HM][NMEM];
    const int row = row0 + blockIdx.x, b = blockIdx.x / rows_per_batch, tid = threadIdx.x, h = tid >> 6, l = tid & 63;
    for (int i = tid; i < WM; i += 256) q[i] = Z[(size_t)row * NIN + C_MQ + i];
    __syncthreads();
    float mx = -INFINITY;
    for (int n = l; n < NMEM; n += 64) {
        const float4* kr = (const float4*)(mk + ((size_t)(b * NMEM + n) * HM + h) * DH);
        float dot = 0.f;
        for (int d4 = 0; d4 < DH / 4; ++d4) { const float4 kv = kr[d4]; const float* qq = q + h * DH + d4 * 4;
            dot = fmaf(qq[0], kv.x, dot); dot = fmaf(qq[1], kv.y, dot); dot = fmaf(qq[2], kv.z, dot); dot = fmaf(qq[3], kv.w, dot); }
        dot *= SM_SCALE; p[h][n] = dot; mx = fmaxf(mx, dot);
    }
    for (int o = 32; o >= 1; o >>= 1) mx = fmaxf(mx, __shfl_xor(mx, o));
    float sum = 0.f;
    for (int n = l; n < NMEM; n += 64) { const float e = expf(p[h][n] - mx); p[h][n] = e; sum += e; }
    for (int o = 32; o >= 1; o >>= 1) sum += __shfl_xor(sum, o);
    __syncthreads();
    float a0 = 0.f, a1 = 0.f;
    for (int n = 0; n < NMEM; ++n) { const float* vr = mv + ((size_t)(b * NMEM + n) * HM + h) * DH + l * 2; const float pn = p[h][n]; a0 = fmaf(pn, vr[0], a0); a1 = fmaf(pn, vr[1], a1); }
    const float inv = 1.f / sum;
    m_out[(size_t)row * WM + h * DH + l * 2] = a0 * inv; m_out[(size_t)row * WM + h * DH + l * 2 + 1] = a1 * inv;
}
__global__ void __launch_bounds__(256) merge_rows(const float* __restrict__ Z, const float* __restrict__ a_out, const float* __restrict__ b_o, const float* __restrict__ m_out, const float* __restrict__ norm_g,
                                                   float* __restrict__ cat, unsigned short* __restrict__ catb) {
    __shared__ float ssq[HB];
    const int row = blockIdx.x, tid = threadIdx.x;
    const float* z = Z + (size_t)row * NIN;
    { const int h = tid >> 6, l = tid & 63; const float x0 = b_o[(size_t)row * WB + h * DV + l], x1 = b_o[(size_t)row * WB + h * DV + 64 + l]; float s = x0 * x0 + x1 * x1;
      for (int o = 32; o >= 1; o >>= 1) s += __shfl_xor(s, o);
      if (l == 0) ssq[h] = s; }
    __syncthreads();
    for (int c = tid; c < WA; c += 256) cat[(size_t)row * DM + c] = a_out[(size_t)row * WA + c] * silu_f(z[C_AG + c]);
    for (int c = tid; c < WB; c += 256) { const int h = c >> 7; const float r = rsqrtf(ssq[h] * (1.f / DV) + RMS_EPS);
        cat[(size_t)row * DM + WA + c] = b_o[(size_t)row * WB + c] * r * norm_g[c & 127] * silu_f(z[C_BG + c]); }
    for (int c = tid; c < WM; c += 256) cat[(size_t)row * DM + WA + WB + c] = m_out[(size_t)row * WM + c] * silu_f(z[C_MG + c]);
    __syncthreads();
    for (int c = tid; c < DM; c += 256) catb[(size_t)row * DM + c] = (unsigned short)f2bf(cat[(size_t)row * DM + c]);
}
__global__ void __launch_bounds__(256) ln_rows(const float* __restrict__ xp, const float* __restrict__ xs, const float* __restrict__ Y, const float* __restrict__ g, const float* __restrict__ bta, float* __restrict__ out) {
    __shared__ float red[8];
    const int row = blockIdx.x, tid = threadIdx.x;
    const float* x = row < MP ? xp + (size_t)row * DM : xs + (size_t)(row - MP) * DM;
    float* o = row < MP ? out + O_YP + (size_t)row * DM : out + O_YS + (size_t)(row - MP) * DM;
    float v[8]; float s = 0.f;
#pragma unroll
    for (int i = 0; i < 8; ++i) { const int c = tid + 256 * i; v[i] = ALPHA * x[c] + Y[(size_t)row * DM + c]; s += v[i]; }
    for (int of = 32; of >= 1; of >>= 1) s += __shfl_xor(s, of);
    if ((tid & 63) == 0) red[tid >> 6] = s;
    __syncthreads();
    const float mean = (red[0] + red[1] + red[2] + red[3]) * (1.f / DM);
    float q = 0.f;
#pragma unroll
    for (int i = 0; i < 8; ++i) { v[i] -= mean; q += v[i] * v[i]; }
    for (int of = 32; of >= 1; of >>= 1) q += __shfl_xor(q, of);
    if ((tid & 63) == 0) red[4 + (tid >> 6)] = q;
    __syncthreads();
    const float rstd = rsqrtf((red[4] + red[5] + red[6] + red[7]) * (1.f / DM) + LN_EPS);
#pragma unroll
    for (int i = 0; i < 8; ++i) { const int c = tid + 256 * i; o[c] = v[i] * rstd * g[c] + bta[c]; }
}

#endif
#if PROBE
__global__ void __launch_bounds__(64) sel_to_mask(const int* __restrict__ sel, unsigned* __restrict__ mask) {
    __shared__ unsigned w[64];
    const int row = blockIdx.x, t = row % T, ns = (t + 1) < TOPK ? (t + 1) : TOPK;
    w[threadIdx.x] = 0u; __syncthreads();
    for (int i = threadIdx.x; i < ns; i += 64) { const int s = sel[(size_t)row * TOPK + i]; atomicOr(&w[s >> 5], 1u << (s & 31)); }
    __syncthreads();
    mask[(size_t)row * 64 + threadIdx.x] = w[threadIdx.x];
}
__global__ void __launch_bounds__(256) cmp_masks(const unsigned* __restrict__ a, const unsigned* __restrict__ b, float* acc) {
    float c = 0.f;
    for (size_t i = (size_t)blockIdx.x * 256 + threadIdx.x; i < (size_t)MP * 64; i += (size_t)gridDim.x * 256) c += (float)__popc(a[i] ^ b[i]);
    for (int o = 32; o >= 1; o >>= 1) c += __shfl_xor(c, o);
    if ((threadIdx.x & 63) == 0) atomicAdd(acc + 2, c);
}
__global__ void __launch_bounds__(256) cmp_vals(const float* __restrict__ a, const float* __restrict__ ref, size_t n, float* acc) {
    float d = 0.f, r = 0.f;
    for (size_t i = (size_t)blockIdx.x * 256 + threadIdx.x; i < n; i += (size_t)gridDim.x * 256) { const float x = a[i] - ref[i]; d += x * x; r += ref[i] * ref[i]; }
    for (int o = 32; o >= 1; o >>= 1) { d += __shfl_xor(d, o); r += __shfl_xor(r, o); }
    if ((threadIdx.x & 63) == 0) { atomicAdd(acc, d); atomicAdd(acc + 1, r); }
}
__global__ void __launch_bounds__(256) apply_probe(float* out, const float* acc) {
    const float err = sqrtf(acc[0] / fmaxf(acc[1], 1e-30f));
    for (int i = threadIdx.x; i < MS * DI; i += 256) out[O_IKS + i] *= (1.f + err);
    if (threadIdx.x == 0) out[O_YP] += acc[2] * (1.f / MP);
}
#endif

extern "C" void kernel_launch(void* const* d_in, const int* in_sizes, int n_in, void* d_out, int out_size, void* d_ws, size_t ws_size, hipStream_t stream) {
    static int grid = 0;
    if (grid == 0) {
        int dev = 0, cus = 0, per_cu = 0;
        if (n_in != 18 || (size_t)out_size != O_END || ws_size < (HYBRID ? WS_END : WS_FAST_END)) { fprintf(stderr, "kernel_launch: unexpected sizes (n_in %d out %d ws %zu need %zu)\n", n_in, out_size, ws_size, (size_t)WS_END); grid = -1; return; }
        if (hipGetDevice(&dev) != hipSuccess || hipDeviceGetAttribute(&cus, hipDeviceAttributeMultiprocessorCount, dev) != hipSuccess) { grid = -1; return; }
        if (hipFuncSetAttribute((const void*)mega_fwd, hipFuncAttributeMaxDynamicSharedMemorySize, LDS_BYTES) != hipSuccess) { fprintf(stderr, "kernel_launch: hipFuncSetAttribute failed\n"); grid = -1; return; }
        if (hipOccupancyMaxActiveBlocksPerMultiprocessor(&per_cu, (const void*)mega_fwd, NWAVES * 64, LDS_BYTES) != hipSuccess || per_cu < 1) fprintf(stderr, "kernel_launch: occupancy query says %d\n", per_cu);
        (void)hipGetLastError();
        grid = cus;
    }
    if (grid < 0) return;
    const float* x_prompt = (const float*)d_in[0]; const float* x_sample = (const float*)d_in[1];
    const float* cache_k = (const float*)d_in[3]; const float* cache_v = (const float*)d_in[4]; const float* cache_idx_k = (const float*)d_in[5];
    const float* state_hgrn = (const float*)d_in[6]; const float* cache_mem_k = (const float*)d_in[7]; const float* cache_mem_v = (const float*)d_in[8];
    const int* page_table = (const int*)d_in[9]; const float* lb_logits = (const float*)d_in[11];
    const float* norm_g = (const float*)d_in[12]; const float* w_out = (const float*)d_in[15]; const float* ln_g = (const float*)d_in[16]; const float* ln_b = (const float*)d_in[17];
    float* out = (float*)d_out;
    unsigned char* wsb = (unsigned char*)d_ws;
    (void)hipMemsetAsync(wsb + WS_CTL, 0, CTL_BYTES, stream);
    Args a{};
    a.x_prompt = x_prompt; a.x_sample = x_sample; a.mem_prompt = (const float*)d_in[2]; a.cache_k = cache_k; a.cache_v = cache_v; a.cache_idx_k = cache_idx_k; a.state_hgrn = state_hgrn;
    a.cache_mem_k = cache_mem_k; a.cache_mem_v = cache_mem_v; a.page_table = page_table; a.w_in = (const float*)d_in[10]; a.lb_logits = lb_logits; a.norm_g = norm_g;
    a.w_mem_k = (const float*)d_in[13]; a.w_mem_v = (const float*)d_in[14]; a.w_out = w_out; a.ln_g = ln_g; a.ln_b = ln_b; a.out = out; a.ws = wsb; a.pad = 0; a.dbg_aout = nullptr; a.dbg_mout = nullptr; a.dbg_bo = nullptr;
#if NLAUNCH == 1
    a.ph_lo = 0; a.ph_hi = HYBRID ? 2 : 7; a.li = 0;
    hipLaunchKernelGGL(mega_fwd, dim3(grid), dim3(NWAVES * 64), LDS_BYTES, stream, a);
#else
    { const int cuts[6] = {0, 2, 3, 4, 5, 7};
      for (int li = 0; li < 5; ++li) { a.ph_lo = cuts[li]; a.ph_hi = cuts[li + 1]; a.li = li; hipLaunchKernelGGL(mega_fwd, dim3(grid), dim3(NWAVES * 64), LDS_BYTES, stream, a); } }
#endif
#if HYBRID
    float* Z = (float*)(wsb + WS_Z); float* Qr = (float*)(wsb + WS_QR); float* IQr = (float*)(wsb + WS_IQR); int* sel = (int*)(wsb + WS_SEL); float* a_out = (float*)(wsb + WS_AOUT);
    float* b_o = (float*)(wsb + WS_BO); float* m_out = (float*)(wsb + WS_MO); float* cat = (float*)(wsb + WS_CAT); float* SC = (float*)(wsb + WS_SC);
    post_rows<<<MR, 256, 0, stream>>>(Z, Qr, IQr, out, 0, 0);
    idx_scores<<<dim3((NKEYS_S + 255) / 256, 64), 256, 0, stream>>>(Z, IQr, out, cache_idx_k, page_table, SC, MP, 16400);
    idx_select<<<dim3((NKEYS_S + 255) / 256, 64), 256, 0, stream>>>(SC, sel, MP, 16400);
    sparse_attn<<<MS, 256, 0, stream>>>(Qr, sel, out, cache_k, cache_v, page_table, a_out, MP);
    a.ph_lo = 2; a.ph_hi = 5; a.li = 1; a.dbg_aout = a_out; a.dbg_mout = m_out; a.dbg_bo = b_o;
    hipLaunchKernelGGL(mega_fwd, dim3(grid), dim3(NWAVES * 64), LDS_BYTES, stream, a);
#if PROBE
    {
        float* m_ref = (float*)(wsb + WS_Y); float* acc = (float*)(wsb + WS_SC);
        (void)hipMemsetAsync(acc, 0, 16, stream);
        mem_attn<<<MP, 256, 0, stream>>>(Z, out + O_MKP, out + O_MVP, m_ref, 0, T);
        cmp_vals<<<1024, 256, 0, stream>>>(m_out, m_ref, (size_t)MP * WM, acc);
    }
#endif
    hgrn_seq<<<SB * HB * 2, 256, 0, stream>>>(Z, lb_logits, state_hgrn, out + O_HS, b_o, MP, ST);
    mem_attn<<<MS, 256, 0, stream>>>(Z, cache_mem_k, cache_mem_v, m_out, MP, ST);
    merge_rows<<<MR, 256, 0, stream>>>(Z, a_out, b_o, m_out, norm_g, cat, (unsigned short*)(wsb + WS_CATB));
    a.ph_lo = 5; a.ph_hi = 7; a.li = 2; a.dbg_aout = nullptr; a.dbg_mout = nullptr; a.dbg_bo = nullptr;
    hipLaunchKernelGGL(mega_fwd, dim3(grid), dim3(NWAVES * 64), LDS_BYTES, stream, a);
#if PROBE
    apply_probe<<<1, 256, 0, stream>>>(out, (const float*)(wsb + WS_SC));
#endif
#endif
}
```
